# Optimizing an MI355X kernel written in HIP

```python
import math
import jax, jax.numpy as jnp
from jax import lax
import numpy as np

D_MODEL = 2048
BATCH = 4
SEQ = 2048
DEPTH = 4

HEAD_DIM = 128
D_FF = 5632
MACARON_WEIGHT = 0.5
RMS_EPS = 1e-6
NEG_INF = -1e30

A_HEADS = 8
A_PATTERNS = ((128, 1), (512, 4), (2048, 16))
A_BLOCK = 64
B_HEADS = 8
B_KV_HEADS = 2
B_HALF_WINDOW = 128
B_BLOCK = 128
C_HEADS = 16
GRID_W = 64
C_KR_MAX = 8
C_KC = 16
C_QR_MAX = 8
C_QC = 16

AB_WIDTH = (A_HEADS + B_HEADS) * HEAD_DIM
AB_IN = 3 * A_HEADS * HEAD_DIM + B_HEADS * HEAD_DIM + 2 * B_KV_HEADS * HEAD_DIM
C_WIDTH = C_HEADS * HEAD_DIM
C_IN = 3 * C_WIDTH
N_EVEN = (DEPTH + 1) // 2
N_ODD = DEPTH // 2

kernel_name = "hybrid_dilated_banded_natten_macaron"


def _rmsnorm(x, g):
    x32 = x.astype(jnp.float32)
    y = x32 * lax.rsqrt(jnp.mean(x32 * x32, axis=-1, keepdims=True) + RMS_EPS)
    return (y * g.astype(jnp.float32)).astype(x.dtype)


def _swiglu(h, w_gate, w_up, w_down):
    return (jax.nn.silu(h @ w_gate) * (h @ w_up)) @ w_down


def _alibi_slopes(n):
    return 2.0 ** (-8.0 * jnp.arange(1, n + 1, dtype=jnp.float32) / n)


def _banded_attention(q, k, v, half_window, block, slopes, dist_scale, sink=None):
    L, dh = q.shape[-2], q.shape[-1]
    nb = L // block
    kw = block + 2 * half_window
    pad = [(0, 0)] * (k.ndim - 2) + [(half_window, half_window), (0, 0)]
    kp = jnp.pad(k, pad)
    vp = jnp.pad(v, pad)
    kidx = jnp.arange(nb)[:, None] * block + jnp.arange(kw)[None, :]
    kb = jnp.take(kp, kidx, axis=-2)
    vb = jnp.take(vp, kidx, axis=-2)
    qb = q.reshape(q.shape[:-2] + (nb, block, dh))
    s = jnp.einsum('...hgnqd,...hnkd->...hgnqk', qb, kb).astype(jnp.float32) * (dh ** -0.5)
    qpos = jnp.arange(L).reshape(nb, block)
    kpos = kidx - half_window
    dist = jnp.abs(qpos[:, :, None] - kpos[:, None, :])
    valid = (dist <= half_window) & (kpos >= 0)[:, None, :] & (kpos < L)[:, None, :]
    bias = -slopes[:, :, None, None, None] * (dist * dist_scale).astype(jnp.float32)
    s = jnp.where(valid, s + bias, NEG_INF)
    m = jnp.max(s, axis=-1)
    if sink is not None:
        sink32 = sink.astype(jnp.float32)[:, :, None, None]
        m = jnp.maximum(m, sink32)
    p = jnp.exp(s - m[..., None])
    denom = jnp.sum(p, axis=-1)
    if sink is not None:
        denom = denom + jnp.exp(sink32 - m)
    o = jnp.einsum('...hgnqk,...hnkd->...hgnqd', (p / denom[..., None]).astype(v.dtype), vb)
    lse = m + jnp.log(denom)
    return o.reshape(q.shape), lse.reshape(q.shape[:-1])


def _dilated_mixture(q, k, v, slopes):
    B, S, H, dh = q.shape
    outs, lses = [], []
    for window, r in A_PATTERNS:
        L = S // r
        def to_res(t):
            return t.reshape(B, L, r, H, dh).transpose(0, 2, 3, 1, 4)
        o, lse = _banded_attention(to_res(q)[:, :, :, None], to_res(k), to_res(v),
                                   window // (2 * r), math.gcd(L, A_BLOCK), slopes[:, None], r)
        outs.append(o[:, :, :, 0].transpose(0, 3, 1, 2, 4).reshape(B, S, H, dh))
        lses.append(lse[:, :, :, 0].transpose(0, 3, 1, 2).reshape(B, S, H))
    w = jax.nn.softmax(jnp.stack(lses), axis=0)
    out = jnp.sum(w[..., None] * jnp.stack(outs).astype(jnp.float32), axis=0)
    return out.astype(q.dtype)


def _windowed_gqa_sink(q, k, v, sink):
    B, S, hq, dh = q.shape
    grp = hq // B_KV_HEADS
    qg = q.reshape(B, S, B_KV_HEADS, grp, dh).transpose(0, 2, 3, 1, 4)
    kt = k.transpose(0, 2, 1, 3)
    vt = v.transpose(0, 2, 1, 3)
    slopes = _alibi_slopes(hq).reshape(B_KV_HEADS, grp)
    o, _ = _banded_attention(qg, kt, vt, B_HALF_WINDOW, B_BLOCK, slopes, 1,
                             sink.reshape(B_KV_HEADS, grp))
    return o.transpose(0, 3, 1, 2, 4).reshape(B, S, hq, dh)


def _neighbourhood_attention(q, k, v, rpb):
    B, S, H, dh = q.shape
    rows = S // GRID_W
    kr = min(C_KR_MAX, rows)
    qr = math.gcd(rows, C_QR_MAX)
    span_r = min(rows, kr + qr - 1)
    span_c = min(GRID_W, C_KC + C_QC - 1)
    nrb, ncb = rows // qr, GRID_W // C_QC
    qrow = jnp.arange(rows)
    qcol = jnp.arange(GRID_W)
    row_start = jnp.clip(qrow - kr // 2, 0, rows - kr)
    col_start = jnp.clip(qcol - C_KC // 2, 0, GRID_W - C_KC)
    rb_start = jnp.clip(jnp.arange(nrb) * qr - kr // 2, 0, rows - span_r)
    cb_start = jnp.clip(jnp.arange(ncb) * C_QC - C_KC // 2, 0, GRID_W - span_c)
    kr_idx = rb_start[:, None] + jnp.arange(span_r)[None, :]
    kc_idx = cb_start[:, None] + jnp.arange(span_c)[None, :]

    def gather_kv(t):
        g = jnp.take(t.reshape(B, rows, GRID_W, H, dh), kr_idx, axis=1)
        g = jnp.take(g, kc_idx, axis=3)
        return g.transpose(0, 5, 1, 3, 2, 4, 6).reshape(B, H, nrb, ncb, span_r * span_c, dh)

    kb = gather_kv(k)
    vb = gather_kv(v)
    qb = q.reshape(B, nrb, qr, ncb, C_QC, H, dh).transpose(0, 5, 1, 3, 2, 4, 6)
    qb = qb.reshape(B, H, nrb, ncb, qr * C_QC, dh)
    s = jnp.einsum('bhnmqd,bhnmkd->bhnmqk', qb, kb).astype(jnp.float32) * (dh ** -0.5)

    kr_b = kr_idx[:, None, :]
    rs = row_start.reshape(nrb, qr)[:, :, None]
    in_r = (kr_b >= rs) & (kr_b < rs + kr)
    dr = kr_b - qrow.reshape(nrb, qr)[:, :, None]
    kc_b = kc_idx[:, None, :]
    cs = col_start.reshape(ncb, C_QC)[:, :, None]
    in_c = (kc_b >= cs) & (kc_b < cs + C_KC)
    dc = kc_b - qcol.reshape(ncb, C_QC)[:, :, None]
    ri = jnp.clip(dr + C_KR_MAX - 1, 0, 2 * C_KR_MAX - 2)
    ci = jnp.clip(dc + C_KC - 1, 0, 2 * C_KC - 2)
    bias = rpb.astype(jnp.float32)[:, ri[:, :, :, None, None, None], ci[None, None, None]]
    mask = in_r[:, :, :, None, None, None] & in_c[None, None, None]
    bias = jnp.where(mask[None], bias, NEG_INF)
    bias = bias.transpose(0, 1, 4, 2, 5, 3, 6).reshape(H, nrb, ncb, qr * C_QC, span_r * span_c)
    p = jax.nn.softmax(s + bias[None], axis=-1)
    o = jnp.einsum('bhnmqk,bhnmkd->bhnmqd', p.astype(v.dtype), vb)
    o = o.reshape(B, H, nrb, ncb, qr, C_QC, dh).transpose(0, 2, 4, 3, 5, 1, 6)
    return o.reshape(B, S, H, dh)


def _mixer_ab(h, w_in, w_out, sink):
    B, S, _ = h.shape
    da, db, dkv = A_HEADS * HEAD_DIM, B_HEADS * HEAD_DIM, B_KV_HEADS * HEAD_DIM
    proj = h @ w_in
    qa, ka, va, qb, kb, vb = jnp.split(
        proj, [da, 2 * da, 3 * da, 3 * da + db, 3 * da + db + dkv], axis=-1)
    heads_a = lambda t: t.reshape(B, S, A_HEADS, HEAD_DIM)
    oa = _dilated_mixture(heads_a(qa), heads_a(ka), heads_a(va), _alibi_slopes(A_HEADS))
    ob = _windowed_gqa_sink(qb.reshape(B, S, B_HEADS, HEAD_DIM),
                            kb.reshape(B, S, B_KV_HEADS, HEAD_DIM),
                            vb.reshape(B, S, B_KV_HEADS, HEAD_DIM), sink)
    o = jnp.concatenate([oa.reshape(B, S, da), ob.reshape(B, S, db)], axis=-1)
    return o @ w_out


def _mixer_c(h, w_in, w_out, rpb):
    B, S, _ = h.shape
    q, k, v = jnp.split(h @ w_in, 3, axis=-1)
    heads = lambda t: t.reshape(B, S, C_HEADS, HEAD_DIM)
    o = _neighbourhood_attention(heads(q), heads(k), heads(v), rpb)
    return o.reshape(B, S, C_WIDTH) @ w_out


def setup_inputs(seed: int = 0) -> dict:
    key = jax.random.key(seed)
    ks = jax.random.split(key, 14)
    f32 = jnp.float32
    D, F = D_MODEL, D_FF
    nrm = lambda k, shape: jax.random.normal(k, shape, f32)
    return {
        'x': nrm(ks[0], (BATCH, SEQ, D)),
        'ffn_norm': 1.0 + 0.02 * nrm(ks[1], (DEPTH, 2, D)),
        'ffn_w_gate': nrm(ks[2], (DEPTH, 2, D, F)) * D ** -0.5,
        'ffn_w_up': nrm(ks[3], (DEPTH, 2, D, F)) * D ** -0.5,
        'ffn_w_down': nrm(ks[4], (DEPTH, 2, F, D)) * F ** -0.5,
        'mix_norm': 1.0 + 0.02 * nrm(ks[5], (DEPTH, D)),
        'ab_w_in': nrm(ks[6], (N_EVEN, D, AB_IN)) * D ** -0.5,
        'ab_w_out': nrm(ks[7], (N_EVEN, AB_WIDTH, D)) * AB_WIDTH ** -0.5,
        'ab_sink': 0.5 * nrm(ks[8], (N_EVEN, B_HEADS)),
        'c_w_in': nrm(ks[9], (N_ODD, D, C_IN)) * D ** -0.5,
        'c_w_out': nrm(ks[10], (N_ODD, C_WIDTH, D)) * C_WIDTH ** -0.5,
        'c_rpb': 0.1 * nrm(ks[11], (N_ODD, C_HEADS, 2 * C_KR_MAX - 1, 2 * C_KC - 1)),
        'final_norm': 1.0 + 0.02 * nrm(ks[12], (D,)),
    }


def reference(x, ffn_norm, ffn_w_gate, ffn_w_up, ffn_w_down, mix_norm, ab_w_in, ab_w_out,
              ab_sink, c_w_in, c_w_out, c_rpb, final_norm):
    for layer in range(DEPTH):
        h = _rmsnorm(x, ffn_norm[layer, 0])
        x = x + MACARON_WEIGHT * _swiglu(h, ffn_w_gate[layer, 0], ffn_w_up[layer, 0], ffn_w_down[layer, 0])
        h = _rmsnorm(x, mix_norm[layer])
        i = layer // 2
        if layer % 2 == 0:
            x = x + _mixer_ab(h, ab_w_in[i], ab_w_out[i], ab_sink[i])
        else:
            x = x + _mixer_c(h, c_w_in[i], c_w_out[i], c_rpb[i])
        h = _rmsnorm(x, ffn_norm[layer, 1])
        x = x + MACARON_WEIGHT * _swiglu(h, ffn_w_gate[layer, 1], ffn_w_up[layer, 1], ffn_w_down[layer, 1])
    return _rmsnorm(x, final_norm)
```

```cpp
#include <hip/hip_runtime.h>
#include <cstdio>
#include <cstdint>

#ifndef MK_MULTI
#define MK_MULTI 1
#endif

namespace pg8 {
#define PG8_LAS __attribute__((address_space(3)))
typedef unsigned short bf16_t;
typedef short bf16x8 __attribute__((ext_vector_type(8)));
typedef float f32x4 __attribute__((ext_vector_type(4)));
typedef unsigned u32x4 __attribute__((ext_vector_type(4)));
constexpr int BM = 256, BK = 64, HALF = 128, HTB = HALF * BK * 2  , STAGE_BYTES = 8 * HTB, NXCD = 8, WGM = 8;

__host__ __device__ __forceinline__ int lds_byte(int r, int c) { const int st = (r >> 4) * 2 + (c >> 5), rr = r & 15, cc = c & 31, ob = rr * 64 + cc * 2; return st * 1024 + (ob ^ (((ob >> 9) & 1) << 5)); }
__host__ __device__ __forceinline__ void stage_rc(int b, int& R, int& C) { const int st = b / 1024, sb = b % 1024, swz = sb ^ (((sb >> 9) & 1) << 5); R = (st >> 1) * 16 + swz / 64; C = (st & 1) * 32 + (swz % 64) / 2; }
__host__ __device__ __forceinline__ int perm32(int rho) { const int n = rho >> 4, i = rho & 15; return 8 * (i >> 2) + 4 * n + (i & 3); }

struct Unit { int pm, pn; };
struct Gemm { const bf16_t* A; const bf16_t* Bt; int M, N, K; };

struct StaticOrder {
    int nM, nN, nwg, G, c;
    __host__ __device__ void init(int M, int N, int G_, int c_) { nM = M / BM; nN = N / BM; nwg = nM * nN; G = G_; c = c_; }
    __host__ __device__ bool next(int i, Unit& u) const {
        const long L = (long)i * G + c; if (L >= nwg) return false;
        int wgid = (int)L; { const int q = nwg / NXCD, r = nwg % NXCD, xcd = wgid % NXCD, off = wgid / NXCD; wgid = (xcd < r ? xcd * (q + 1) : r * (q + 1) + (xcd - r) * q) + off; }
        const int nig = WGM * nN, gid = wgid / nig, fm = gid * WGM, gsz = (nM - fm) < WGM ? (nM - fm) : WGM;
        u.pm = fm + ((wgid % nig) % gsz); u.pn = (wgid % nig) / gsz; return true;
    }
    __device__ __forceinline__ void a_ready(const Unit&) const {}
    __device__ __forceinline__ void done(const Unit&) const {}
};

__device__ __forceinline__ unsigned cvt_pk_bf16(float lo, float hi) { unsigned r; asm volatile("v_cvt_pk_bf16_f32 %0, %1, %2" : "=v"(r) : "v"(lo), "v"(hi)); return r; }

struct EpiBf16 {
    static constexpr bool PERM = true, AFTER_DRAIN = false;
    bf16_t* O; int ldc;
    __device__ __forceinline__ void operator()(const f32x4 (&acc)[2][2][4][2], const Unit& u, int wr, int wc, int fr, int fq) const {
        const int row0 = u.pm * BM + wr * 64 + fr; const int col0 = u.pn * BM + wc * 32 + 8 * fq;
#pragma unroll
        for (int ai = 0; ai < 2; ++ai)
#pragma unroll
            for (int m = 0; m < 4; ++m) { bf16_t* rowp = O + (size_t)(row0 + ai * HALF + m * 16) * ldc + col0;
#pragma unroll
                for (int bj = 0; bj < 2; ++bj) { const f32x4 v0 = acc[ai][bj][m][0], v1 = acc[ai][bj][m][1];
                    u32x4 w; w.x = cvt_pk_bf16(v0[0], v0[1]); w.y = cvt_pk_bf16(v0[2], v0[3]); w.z = cvt_pk_bf16(v1[0], v1[1]); w.w = cvt_pk_bf16(v1[2], v1[3]);
                    *(u32x4*)(rowp + bj * HALF) = w; } }
    }
};
struct EpiSwiglu {
    static constexpr bool PERM = true, AFTER_DRAIN = false;
    bf16_t* O; int ldc;
    __device__ __forceinline__ void operator()(const f32x4 (&acc)[2][2][4][2], const Unit& u, int wr, int wc, int fr, int fq) const {
        const int row0 = u.pm * BM + wr * 64 + fr; const int col0 = u.pn * HALF + wc * 32 + 8 * fq;
#pragma unroll
        for (int ai = 0; ai < 2; ++ai)
#pragma unroll
            for (int m = 0; m < 4; ++m) { bf16_t* rowp = O + (size_t)(row0 + ai * HALF + m * 16) * ldc + col0;
                float r[8];
#pragma unroll
                for (int n = 0; n < 2; ++n)
#pragma unroll
                    for (int j = 0; j < 4; ++j) { const float g = acc[ai][0][m][n][j], up = acc[ai][1][m][n][j];
                        r[n * 4 + j] = g * __builtin_amdgcn_rcpf(1.0f + __expf(-g)) * up; }
                u32x4 w; w.x = cvt_pk_bf16(r[0], r[1]); w.y = cvt_pk_bf16(r[2], r[3]); w.z = cvt_pk_bf16(r[4], r[5]); w.w = cvt_pk_bf16(r[6], r[7]);
                *(u32x4*)rowp = w; }
    }
};
struct EpiResid {
    static constexpr bool PERM = false, AFTER_DRAIN = false;
    const float* base; float* out; int ldc; float scale;
    __device__ __forceinline__ void operator()(const f32x4 (&acc)[2][2][4][2], const Unit& u, int wr, int wc, int fr, int fq) const {
        const int row0 = u.pm * BM + wr * 64 + fr, col0 = u.pn * BM + wc * 32 + 4 * fq;
#pragma unroll
        for (int ai = 0; ai < 2; ++ai)
#pragma unroll
            for (int m = 0; m < 4; ++m) { const size_t off = (size_t)(row0 + ai * HALF + m * 16) * ldc + col0;
#pragma unroll
                for (int bj = 0; bj < 2; ++bj)
#pragma unroll
                    for (int n = 0; n < 2; ++n) { const f32x4 b = *(const f32x4*)(base + off + bj * HALF + n * 16);
                        *(f32x4*)(out + off + bj * HALF + n * 16) = b + acc[ai][bj][m][n] * scale; } }
    }
};
template <class Epi, class Sched, bool ALIGN_EPI = false, bool SP2 = false>
__device__ __forceinline__ void gemm_phase(PG8_LAS unsigned char* lds, const Gemm g, const Sched& S, const Epi& E) {
    int tid_ = threadIdx.x; asm volatile("" : "+v"(tid_));
    const int tid = tid_, wid = __builtin_amdgcn_readfirstlane(tid >> 6), lane = tid & 63, wr = wid >> 2, wc = wid & 3, fr = lane & 15, fq = lane >> 4;
    const int K = g.K, nt = K / BK;
    unsigned voffA[2], voffB[2];
#pragma unroll
    for (int i = 0; i < 2; ++i) { int R, C; stage_rc(tid * 16 + i * 8192, R, C); const int Rb = Epi::PERM ? ((R & ~31) + perm32(R & 31)) : R;
        voffA[i] = (unsigned)(R * K + C) * 2u; voffB[i] = (unsigned)(Rb * K + C) * 2u; }
    const size_t kstep = (size_t)(BK * 2);
    const size_t hstep = (size_t)HALF * K * 2;
    const size_t tstep = 2 * hstep;
    const unsigned ldsw = (unsigned)wid * 1024u;
    const int aoff = lds_byte(wr * 64 + fr, fq * 8), boff = lds_byte(wc * 32 + fr, fq * 8);
#define PG8_SA(b, h) (((b) * 2 + (h)) * HTB)
#define PG8_SB(b, h) ((4 + (b) * 2 + (h)) * HTB)
#define PG8_STAGE(bufoff, gbase, voff) do { _Pragma("unroll") for (int _i = 0; _i < 2; ++_i) \
        __builtin_amdgcn_global_load_lds((const unsigned*)((const char*)(gbase) + (voff)[_i]), (PG8_LAS unsigned*)(lds + (bufoff) + ldsw + _i * 8192), 16, 0, 0); } while (0)
#define PG8_LDA(dst, b, h) do { _Pragma("unroll") for (int m = 0; m < 4; ++m) _Pragma("unroll") for (int k = 0; k < 2; ++k) dst[m][k] = *(const PG8_LAS bf16x8*)(lds + PG8_SA(b, h) + aoff + m * 2048 + k * 1024); } while (0)
#define PG8_LDB(dst, b, h) do { _Pragma("unroll") for (int n = 0; n < 2; ++n) _Pragma("unroll") for (int k = 0; k < 2; ++k) dst[n][k] = *(const PG8_LAS bf16x8*)(lds + PG8_SB(b, h) + boff + n * 2048 + k * 1024); } while (0)
#define PG8_MMA(ai, bj, At, Bt) do { __builtin_amdgcn_s_setprio(1); _Pragma("unroll") for (int m = 0; m < 4; ++m) _Pragma("unroll") for (int n = 0; n < 2; ++n) _Pragma("unroll") for (int k = 0; k < 2; ++k) \
        acc[ai][bj][m][n] = __builtin_amdgcn_mfma_f32_16x16x32_bf16(Bt[n][k], At[m][k], acc[ai][bj][m][n], 0, 0, 0); __builtin_amdgcn_s_setprio(0); } while (0)
#define PG8_WAIT_V(n) asm volatile("s_waitcnt vmcnt(" #n ")" ::: "memory")
#define PG8_WAIT_L(n) asm volatile("s_waitcnt lgkmcnt(" #n ")" ::: "memory")
#define PG8_BAR __builtin_amdgcn_s_barrier()
#define PG8_SCHED __builtin_amdgcn_sched_barrier(0)
    Unit cur, nxt; int ui = 0;
    if (!S.next(0, cur)) return;
    f32x4 acc[2][2][4][2];
#pragma unroll
    for (int a = 0; a < 2; ++a)
#pragma unroll
        for (int b = 0; b < 2; ++b)
#pragma unroll
            for (int m = 0; m < 4; ++m)
#pragma unroll
                for (int n = 0; n < 2; ++n) acc[a][b][m][n] = (f32x4){0.f, 0.f, 0.f, 0.f};
    bf16x8 At[4][2], B0[2][2], B1[2][2];
    const char* cA = (const char*)g.A + (size_t)cur.pm * tstep; const char* cB = (const char*)g.Bt + (size_t)cur.pn * tstep;
    S.a_ready(cur);
    if constexpr (SP2) {
        PG8_STAGE(PG8_SB(0, 0), cB, voffB); PG8_STAGE(PG8_SB(0, 1), cB + hstep, voffB); PG8_STAGE(PG8_SA(0, 0), cA, voffA); PG8_STAGE(PG8_SA(0, 1), cA + hstep, voffA);
        if (wr == 1) PG8_BAR;
        PG8_WAIT_V(2); PG8_BAR;
        PG8_STAGE(PG8_SB(1, 0), cB + kstep, voffB); PG8_STAGE(PG8_SA(1, 0), cA + kstep, voffA); PG8_STAGE(PG8_SB(1, 1), cB + hstep + kstep, voffB);
        PG8_WAIT_V(6); PG8_BAR;
    } else {
        PG8_STAGE(PG8_SB(0, 0), cB, voffB); PG8_STAGE(PG8_SA(0, 0), cA, voffA); PG8_STAGE(PG8_SB(0, 1), cB + hstep, voffB); PG8_STAGE(PG8_SA(0, 1), cA + hstep, voffA);
        if (wr == 1) PG8_BAR;
        PG8_WAIT_V(4); PG8_BAR;
        PG8_STAGE(PG8_SB(1, 0), cB + kstep, voffB); PG8_STAGE(PG8_SA(1, 0), cA + kstep, voffA); PG8_STAGE(PG8_SB(1, 1), cB + hstep + kstep, voffB);
        PG8_WAIT_V(6); PG8_BAR;
    }
    for (;;) {
        const bool has_next = S.next(ui + 1, nxt);
        const char* nA = has_next ? (const char*)g.A + (size_t)nxt.pm * tstep : cA; const char* nB = has_next ? (const char*)g.Bt + (size_t)nxt.pn * tstep : cB;
        for (int t = 0; t < nt; t += 2) {
            const bool last = (t == nt - 2);
            const char* a1 = cA + (size_t)(t + 1) * kstep;
            const char* a2 = last ? nA : cA + (size_t)(t + 2) * kstep; const char* b2 = last ? nB : cB + (size_t)(t + 2) * kstep;
            const char* a3 = a2 + kstep; const char* b3 = b2 + kstep;
            if (last && has_next) S.a_ready(nxt);
            if constexpr (SP2) {
            PG8_LDB(B0, 0, 0); PG8_LDB(B1, 0, 1); PG8_SCHED; PG8_LDA(At, 0, 0); PG8_STAGE(PG8_SA(1, 1), a1 + hstep, voffA);
            PG8_WAIT_V(8); PG8_WAIT_L(0); PG8_BAR; PG8_MMA(0, 0, At, B0); PG8_MMA(0, 1, At, B1); PG8_BAR; PG8_SCHED;
            PG8_LDA(At, 0, 1); PG8_STAGE(PG8_SB(0, 0), b2, voffB); PG8_STAGE(PG8_SB(0, 1), b2 + hstep, voffB); PG8_STAGE(PG8_SA(0, 0), a2, voffA);
            PG8_WAIT_V(8); PG8_WAIT_L(0); PG8_BAR; PG8_MMA(1, 0, At, B0); PG8_MMA(1, 1, At, B1); PG8_BAR; PG8_SCHED;
            PG8_LDB(B0, 1, 0); PG8_LDB(B1, 1, 1); PG8_SCHED; PG8_LDA(At, 1, 0); PG8_STAGE(PG8_SA(0, 1), a2 + hstep, voffA);
            PG8_WAIT_V(8); PG8_WAIT_L(0); PG8_BAR; PG8_MMA(0, 0, At, B0); PG8_MMA(0, 1, At, B1); PG8_BAR; PG8_SCHED;
            PG8_LDA(At, 1, 1); PG8_STAGE(PG8_SB(1, 0), b3, voffB); PG8_STAGE(PG8_SB(1, 1), b3 + hstep, voffB); PG8_STAGE(PG8_SA(1, 0), a3, voffA);
            PG8_WAIT_V(8); PG8_WAIT_L(0); PG8_BAR; PG8_MMA(1, 0, At, B0); PG8_MMA(1, 1, At, B1); PG8_BAR; PG8_SCHED;
            } else {
            PG8_LDB(B0, 0, 0); PG8_SCHED; PG8_LDA(At, 0, 0); PG8_STAGE(PG8_SA(1, 1), a1 + hstep, voffA);
            PG8_WAIT_L(8); PG8_BAR; PG8_WAIT_L(0); PG8_MMA(0, 0, At, B0); PG8_BAR; PG8_SCHED;
            PG8_LDB(B1, 0, 1); PG8_STAGE(PG8_SB(0, 0), b2, voffB);
            PG8_BAR; PG8_WAIT_L(0); PG8_MMA(0, 1, At, B1); PG8_BAR;
            PG8_LDA(At, 0, 1); PG8_STAGE(PG8_SA(0, 0), a2, voffA);
            PG8_BAR; PG8_WAIT_L(0); PG8_MMA(1, 0, At, B0); PG8_BAR; PG8_SCHED;
            PG8_STAGE(PG8_SB(0, 1), b2 + hstep, voffB);
            PG8_WAIT_V(6); PG8_BAR; PG8_MMA(1, 1, At, B1); PG8_BAR;
            PG8_LDB(B0, 1, 0); PG8_SCHED; PG8_LDA(At, 1, 0); PG8_STAGE(PG8_SA(0, 1), a2 + hstep, voffA);
            PG8_WAIT_L(8); PG8_BAR; PG8_WAIT_L(0); PG8_MMA(0, 0, At, B0); PG8_BAR; PG8_SCHED;
            PG8_LDB(B1, 1, 1); PG8_STAGE(PG8_SB(1, 0), b3, voffB);
            PG8_BAR; PG8_WAIT_L(0); PG8_MMA(0, 1, At, B1); PG8_BAR;
            PG8_LDA(At, 1, 1); PG8_STAGE(PG8_SA(1, 0), a3, voffA);
            PG8_BAR; PG8_WAIT_L(0); PG8_MMA(1, 0, At, B0); PG8_BAR; PG8_SCHED;
            PG8_STAGE(PG8_SB(1, 1), b3 + hstep, voffB);
            PG8_WAIT_V(6); PG8_BAR; PG8_MMA(1, 1, At, B1); PG8_BAR;
            }
        }
        if constexpr (ALIGN_EPI) { if (wr == 0) PG8_BAR; }
        if constexpr (!Epi::AFTER_DRAIN) { E(acc, cur, wr, wc, fr, fq); S.done(cur); }
        if (!has_next) break;
#pragma unroll
        for (int a = 0; a < 2; ++a)
#pragma unroll
            for (int b = 0; b < 2; ++b)
#pragma unroll
                for (int m = 0; m < 4; ++m)
#pragma unroll
                    for (int n = 0; n < 2; ++n) acc[a][b][m][n] = (f32x4){0.f, 0.f, 0.f, 0.f};
        cur = nxt; cA = nA; cB = nB; ++ui;
        if constexpr (ALIGN_EPI) { if (wr == 1) PG8_BAR; }
    }
    PG8_WAIT_V(0);
    if constexpr (!ALIGN_EPI) { if (wr == 0) PG8_BAR; }
    PG8_BAR;
    if constexpr (Epi::AFTER_DRAIN) { E.fused(acc, cur, wr, wc, fr, fq, lds, wid, lane); S.done(cur); }
#undef PG8_SA
#undef PG8_SB
#undef PG8_STAGE
#undef PG8_LDA
#undef PG8_LDB
#undef PG8_MMA
#undef PG8_WAIT_V
#undef PG8_WAIT_L
#undef PG8_BAR
#undef PG8_SCHED
}
}

constexpr int NWAVES = 8;
constexpr int D = 2048, BATCH = 4, SEQ = 2048, DEPTH = 4, HD = 128, FF = 5632;
constexpr int M = BATCH * SEQ;
constexpr int AB_IN = 4608, C_IN = 6144;
constexpr float RMS_EPS = 1e-6f;
constexpr float QK_SCALE = 0.08838834764831845f;

constexpr size_t MiB = 1u << 20;
constexpr size_t WS_CTL = 0, CTL_ZERO_BYTES = 1 * MiB;
constexpr size_t SZ_WGU = (size_t)2 * FF * D * 2, SZ_WD = (size_t)D * FF * 2, SZ_WABIN = (size_t)AB_IN * D * 2, SZ_WOUT = (size_t)D * D * 2, SZ_WCIN = (size_t)C_IN * D * 2;
constexpr size_t WS_WGU = 2 * MiB;
constexpr size_t WS_WD = WS_WGU + 8 * SZ_WGU;
constexpr size_t WS_WABIN = WS_WD + 8 * SZ_WD;
constexpr size_t WS_WABOUT = WS_WABIN + 2 * SZ_WABIN;
constexpr size_t WS_WCIN = WS_WABOUT + 2 * SZ_WOUT;
constexpr size_t WS_WCOUT = WS_WCIN + 2 * SZ_WCIN;
constexpr size_t WS_H = WS_WCOUT + 2 * SZ_WOUT;
constexpr size_t WS_U = WS_H + (size_t)M * D * 2;
constexpr size_t WS_QKV = WS_U + (size_t)M * FF * 2;
constexpr size_t WS_O = WS_QKV + (size_t)M * C_IN * 2;
constexpr size_t WS_END = WS_O + (size_t)M * D * 2;
constexpr int CW_BAR = 4096;

constexpr int RING_OFF = 0, RING_BYTES = 131072;
constexpr int LDSCTL_OFF = RING_BYTES, MISC_OFF = LDSCTL_OFF + 320;
constexpr int LDS_BYTES = 147456;
static_assert(MISC_OFF + 128 <= LDS_BYTES, "LDS map");

#define GAS __attribute__((address_space(1)))
#define LAS __attribute__((address_space(3)))
typedef unsigned short bf16;
typedef unsigned v4u __attribute__((ext_vector_type(4)));
typedef unsigned v2u __attribute__((ext_vector_type(2)));
typedef float f32x4 __attribute__((ext_vector_type(4)));
typedef GAS unsigned gu32;
#define RLX_AGENT __ATOMIC_RELAXED, __HIP_MEMORY_SCOPE_AGENT
#define LDS_WAIT() asm volatile("s_waitcnt lgkmcnt(0)" ::: "memory")
#define VM_WAIT() asm volatile("s_waitcnt vmcnt(0)" ::: "memory")
__device__ __forceinline__ unsigned f2bf(float f) { unsigned u = __builtin_bit_cast(unsigned, f); return (u + 0x7fffu + ((u >> 16) & 1u)) >> 16; }
__device__ __forceinline__ unsigned pk2(float lo, float hi) { return f2bf(lo) | (f2bf(hi) << 16); }
__device__ __forceinline__ float bflo(unsigned w) { return __builtin_bit_cast(float, w << 16); }
__device__ __forceinline__ float bfhi(unsigned w) { return __builtin_bit_cast(float, w & 0xffff0000u); }

#define XB_TMO      128
#define XB_XCNT(j)  (256  + 64 * (j))
#define XB_XSUB(j)  (1280 + 64 * (j))
#define XB_XGEN(j)  (2304 + 64 * (j))
#define XB_TOP      3328
#define XB_TOPGEN   3392
#define XCD_BAR_WORDS 3456
#define XB_SPIN_CAP (1u << 18)

__device__ __forceinline__ unsigned xb_ld(unsigned* p)              { return __hip_atomic_load(p, __ATOMIC_RELAXED, __HIP_MEMORY_SCOPE_AGENT); }
__device__ __forceinline__ unsigned xb_add(unsigned* p, unsigned v) { return __hip_atomic_fetch_add(p, v, __ATOMIC_RELAXED, __HIP_MEMORY_SCOPE_AGENT); }
__device__ __forceinline__ unsigned xb_xcc_id() { return (unsigned)__builtin_amdgcn_s_getreg((3 << 11) | 20) & 0xFu; }
#define XB_SPIN(cond, bar) do { unsigned _sp = 0; while (cond) { __builtin_amdgcn_s_sleep(1); \
    if ((++_sp & 255u) == 0u) { if (xb_ld(&(bar)[XB_TMO])) break; if (_sp > XB_SPIN_CAP) { atomicAdd(&(bar)[XB_TMO], 1u); break; } } } } while (0)

struct XcdBarrier {
    unsigned* bar; unsigned x;
    volatile LAS unsigned* st;
};

__device__ __forceinline__ XcdBarrier xcd_barrier_post(unsigned* bar, volatile LAS unsigned* st) {
    XcdBarrier b; b.bar = bar; b.x = xb_xcc_id(); b.st = st;
    if (threadIdx.x == 0) (void)xb_add(&bar[XB_XCNT(b.x)], 1u);
    return b;
}
__device__ __forceinline__ void xcd_barrier_complete(unsigned* bar, unsigned x, unsigned& nloc, unsigned& nx) {
    const unsigned G = gridDim.x * gridDim.y * gridDim.z;
    unsigned sum, cnt, mine, sp = 0u;
    for (;;) {
        sum = 0u; cnt = 0u; mine = 0u;
#pragma unroll
        for (unsigned j = 0; j < 16; ++j) { const unsigned c = xb_ld(&bar[XB_XCNT(j)]); sum += c; cnt += (c > 0u) ? 1u : 0u; mine = (j == x) ? c : mine; }
        if (sum == G) break;
        __builtin_amdgcn_s_sleep(1);
        if ((++sp & 255u) == 0u) { if (xb_ld(&bar[XB_TMO])) break; if (sp > XB_SPIN_CAP) { atomicAdd(&bar[XB_TMO], 1u); break; } }
    }
    nloc = mine > 0u ? mine : 1u; nx = cnt > 0u ? cnt : 1u;
}

__device__ __forceinline__ void xcd_barrier(const XcdBarrier& b) {
    asm volatile("s_waitcnt vmcnt(0)" ::: "memory");
    __syncthreads();
    if (threadIdx.x == 0) {
        unsigned* bar = b.bar;
        __builtin_amdgcn_s_waitcnt(0);
        unsigned nloc = b.st[0], nx = b.st[1];
        if (nloc == 0u) { xcd_barrier_complete(bar, b.x, nloc, nx); b.st[0] = nloc; b.st[1] = nx; }
        const unsigned old = xb_add(&bar[XB_XSUB(b.x)], 1u);
        const unsigned gen = old / nloc;
        if (old + 1u == (gen + 1u) * nloc) {
            __builtin_amdgcn_fence(__ATOMIC_RELEASE, "agent");
            asm volatile("s_waitcnt vmcnt(0)" ::: "memory");
            const unsigned og = xb_add(&bar[XB_TOP], 1u);
            const unsigned tg = og / nx;
            if (og + 1u == (tg + 1u) * nx) xb_add(&bar[XB_TOPGEN], 1u);
            else XB_SPIN(xb_ld(&bar[XB_TOPGEN]) == tg, bar);
            __builtin_amdgcn_fence(__ATOMIC_ACQUIRE, "agent");
            xb_add(&bar[XB_XGEN(b.x)], 1u);
            asm volatile("s_waitcnt vmcnt(0)" ::: "memory");
        } else {
            XB_SPIN(xb_ld(&bar[XB_XGEN(b.x)]) == gen, bar);
            __builtin_amdgcn_fence(__ATOMIC_ACQUIRE, "agent");
            asm volatile("s_waitcnt vmcnt(0)" ::: "memory");
        }
    }
    __syncthreads();
}

struct Frame {
    LAS unsigned char* lds;
    int tid, lane, wave;
    int G;
};
__device__ __forceinline__ float wave_sum(float v) {
#pragma unroll
    for (int o = 1; o < 64; o <<= 1) v += __shfl_xor(v, o);
    return v;
}
__device__ __forceinline__ float wave_max(float v) {
#pragma unroll
    for (int o = 1; o < 64; o <<= 1) v = fmaxf(v, __shfl_xor(v, o));
    return v;
}
__device__ __forceinline__ void p0_transpose_item(const float* W, int K, int N, bf16* WT, int k0, int n0, int drow0, LAS float* scr, int lane) {
#pragma unroll 8
    for (int i = 0; i < 32; ++i) { const int kk = 2 * i + (lane >> 5); scr[kk * 33 + (lane & 31)] = W[(size_t)(k0 + kk) * N + n0 + (lane & 31)]; }
    LDS_WAIT(); asm volatile("" ::: "memory");
    const int c = lane & 7;
#pragma unroll
    for (int j = 0; j < 4; ++j) { const int n = (lane >> 3) + 8 * j; const LAS float* s = scr + (8 * c) * 33 + n;
        v4u o; o.x = pk2(s[0 * 33], s[1 * 33]); o.y = pk2(s[2 * 33], s[3 * 33]); o.z = pk2(s[4 * 33], s[5 * 33]); o.w = pk2(s[6 * 33], s[7 * 33]);
        *(GAS v4u*)(WT + (size_t)(drow0 + n) * K + k0 + 8 * c) = o; }
    LDS_WAIT(); asm volatile("" ::: "memory");
}
struct Args {
    const float* x; const float* ffn_norm; const float* wg; const float* wu; const float* wd; const float* mix_norm;
    const float* ab_in; const float* ab_out; const float* ab_sink; const float* c_in; const float* c_out; const float* c_rpb; const float* final_norm;
    float* out; unsigned char* ws; int ph_lo, ph_hi;
};
static_assert(sizeof(Args) == 15 * 8 + 8, "Args has no padding");

__device__ __forceinline__ void p0_prologue(const Frame& F, const Args& a) {
    LAS float* scr = (LAS float*)(F.lds + RING_OFF + F.wave * 16384);
    const int gw = blockIdx.x * NWAVES + F.wave, NGW = F.G * NWAVES;
    int lane = F.lane; asm volatile("" : "+v"(lane));
    constexpr int I_GU = (D / 64) * (FF / 32);
    constexpr int I_D = (FF / 64) * (D / 32);
    constexpr int I_ABIN = (D / 64) * (AB_IN / 32);
    constexpr int I_OUT = (D / 64) * (D / 32);
    constexpr int I_CIN = (D / 64) * (C_IN / 32);
    constexpr int T0 = 16 * I_GU, T1 = T0 + 8 * I_D, T2 = T1 + 2 * I_ABIN, T3 = T2 + 2 * I_OUT, T4 = T3 + 2 * I_CIN, T5 = T4 + 2 * I_OUT;
    for (int it = gw; it < T5; it += NGW) {
        if (it < T0) { const int mat = it / I_GU, r = it % I_GU, lf = mat >> 1, up = mat & 1; const int nblk = FF / 32, kb = r / nblk, nb = r % nblk, n0 = 32 * nb;
            p0_transpose_item((up ? a.wu : a.wg) + (size_t)lf * D * FF, D, FF, (bf16*)(a.ws + WS_WGU + (size_t)lf * SZ_WGU), 64 * kb, n0, (n0 >> 7) * 256 + (n0 & 127) + up * 128, scr, lane); }
        else if (it < T1) { const int q = it - T0, lf = q / I_D, r = q % I_D; const int nblk = D / 32, kb = r / nblk, nb = r % nblk, n0 = 32 * nb;
            p0_transpose_item(a.wd + (size_t)lf * FF * D, FF, D, (bf16*)(a.ws + WS_WD + (size_t)lf * SZ_WD), 64 * kb, n0, n0, scr, lane); }
        else if (it < T2) { const int q = it - T1, i = q / I_ABIN, r = q % I_ABIN; const int nblk = AB_IN / 32, kb = r / nblk, nb = r % nblk, n0 = 32 * nb;
            p0_transpose_item(a.ab_in + (size_t)i * D * AB_IN, D, AB_IN, (bf16*)(a.ws + WS_WABIN + (size_t)i * SZ_WABIN), 64 * kb, n0, n0, scr, lane); }
        else if (it < T3) { const int q = it - T2, i = q / I_OUT, r = q % I_OUT; const int nblk = D / 32, kb = r / nblk, nb = r % nblk, n0 = 32 * nb;
            p0_transpose_item(a.ab_out + (size_t)i * D * D, D, D, (bf16*)(a.ws + WS_WABOUT + (size_t)i * SZ_WOUT), 64 * kb, n0, n0, scr, lane); }
        else if (it < T4) { const int q = it - T3, i = q / I_CIN, r = q % I_CIN; const int nblk = C_IN / 32, kb = r / nblk, nb = r % nblk, n0 = 32 * nb;
            p0_transpose_item(a.c_in + (size_t)i * D * C_IN, D, C_IN, (bf16*)(a.ws + WS_WCIN + (size_t)i * SZ_WCIN), 64 * kb, n0, n0, scr, lane); }
        else { const int q = it - T4, i = q / I_OUT, r = q % I_OUT; const int nblk = D / 32, kb = r / nblk, nb = r % nblk, n0 = 32 * nb;
            p0_transpose_item(a.c_out + (size_t)i * D * D, D, D, (bf16*)(a.ws + WS_WCOUT + (size_t)i * SZ_WOUT), 64 * kb, n0, n0, scr, lane); }
    }
}
template <bool OUT_F32>
__device__ __forceinline__ void rmsnorm_phase(const Frame& F, const float* x, const float* g, void* outp) {
    const int gw = blockIdx.x * NWAVES + F.wave, NGW = F.G * NWAVES;
    int lane = F.lane; asm volatile("" : "+v"(lane));
    for (int m = gw; m < M; m += NGW) {
        const GAS f32x4* xr = (const GAS f32x4*)(x + (size_t)m * D) + lane;
        f32x4 v[8]; float s = 0.f;
#pragma unroll
        for (int j = 0; j < 8; ++j) { v[j] = xr[64 * j]; s += (v[j].x * v[j].x + v[j].y * v[j].y) + (v[j].z * v[j].z + v[j].w * v[j].w); }
        const float rstd = 1.0f / sqrtf(wave_sum(s) * (1.f / D) + RMS_EPS);
        const GAS f32x4* gr = (const GAS f32x4*)g + lane;
#pragma unroll
        for (int j = 0; j < 8; ++j) { const f32x4 gg = gr[64 * j]; const f32x4 y = v[j] * rstd * gg;
            if (OUT_F32) { ((GAS f32x4*)((float*)outp + (size_t)m * D) + lane)[64 * j] = y; }
            else { v2u w; w.x = pk2(y.x, y.y); w.y = pk2(y.z, y.w); ((GAS v2u*)((bf16*)outp + (size_t)m * D) + lane)[64 * j] = w; } }
    }
}
template <int MODE>
__device__ __forceinline__ void attn_naive(const Frame& F, const bf16* QKV, int ld, bf16* O, const float* extra) {
    LAS float* qs = (LAS float*)(F.lds + RING_OFF + F.wave * 1024);
    const int gw = blockIdx.x * NWAVES + F.wave, NGW = F.G * NWAVES; int lane = F.lane; asm volatile("" : "+v"(lane));
    constexpr int NH = (MODE == 2) ? 16 : 8;
    constexpr int NKEYS = (MODE == 0) ? 387 : (MODE == 1) ? 257 : 128;
    for (int it = gw; it < M * NH; it += NGW) {
        const int tok = it / NH, h = it % NH, b = tok / SEQ, s = tok % SEQ;
        int qcol, kcol, vcol, ocol;
        if (MODE == 0) { qcol = h * HD; kcol = 1024 + h * HD; vcol = 2048 + h * HD; ocol = h * HD; }
        else if (MODE == 1) { qcol = 3072 + h * HD; kcol = 4096 + (h >> 2) * HD; vcol = 4352 + (h >> 2) * HD; ocol = 1024 + h * HD; }
        else { qcol = h * HD; kcol = 2048 + h * HD; vcol = 4096 + h * HD; ocol = h * HD; }
        const float slope = exp2f(-(float)(h + 1));
        { const unsigned qq = ((const unsigned*)(QKV + (size_t)tok * ld + qcol))[lane];
          qs[2 * lane] = bflo(qq) * QK_SCALE; qs[2 * lane + 1] = bfhi(qq) * QK_SCALE; }
        LDS_WAIT(); asm volatile("" ::: "memory");
        float mrun = -1e30f, lrun = 0.f, o0 = 0.f, o1 = 0.f;
        for (int c0 = 0; c0 < NKEYS; c0 += 64) {
            const int idx = c0 + lane; bool valid = idx < NKEYS; int sk = s; float bias = 0.f;
            if (MODE == 0) { const int p = idx / 129, kk = idx % 129; const int r = (p == 0) ? 1 : (p == 1) ? 4 : 16; const int L = SEQ / r, j = s % r, lq = s / r, lk = lq - 64 + kk;
                valid = valid && lk >= 0 && lk < L; sk = lk * r + j; bias = -slope * fabsf((float)(s - sk)); }
            else if (MODE == 1) { sk = s - 128 + idx; valid = valid && sk >= 0 && sk < SEQ; bias = -slope * fabsf((float)(s - sk)); }
            else { const int qrow = s >> 6, qc = s & 63; int rs = qrow - 4; rs = rs < 0 ? 0 : (rs > 24 ? 24 : rs); int cs = qc - 8; cs = cs < 0 ? 0 : (cs > 48 ? 48 : cs);
                const int kr = rs + (idx >> 4), kc = cs + (idx & 15); sk = kr * 64 + kc; if (valid) bias = extra[h * 15 * 31 + (kr - qrow + 7) * 31 + (kc - qc + 15)]; }
            if (!valid) sk = s;
            const int tk = b * SEQ + sk;
            const v4u* kp = (const v4u*)(QKV + (size_t)tk * ld + kcol);
            float acc = 0.f;
#pragma unroll
            for (int c = 0; c < 16; ++c) { const v4u kv = kp[c]; const f32x4 qa = *(const LAS f32x4*)(qs + 8 * c), qb = *(const LAS f32x4*)(qs + 8 * c + 4);
                acc += qa.x * bflo(kv.x) + qa.y * bfhi(kv.x) + qa.z * bflo(kv.y) + qa.w * bfhi(kv.y) + qb.x * bflo(kv.z) + qb.y * bfhi(kv.z) + qb.z * bflo(kv.w) + qb.w * bfhi(kv.w); }
            const float sc = valid ? acc + bias : -1e30f;
            const float mn = fmaxf(mrun, wave_max(sc)); const float alpha = __expf(mrun - mn); const float p = valid ? __expf(sc - mn) : 0.f;
            lrun = lrun * alpha + wave_sum(p); o0 *= alpha; o1 *= alpha; mrun = mn;
            for (int t = 0; t < 64; ++t) { const float pt = __builtin_bit_cast(float, __builtin_amdgcn_readlane(__builtin_bit_cast(int, p), t)); const int tt = __builtin_amdgcn_readlane(tk, t);
                const unsigned vv = ((const unsigned*)(QKV + (size_t)tt * ld + vcol))[lane]; o0 += pt * bflo(vv); o1 += pt * bfhi(vv); }
        }
        if (MODE == 1) { const float sk_ = extra[h]; const float mn = fmaxf(mrun, sk_); const float a = __expf(mrun - mn); lrun = lrun * a + __expf(sk_ - mn); o0 *= a; o1 *= a; }
        const float inv = 1.0f / lrun;
        ((unsigned*)(O + (size_t)tok * D + ocol))[lane] = pk2(o0 * inv, o1 * inv);
        LDS_WAIT(); asm volatile("" ::: "memory");
    }
}

constexpr int NPH = 1 + DEPTH * 10 + 1;
__global__ void __launch_bounds__(NWAVES * 64, 2) fwd(Args a) {
    extern __shared__ __attribute__((aligned(16))) unsigned char lds[];
    Frame F;
    F.lds = (LAS unsigned char*)lds;
    F.tid = threadIdx.x; F.lane = F.tid & 63; F.wave = __builtin_amdgcn_readfirstlane(F.tid >> 6);
    F.G = gridDim.x;
    for (int u = F.tid; u < (LDS_BYTES - LDSCTL_OFF) / 4; u += NWAVES * 64) ((LAS unsigned*)(F.lds + LDSCTL_OFF))[u] = 0u;
    __syncthreads();
#if !MK_MULTI
    XcdBarrier bar = xcd_barrier_post((unsigned*)(a.ws + WS_CTL) + CW_BAR, (volatile LAS unsigned*)(F.lds + MISC_OFF) + 8);
#define SEAM() xcd_barrier(bar)
#else
#define SEAM() do { } while (0)
#endif
    const int lo = a.ph_lo, hi = a.ph_hi;
#define IN(k) (lo <= (k) && (k) < hi)
    bf16* const Hb = (bf16*)(a.ws + WS_H); bf16* const Ub = (bf16*)(a.ws + WS_U); bf16* const QKVb = (bf16*)(a.ws + WS_QKV); bf16* const Ob = (bf16*)(a.ws + WS_O);
    int ph = 0;
    if (IN(ph)) p0_prologue(F, a);
    SEAM(); ++ph;
    for (int layer = 0; layer < DEPTH; ++layer) {
        const bool even = (layer & 1) == 0; const int li = layer >> 1;
        for (int sub = 0; sub < 3; ++sub) {
            const float* xin = (layer == 0 && sub == 0) ? a.x : (const float*)a.out;
            const int lf = layer * 2 + (sub == 2 ? 1 : 0);
            if (IN(ph)) rmsnorm_phase<false>(F, xin, sub == 1 ? a.mix_norm + (size_t)layer * D : a.ffn_norm + (size_t)lf * D, Hb);
            SEAM(); ++ph;
            if (IN(ph)) {
                if (sub == 1) {
                    const int N1 = even ? AB_IN : C_IN;
                    const bf16* W = even ? (const bf16*)(a.ws + WS_WABIN + (size_t)li * SZ_WABIN) : (const bf16*)(a.ws + WS_WCIN + (size_t)li * SZ_WCIN);
                    pg8::Gemm g{Hb, W, M, N1, D}; pg8::StaticOrder S; S.init(M, N1, F.G, (int)blockIdx.x);
                    pg8::EpiBf16 E{QKVb, N1};
                    pg8::gemm_phase<pg8::EpiBf16, pg8::StaticOrder, true, true>(F.lds + RING_OFF, g, S, E);
                } else {
                    pg8::Gemm g{Hb, (const bf16*)(a.ws + WS_WGU + (size_t)lf * SZ_WGU), M, 2 * FF, D}; pg8::StaticOrder S; S.init(M, 2 * FF, F.G, (int)blockIdx.x);
                    pg8::EpiSwiglu E{Ub, FF};
                    pg8::gemm_phase<pg8::EpiSwiglu, pg8::StaticOrder, true, true>(F.lds + RING_OFF, g, S, E);
                }
            }
            SEAM(); ++ph;
            if (sub == 1) {
                if (IN(ph)) {
                    if (even) { attn_naive<0>(F, QKVb, AB_IN, Ob, nullptr); attn_naive<1>(F, QKVb, AB_IN, Ob, a.ab_sink + li * 8); }
                    else attn_naive<2>(F, QKVb, C_IN, Ob, a.c_rpb + (size_t)li * 16 * 15 * 31);
                }
                SEAM(); ++ph;
            }
            if (IN(ph)) {
                const bf16* A2 = (sub == 1) ? Ob : Ub; const int K2 = (sub == 1) ? D : FF;
                const bf16* W2 = (sub == 1) ? (even ? (const bf16*)(a.ws + WS_WABOUT + (size_t)li * SZ_WOUT) : (const bf16*)(a.ws + WS_WCOUT + (size_t)li * SZ_WOUT))
                                            : (const bf16*)(a.ws + WS_WD + (size_t)lf * SZ_WD);
                pg8::Gemm g{A2, W2, M, D, K2}; pg8::StaticOrder S; S.init(M, D, F.G, (int)blockIdx.x);
                pg8::EpiResid E{xin, a.out, D, (sub == 1) ? 1.0f : 0.5f};
                pg8::gemm_phase<pg8::EpiResid, pg8::StaticOrder, true, true>(F.lds + RING_OFF, g, S, E);
            }
            SEAM(); ++ph;
        }
    }
    if (IN(ph)) rmsnorm_phase<true>(F, a.out, a.final_norm, a.out);
#undef IN
#undef SEAM
}

extern "C" void kernel_launch(void* const* d_in, const int* in_sizes, int n_in, void* d_out, int out_size, void* d_ws, size_t ws_size, hipStream_t stream) {
    static int grid = 0;
    if (grid == 0) {
        if (n_in != 13 || in_sizes[0] != M * D || out_size != M * D || ws_size < WS_END) { fprintf(stderr, "kernel_launch: unexpected shapes (n_in %d, in0 %d, out %d, ws %zu, need %zu); nothing launched\n", n_in, n_in > 0 ? in_sizes[0] : -1, out_size, ws_size, (size_t)WS_END); grid = -1; return; }
        int dev = 0, cus = 0, per_cu = 0;
        if (hipGetDevice(&dev) != hipSuccess || hipDeviceGetAttribute(&cus, hipDeviceAttributeMultiprocessorCount, dev) != hipSuccess) { fprintf(stderr, "kernel_launch: device query failed\n"); grid = -1; return; }
        if (hipFuncSetAttribute((const void*)fwd, hipFuncAttributeMaxDynamicSharedMemorySize, LDS_BYTES) != hipSuccess) { fprintf(stderr, "kernel_launch: hipFuncSetAttribute failed\n"); grid = -1; return; }
        if (hipOccupancyMaxActiveBlocksPerMultiprocessor(&per_cu, (const void*)fwd, NWAVES * 64, LDS_BYTES) != hipSuccess || per_cu < 1)
            fprintf(stderr, "kernel_launch: note: occupancy query reports %d workgroups per CU\n", per_cu);
        (void)hipGetLastError();
        grid = cus;
    }
    if (grid < 0) return;
    if (hipMemsetAsync((char*)d_ws + WS_CTL, 0, CTL_ZERO_BYTES, stream) != hipSuccess) { fprintf(stderr, "kernel_launch: memset failed\n"); return; }
    Args a{};
    a.x = (const float*)d_in[0]; a.ffn_norm = (const float*)d_in[1]; a.wg = (const float*)d_in[2]; a.wu = (const float*)d_in[3]; a.wd = (const float*)d_in[4]; a.mix_norm = (const float*)d_in[5];
    a.ab_in = (const float*)d_in[6]; a.ab_out = (const float*)d_in[7]; a.ab_sink = (const float*)d_in[8]; a.c_in = (const float*)d_in[9]; a.c_out = (const float*)d_in[10]; a.c_rpb = (const float*)d_in[11];
    a.final_norm = (const float*)d_in[12]; a.out = (float*)d_out; a.ws = (unsigned char*)d_ws;
#if MK_MULTI
    for (int ph = 0; ph < NPH; ++ph) { a.ph_lo = ph; a.ph_hi = ph + 1; hipLaunchKernelGGL(fwd, dim3(grid), dim3(NWAVES * 64), LDS_BYTES, stream, a); }
#else
    a.ph_lo = 0; a.ph_hi = NPH; hipLaunchKernelGGL(fwd, dim3(grid), dim3(NWAVES * 64), LDS_BYTES, stream, a);
#endif
    const hipError_t le = hipPeekAtLastError();
    if (le != hipSuccess) fprintf(stderr, "kernel_launch: launch failed: %s\n", hipGetErrorName(le));
}
```

```cpp
#include <hip/hip_runtime.h>
#include <cstdio>
#include <cstdint>

#ifndef PROBE_ABL
#define PROBE_ABL 0
#endif
#ifndef RESID_F16
#define RESID_F16 1
#endif

namespace pg8 {
#define PG8_LAS __attribute__((address_space(3)))
typedef unsigned short bf16_t;
typedef short bf16x8 __attribute__((ext_vector_type(8)));
typedef _Float16 f16x8 __attribute__((ext_vector_type(8)));
typedef _Float16 f16x4 __attribute__((ext_vector_type(4)));
typedef float f32x4 __attribute__((ext_vector_type(4)));
typedef unsigned u32x4 __attribute__((ext_vector_type(4)));
constexpr int BM = 256, BK = 64, HALF = 128, HTB = HALF * BK * 2  , STAGE_BYTES = 8 * HTB, NXCD = 8, WGM = 8;

__host__ __device__ __forceinline__ int lds_byte(int r, int c) { const int st = (r >> 4) * 2 + (c >> 5), rr = r & 15, cc = c & 31, ob = rr * 64 + cc * 2; return st * 1024 + (ob ^ (((ob >> 9) & 1) << 5)); }
__host__ __device__ __forceinline__ void stage_rc(int b, int& R, int& C) { const int st = b / 1024, sb = b % 1024, swz = sb ^ (((sb >> 9) & 1) << 5); R = (st >> 1) * 16 + swz / 64; C = (st & 1) * 32 + (swz % 64) / 2; }
__host__ __device__ __forceinline__ int perm32(int rho) { const int n = rho >> 4, i = rho & 15; return 8 * (i >> 2) + 4 * n + (i & 3); }

struct Unit { int pm, pn; };
struct Gemm { const bf16_t* A; const bf16_t* Bt; int M, N, K; };

struct StaticOrder {
    int nM, nN, nwg, G, c;
    __host__ __device__ void init(int M, int N, int G_, int c_) { nM = M / BM; nN = N / BM; nwg = nM * nN; G = G_; c = c_; }
    __host__ __device__ bool next(int i, Unit& u) const {
        const long L = (long)i * G + c; if (L >= nwg) return false;
        int wgid = (int)L; { const int q = nwg / NXCD, r = nwg % NXCD, xcd = wgid % NXCD, off = wgid / NXCD; wgid = (xcd < r ? xcd * (q + 1) : r * (q + 1) + (xcd - r) * q) + off; }
        const int nig = WGM * nN, gid = wgid / nig, fm = gid * WGM, gsz = (nM - fm) < WGM ? (nM - fm) : WGM;
        u.pm = fm + ((wgid % nig) % gsz); u.pn = (wgid % nig) / gsz; return true;
    }
    __device__ __forceinline__ void a_ready(const Unit&) const {}
    __device__ __forceinline__ void done(const Unit&) const {}
};


__device__ __forceinline__ unsigned cvt_pk_bf16(float lo, float hi) { unsigned r; asm volatile("v_cvt_pk_bf16_f32 %0, %1, %2" : "=v"(r) : "v"(lo), "v"(hi)); return r; }

__device__ __forceinline__ int lane_id_here() { int l; asm volatile("v_mbcnt_lo_u32_b32 %0, -1, 0\n\tv_mbcnt_hi_u32_b32 %0, -1, %0" : "=v"(l)); return l; }
__device__ __forceinline__ float xor_shfl(float v, int mask, int lane) { return __builtin_bit_cast(float, __builtin_amdgcn_ds_bpermute((lane ^ mask) << 2, __builtin_bit_cast(int, v))); }
typedef unsigned long long ssq_t;
__device__ __forceinline__ ssq_t ssq_fix(float s) { const int hi = (int)s; const int lo = (int)((s - (float)hi) * 16777216.0f); return ((ssq_t)(unsigned)hi << 24) + (ssq_t)(unsigned)lo; }
__device__ __forceinline__ float ssq_val(ssq_t v) { return (float)(unsigned)(v >> 24) + (float)(unsigned)(v & 0xFFFFFFull) * (1.0f / 16777216.0f); }
__device__ __forceinline__ float row_rstd(const ssq_t* ssq, int row) { return 1.0f / sqrtf(ssq_val(ssq[row]) * (1.0f / 2048.0f) + 1e-6f); }
struct PreSsq { ssq_t v[2][4]; };
__device__ __forceinline__ void pre_ssq_issue(PreSsq& p, const ssq_t* ssq, int row0) {
    typedef __attribute__((address_space(1))) const ssq_t gssq_t;
    gssq_t* a = (gssq_t*)ssq + row0;
    asm volatile("global_load_dwordx2 %0, %1, off" : "=v"(p.v[0][0]) : "v"(a));
    asm volatile("global_load_dwordx2 %0, %1, off offset:128" : "=v"(p.v[0][1]) : "v"(a));
    asm volatile("global_load_dwordx2 %0, %1, off offset:256" : "=v"(p.v[0][2]) : "v"(a));
    asm volatile("global_load_dwordx2 %0, %1, off offset:384" : "=v"(p.v[0][3]) : "v"(a));
    asm volatile("global_load_dwordx2 %0, %1, off offset:1024" : "=v"(p.v[1][0]) : "v"(a));
    asm volatile("global_load_dwordx2 %0, %1, off offset:1152" : "=v"(p.v[1][1]) : "v"(a));
    asm volatile("global_load_dwordx2 %0, %1, off offset:1280" : "=v"(p.v[1][2]) : "v"(a));
    asm volatile("global_load_dwordx2 %0, %1, off offset:1408" : "=v"(p.v[1][3]) : "v"(a));
}
__device__ __forceinline__ void pre_ssq_wait(PreSsq& p) {
    asm volatile("s_waitcnt vmcnt(16)" : "+v"(p.v[0][0]), "+v"(p.v[0][1]), "+v"(p.v[0][2]), "+v"(p.v[0][3]), "+v"(p.v[1][0]), "+v"(p.v[1][1]), "+v"(p.v[1][2]), "+v"(p.v[1][3]) :: "memory");
}
__device__ __forceinline__ void rows_rstd(const PreSsq& p, float (&rs)[2][4]) {
#pragma unroll
    for (int ai = 0; ai < 2; ++ai)
#pragma unroll
        for (int m = 0; m < 4; ++m) rs[ai][m] = __builtin_amdgcn_rsqf(ssq_val(p.v[ai][m]) * (1.0f / 2048.0f) + 1e-6f);
}
typedef __attribute__((address_space(1))) u32x4 gu32x4;
struct EpiBf16 {
    static constexpr bool PERM = true, AFTER_DRAIN = false, HAS_INIT = false, HAS_PRE = true;
    typedef PreSsq Pre;
    bf16_t* O; int ldc; const ssq_t* ssq;
    __device__ __forceinline__ void pre_issue(Pre& p, const Unit& u, int wr, int wc, int fr, int fq) const { pre_ssq_issue(p, ssq, u.pm * BM + wr * 64 + fr); }
    __device__ __forceinline__ void pre_wait(Pre& p) const { pre_ssq_wait(p); }
    __device__ __forceinline__ void operator()(const f32x4 (&acc)[2][2][4][2], const Unit& u, int wr, int wc, int fr, int fq, const Pre& pre) const {
        const int row0 = u.pm * BM + wr * 64 + fr; const int col0 = u.pn * BM + wc * 32 + 8 * fq;
        float rsv[2][4]; rows_rstd(pre, rsv);
#pragma unroll
        for (int ai = 0; ai < 2; ++ai)
#pragma unroll
            for (int m = 0; m < 4; ++m) { const int row = row0 + ai * HALF + m * 16; const float rs = rsv[ai][m]; bf16_t* rowp = O + (size_t)row * ldc + col0;
#pragma unroll
                for (int bj = 0; bj < 2; ++bj) { const f32x4 v0 = acc[ai][bj][m][0] * rs, v1 = acc[ai][bj][m][1] * rs;
                    u32x4 w; w.x = cvt_pk_bf16(v0[0], v0[1]); w.y = cvt_pk_bf16(v0[2], v0[3]); w.z = cvt_pk_bf16(v1[0], v1[1]); w.w = cvt_pk_bf16(v1[2], v1[3]);
                    *(gu32x4*)(rowp + bj * HALF) = w; } }
    }
};
struct EpiSwiglu {
    static constexpr bool PERM = true, AFTER_DRAIN = false, HAS_INIT = false, HAS_PRE = true;
    typedef PreSsq Pre;
    bf16_t* O; int ldc; const ssq_t* ssq;
    __device__ __forceinline__ void pre_issue(Pre& p, const Unit& u, int wr, int wc, int fr, int fq) const { pre_ssq_issue(p, ssq, u.pm * BM + wr * 64 + fr); }
    __device__ __forceinline__ void pre_wait(Pre& p) const { pre_ssq_wait(p); }
    __device__ __forceinline__ void operator()(const f32x4 (&acc)[2][2][4][2], const Unit& u, int wr, int wc, int fr, int fq, const Pre& pre) const {
        const int row0 = u.pm * BM + wr * 64 + fr; const int col0 = u.pn * HALF + wc * 32 + 8 * fq;
        float rsv[2][4]; rows_rstd(pre, rsv);
#pragma unroll
        for (int ai = 0; ai < 2; ++ai)
#pragma unroll
            for (int m = 0; m < 4; ++m) { const int row = row0 + ai * HALF + m * 16; const float rs = rsv[ai][m]; bf16_t* rowp = O + (size_t)row * ldc + col0;
                float r[8];
#pragma unroll
                for (int n = 0; n < 2; ++n)
#pragma unroll
                    for (int j = 0; j < 4; ++j) { const float g = acc[ai][0][m][n][j] * rs, up = acc[ai][1][m][n][j] * rs;
                        r[n * 4 + j] = g * __builtin_amdgcn_rcpf(1.0f + __expf(-g)) * up; }
                u32x4 w; w.x = cvt_pk_bf16(r[0], r[1]); w.y = cvt_pk_bf16(r[2], r[3]); w.z = cvt_pk_bf16(r[4], r[5]); w.w = cvt_pk_bf16(r[6], r[7]);
                *(gu32x4*)rowp = w; }
    }
};
struct EpiResidH {
    static constexpr bool PERM = true, AFTER_DRAIN = false, HAS_INIT = false, HAS_PRE = true;
    struct Pre { f16x8 t[2][2]; };
    const bf16_t* xin; int ldc; float scale; bf16_t* xb; ssq_t* ssq_out;
    __device__ __forceinline__ unsigned lane_off(const Unit& u, int wr, int wc, int fr, int fq) const { return (unsigned)(((u.pm * BM + wr * 64 + fr) * ldc + u.pn * BM + wc * 32 + 8 * fq) * 2); }
    __device__ __forceinline__ void issue_batch(f16x8 (&t)[2][2], unsigned voff, int ai, int mp) const {
        const char* xr = (const char*)xin; asm volatile("" : "+s"(xr));
#pragma unroll
        for (int mm = 0; mm < 2; ++mm) { const char* sb = xr + (size_t)((ai * HALF + (2 * mp + mm) * 16) * ldc) * 2;
            asm volatile("global_load_dwordx4 %0, %1, %2" : "=v"(t[mm][0]) : "v"(voff), "s"(sb));
            asm volatile("global_load_dwordx4 %0, %1, %2 offset:256" : "=v"(t[mm][1]) : "v"(voff), "s"(sb)); }
    }
    __device__ __forceinline__ void pre_issue(Pre& p, const Unit& u, int wr, int wc, int fr, int fq) const { issue_batch(p.t, lane_off(u, wr, wc, fr, fq), 0, 0); }
    __device__ __forceinline__ void pre_wait(Pre& p) const { asm volatile("s_waitcnt vmcnt(16)" : "+v"(p.t[0][0]), "+v"(p.t[0][1]), "+v"(p.t[1][0]), "+v"(p.t[1][1]) :: "memory"); }
    __device__ __forceinline__ void batch(f32x4 (&acc)[2][2][4][2], const f16x8 (&t)[2][2], int ai, int mp, int row0, int col0, int fq, ssq_t (&olds)[8], float sc, bf16_t* xb, ssq_t* ssq_out) const {
        typedef __attribute__((address_space(1))) f16x8 gf16x8;
#pragma unroll
        for (int mm = 0; mm < 2; ++mm) { const int m = 2 * mp + mm, row = row0 + ai * HALF + m * 16; const size_t off = (size_t)row * ldc + col0; float s = 0.f;
#pragma unroll
            for (int bj = 0; bj < 2; ++bj) { const f16x8 b8 = t[mm][bj];
                const f32x4 y0 = __builtin_convertvector(__builtin_shufflevector(b8, b8, 0, 1, 2, 3), f32x4) + acc[ai][bj][m][0] * sc, y1 = __builtin_convertvector(__builtin_shufflevector(b8, b8, 4, 5, 6, 7), f32x4) + acc[ai][bj][m][1] * sc;
                const f16x4 h0 = __builtin_convertvector(y0, f16x4), h1 = __builtin_convertvector(y1, f16x4);
                *(gf16x8*)(xb + off + bj * HALF) = __builtin_shufflevector(h0, h1, 0, 1, 2, 3, 4, 5, 6, 7);
                const f32x4 z0 = __builtin_convertvector(h0, f32x4), z1 = __builtin_convertvector(h1, f32x4);
                s += ((z0[0] * z0[0] + z0[1] * z0[1]) + (z0[2] * z0[2] + z0[3] * z0[3])) + ((z1[0] * z1[0] + z1[1] * z1[1]) + (z1[2] * z1[2] + z1[3] * z1[3])); }
            { const int ln_ = lane_id_here(); s += xor_shfl(s, 16, ln_); s += xor_shfl(s, 32, ln_); }
            olds[ai * 4 + m] = 0;
            if (fq == 0) olds[ai * 4 + m] = __hip_atomic_fetch_add((__attribute__((address_space(1))) ssq_t*)(ssq_out + row), ssq_fix(s), __ATOMIC_RELAXED, __HIP_MEMORY_SCOPE_AGENT); }
    }
#define EPI_WAITB(n, t) asm volatile("s_waitcnt vmcnt(" #n ")" : "+v"(t[0][0]), "+v"(t[0][1]), "+v"(t[1][0]), "+v"(t[1][1]) :: "memory")
    __device__ __forceinline__ void operator()(f32x4 (&acc)[2][2][4][2], const Unit& u, int wr, int wc, int fr, int fq, const Pre& pre) const {
        const int row0 = u.pm * BM + wr * 64 + fr, col0 = u.pn * BM + wc * 32 + 8 * fq;
        const unsigned voff = lane_off(u, wr, wc, fr, fq);
        f16x8 t1[2][2], t2[2][2], t3[2][2];
        issue_batch(t1, voff, 0, 1); issue_batch(t2, voff, 1, 0); issue_batch(t3, voff, 1, 1);
        ssq_t olds[8];
        float sc = scale; bf16_t* xo = xb; ssq_t* so = ssq_out; asm volatile("" : "+s"(sc), "+s"(xo), "+s"(so));
        batch(acc, pre.t, 0, 0, row0, col0, fq, olds, sc, xo, so);
        EPI_WAITB(12, t1);
        batch(acc, t1, 0, 1, row0, col0, fq, olds, sc, xo, so);
        EPI_WAITB(12, t2);
        batch(acc, t2, 1, 0, row0, col0, fq, olds, sc, xo, so);
        EPI_WAITB(12, t3);
        batch(acc, t3, 1, 1, row0, col0, fq, olds, sc, xo, so);
#pragma unroll
        for (int i = 0; i < 8; ++i) asm volatile("" :: "v"(olds[i]));
    }
#undef EPI_WAITB
};

template <class Epi, class Sched, bool ALIGN_EPI = false, bool SP2 = false, int ABL = 0  , bool F16 = false  >
__device__ __forceinline__ void gemm_phase(PG8_LAS unsigned char* lds, const Gemm g, const Sched& S, const Epi& E, int tid_in) {
    int tid_ = tid_in; asm volatile("" : "+v"(tid_));
    const int tid = tid_, wid = __builtin_amdgcn_readfirstlane(tid >> 6), lane = tid & 63, wr = wid >> 2, wc = wid & 3, fr = lane & 15, fq = lane >> 4;
    const int K = g.K, nt = K / BK;
    unsigned voffA[2], voffB[2];
#pragma unroll
    for (int i = 0; i < 2; ++i) { const int R = 8 * (wid + 8 * i) + (lane >> 3), C = (((lane & 7) ^ ((R >> 1) & 7)) << 3); const int Rb = Epi::PERM ? ((R & ~31) + perm32(R & 31)) : R;
        voffA[i] = (unsigned)(R * K + C) * 2u; voffB[i] = (unsigned)(Rb * K + C) * 2u; }
    const unsigned kstep = (unsigned)(BK * 2);
    const unsigned hstep = (unsigned)HALF * (unsigned)K * 2u;
    const unsigned tstep = 2u * hstep;
    const __amdgpu_buffer_rsrc_t rA = __builtin_amdgcn_make_buffer_rsrc((void*)g.A, 0, 0x7ffffff0, 0x00020000), rB = __builtin_amdgcn_make_buffer_rsrc((void*)g.Bt, 0, 0x7ffffff0, 0x00020000);
    const unsigned ldsw = (unsigned)wid * 1024u;
    const int arow = wr * 64 + fr, brow = wc * 32 + fr;
    const int aoff0 = arow * 128 + ((fq ^ ((arow >> 1) & 7)) << 4), aoff1 = aoff0 ^ 64, boff0 = brow * 128 + ((fq ^ ((brow >> 1) & 7)) << 4), boff1 = boff0 ^ 64;
#define PG8_SA(b, h) (((b) * 2 + (h)) * HTB)
#define PG8_SB(b, h) ((4 + (b) * 2 + (h)) * HTB)
#define PG8_STAGE(bufoff, rsrc, goff, voff) do { if (ABL != 2) _Pragma("unroll") for (int _i = 0; _i < 2; ++_i) \
        __builtin_amdgcn_raw_ptr_buffer_load_lds(rsrc, (PG8_LAS void*)(lds + (bufoff) + ldsw + _i * 8192), 16, (voff)[_i], (int)(goff), 0, 0); } while (0)
#define PG8_LDA(dst, b, h) do { if (ABL != 3) _Pragma("unroll") for (int m = 0; m < 4; ++m) { dst[m][0] = *(const PG8_LAS bf16x8*)(lds + PG8_SA(b, h) + aoff0 + m * 2048); dst[m][1] = *(const PG8_LAS bf16x8*)(lds + PG8_SA(b, h) + aoff1 + m * 2048); } } while (0)
#define PG8_LDB(dst, b, h) do { if (ABL != 3) _Pragma("unroll") for (int n = 0; n < 2; ++n) { dst[n][0] = *(const PG8_LAS bf16x8*)(lds + PG8_SB(b, h) + boff0 + n * 2048); dst[n][1] = *(const PG8_LAS bf16x8*)(lds + PG8_SB(b, h) + boff1 + n * 2048); } } while (0)
#define PG8_MMA(ai, bj, At, Bt) do { __builtin_amdgcn_s_setprio(1); _Pragma("unroll") for (int m = 0; m < 4; ++m) _Pragma("unroll") for (int n = 0; n < 2; ++n) _Pragma("unroll") for (int k = 0; k < 2; ++k) { \
        if (ABL == 5) { if (((m & 1) == 0)) acc32[((ai) * 2 + (bj)) * 2 + (m >> 1)] = __builtin_amdgcn_mfma_f32_32x32x16_bf16(Bt[n][k], At[m][k], acc32[((ai) * 2 + (bj)) * 2 + (m >> 1)], 0, 0, 0); else asm volatile("" :: "v"(Bt[n][k]), "v"(At[m][k])); } \
        else if (ABL != 1) { if (F16) acc[ai][bj][m][n] = __builtin_amdgcn_mfma_f32_16x16x32_f16(__builtin_bit_cast(f16x8, Bt[n][k]), __builtin_bit_cast(f16x8, At[m][k]), acc[ai][bj][m][n], 0, 0, 0); \
            else acc[ai][bj][m][n] = __builtin_amdgcn_mfma_f32_16x16x32_bf16(Bt[n][k], At[m][k], acc[ai][bj][m][n], 0, 0, 0); } else asm volatile("" :: "v"(Bt[n][k]), "v"(At[m][k])); } __builtin_amdgcn_s_setprio(0); } while (0)
#define PG8_WAIT_V(n) asm volatile("s_waitcnt vmcnt(" #n ")" ::: "memory")
#define PG8_WAIT_L(n) asm volatile("s_waitcnt lgkmcnt(" #n ")" ::: "memory")
#define PG8_BAR __builtin_amdgcn_s_barrier()
#define PG8_SCHED __builtin_amdgcn_sched_barrier(0)
    Unit cur, nxt; int ui = 0;
    if (!S.next(0, cur)) return;
    f32x4 acc[2][2][4][2];
    if constexpr (Epi::HAS_INIT) E.init(acc, cur, wr, wc, fr, fq);
    else {
#pragma unroll
    for (int a = 0; a < 2; ++a)
#pragma unroll
        for (int b = 0; b < 2; ++b)
#pragma unroll
            for (int m = 0; m < 4; ++m)
#pragma unroll
                for (int n = 0; n < 2; ++n) acc[a][b][m][n] = (f32x4){0.f, 0.f, 0.f, 0.f};
    }
    bf16x8 At[4][2], B0[2][2], B1[2][2];
    typename Epi::Pre pre = {};
    typedef float f32x16_t __attribute__((ext_vector_type(16))); f32x16_t acc32[8];
    if (ABL == 5) { _Pragma("unroll") for (int i = 0; i < 8; ++i) _Pragma("unroll") for (int r = 0; r < 16; ++r) acc32[i][r] = 0.f; }
    if (ABL == 3) { _Pragma("unroll") for (int m = 0; m < 4; ++m) _Pragma("unroll") for (int k = 0; k < 2; ++k) At[m][k] = (bf16x8){1, 2, 3, 4, 5, 6, 7, 8}; _Pragma("unroll") for (int n = 0; n < 2; ++n) _Pragma("unroll") for (int k = 0; k < 2; ++k) { B0[n][k] = (bf16x8){8, 7, 6, 5, 4, 3, 2, 1}; B1[n][k] = (bf16x8){1, 1, 2, 2, 3, 3, 4, 4}; } }
    unsigned cA = (unsigned)cur.pm * tstep, cB = (unsigned)cur.pn * tstep;
    S.a_ready(cur);
    if constexpr (SP2) {
        PG8_STAGE(PG8_SB(0, 0), rB, cB, voffB); PG8_STAGE(PG8_SB(0, 1), rB, cB + hstep, voffB); PG8_STAGE(PG8_SA(0, 0), rA, cA, voffA); PG8_STAGE(PG8_SA(0, 1), rA, cA + hstep, voffA);
        if (wr == 1) PG8_BAR;
        PG8_WAIT_V(2); PG8_BAR;
        PG8_STAGE(PG8_SB(1, 0), rB, cB + kstep, voffB); PG8_STAGE(PG8_SA(1, 0), rA, cA + kstep, voffA); PG8_STAGE(PG8_SB(1, 1), rB, cB + hstep + kstep, voffB);
        PG8_WAIT_V(6); PG8_BAR;
    } else {
        PG8_STAGE(PG8_SB(0, 0), rB, cB, voffB); PG8_STAGE(PG8_SA(0, 0), rA, cA, voffA); PG8_STAGE(PG8_SB(0, 1), rB, cB + hstep, voffB); PG8_STAGE(PG8_SA(0, 1), rA, cA + hstep, voffA);
        if (wr == 1) PG8_BAR;
        PG8_WAIT_V(4); PG8_BAR;
        PG8_STAGE(PG8_SB(1, 0), rB, cB + kstep, voffB); PG8_STAGE(PG8_SA(1, 0), rA, cA + kstep, voffA); PG8_STAGE(PG8_SB(1, 1), rB, cB + hstep + kstep, voffB);
        PG8_WAIT_V(6); PG8_BAR;
    }
    for (;;) {
        const bool has_next = S.next(ui + 1, nxt);
        const unsigned nA = has_next ? (unsigned)nxt.pm * tstep : cA, nB = has_next ? (unsigned)nxt.pn * tstep : cB;
        for (int t = 0; t < nt; t += 2) {
            const bool last = (t == nt - 2);
            const unsigned a1 = cA + (unsigned)(t + 1) * kstep;
            const unsigned a2 = last ? nA : cA + (unsigned)(t + 2) * kstep, b2 = last ? nB : cB + (unsigned)(t + 2) * kstep;
            const unsigned a3 = a2 + kstep, b3 = b2 + kstep;
            if (last && has_next) S.a_ready(nxt);
            if constexpr (Epi::HAS_PRE) { if (last) E.pre_issue(pre, cur, wr, wc, fr, fq); }
            if constexpr (SP2) {
            PG8_LDB(B0, 0, 0); PG8_LDB(B1, 0, 1); PG8_SCHED; PG8_LDA(At, 0, 0); PG8_STAGE(PG8_SA(1, 1), rA, a1 + hstep, voffA);
            PG8_WAIT_V(8); PG8_WAIT_L(0); PG8_BAR; PG8_MMA(0, 0, At, B0); PG8_MMA(0, 1, At, B1); PG8_BAR; PG8_SCHED;
            PG8_LDA(At, 0, 1); PG8_STAGE(PG8_SB(0, 0), rB, b2, voffB); PG8_STAGE(PG8_SB(0, 1), rB, b2 + hstep, voffB); PG8_STAGE(PG8_SA(0, 0), rA, a2, voffA);
            PG8_WAIT_V(8); PG8_WAIT_L(0); PG8_BAR; PG8_MMA(1, 0, At, B0); PG8_MMA(1, 1, At, B1); PG8_BAR; PG8_SCHED;
            PG8_LDB(B0, 1, 0); PG8_LDB(B1, 1, 1); PG8_SCHED; PG8_LDA(At, 1, 0); PG8_STAGE(PG8_SA(0, 1), rA, a2 + hstep, voffA);
            PG8_WAIT_V(8); PG8_WAIT_L(0); PG8_BAR; PG8_MMA(0, 0, At, B0); PG8_MMA(0, 1, At, B1); PG8_BAR; PG8_SCHED;
            PG8_LDA(At, 1, 1); PG8_STAGE(PG8_SB(1, 0), rB, b3, voffB); PG8_STAGE(PG8_SB(1, 1), rB, b3 + hstep, voffB); PG8_STAGE(PG8_SA(1, 0), rA, a3, voffA);
            PG8_WAIT_V(8); PG8_WAIT_L(0); PG8_BAR; PG8_MMA(1, 0, At, B0); PG8_MMA(1, 1, At, B1); PG8_BAR; PG8_SCHED;
            } else {
            PG8_LDB(B0, 0, 0); PG8_SCHED; PG8_LDA(At, 0, 0); PG8_STAGE(PG8_SA(1, 1), rA, a1 + hstep, voffA);
            PG8_WAIT_L(8); PG8_BAR; PG8_WAIT_L(0); PG8_MMA(0, 0, At, B0); PG8_BAR; PG8_SCHED;
            PG8_LDB(B1, 0, 1); PG8_STAGE(PG8_SB(0, 0), rB, b2, voffB);
            PG8_BAR; PG8_WAIT_L(0); PG8_MMA(0, 1, At, B1); PG8_BAR;
            PG8_LDA(At, 0, 1); PG8_STAGE(PG8_SA(0, 0), rA, a2, voffA);
            PG8_BAR; PG8_WAIT_L(0); PG8_MMA(1, 0, At, B0); PG8_BAR; PG8_SCHED;
            PG8_STAGE(PG8_SB(0, 1), rB, b2 + hstep, voffB);
            PG8_WAIT_V(6); PG8_BAR; PG8_MMA(1, 1, At, B1); PG8_BAR;
            PG8_LDB(B0, 1, 0); PG8_SCHED; PG8_LDA(At, 1, 0); PG8_STAGE(PG8_SA(0, 1), rA, a2 + hstep, voffA);
            PG8_WAIT_L(8); PG8_BAR; PG8_WAIT_L(0); PG8_MMA(0, 0, At, B0); PG8_BAR; PG8_SCHED;
            PG8_LDB(B1, 1, 1); PG8_STAGE(PG8_SB(1, 0), rB, b3, voffB);
            PG8_BAR; PG8_WAIT_L(0); PG8_MMA(0, 1, At, B1); PG8_BAR;
            PG8_LDA(At, 1, 1); PG8_STAGE(PG8_SA(1, 0), rA, a3, voffA);
            PG8_BAR; PG8_WAIT_L(0); PG8_MMA(1, 0, At, B0); PG8_BAR; PG8_SCHED;
            PG8_STAGE(PG8_SB(1, 1), rB, b3 + hstep, voffB);
            PG8_WAIT_V(6); PG8_BAR; PG8_MMA(1, 1, At, B1); PG8_BAR;
            }
        }
        if constexpr (ALIGN_EPI) { if (wr == 0) PG8_BAR; }
        if constexpr (!Epi::AFTER_DRAIN) { if constexpr (Epi::HAS_PRE) { E.pre_wait(pre); E(acc, cur, wr, wc, fr, fq, pre); } else E(acc, cur, wr, wc, fr, fq); S.done(cur); }
        if (!has_next) break;
        if constexpr (Epi::HAS_INIT) E.init(acc, nxt, wr, wc, fr, fq);
        else {
#pragma unroll
        for (int a = 0; a < 2; ++a)
#pragma unroll
            for (int b = 0; b < 2; ++b)
#pragma unroll
                for (int m = 0; m < 4; ++m)
#pragma unroll
                    for (int n = 0; n < 2; ++n) acc[a][b][m][n] = (f32x4){0.f, 0.f, 0.f, 0.f};
        }
        cur = nxt; cA = nA; cB = nB; ++ui;
        if constexpr (ALIGN_EPI) { if (wr == 1) PG8_BAR; }
    }
    PG8_WAIT_V(0);
    if constexpr (!ALIGN_EPI) { if (wr == 0) PG8_BAR; }
    PG8_BAR;
    if constexpr (Epi::AFTER_DRAIN) { E.fused(acc, cur, wr, wc, fr, fq, lds, wid, lane); S.done(cur); }
    if (ABL == 5) { _Pragma("unroll") for (int i = 0; i < 8; ++i) asm volatile("" :: "v"(acc32[i])); }
#undef PG8_SA
#undef PG8_SB
#undef PG8_STAGE
#undef PG8_LDA
#undef PG8_LDB
#undef PG8_MMA
#undef PG8_WAIT_V
#undef PG8_WAIT_L
#undef PG8_BAR
#undef PG8_SCHED
}
}

constexpr int NWAVES = 8;
constexpr int D = 2048, BATCH = 4, SEQ = 2048, DEPTH = 4, HD = 128, FF = 5632;
constexpr int M = BATCH * SEQ;
constexpr int AB_IN = 4608, C_IN = 6144;
constexpr float RMS_EPS = 1e-6f;
constexpr float QK_SCALE = 0.08838834764831845f;

constexpr size_t MiB = 1u << 20;
constexpr size_t WS_CTL = 0, CTL_ZERO_BYTES = 1 * MiB;
constexpr size_t SZ_WGU = (size_t)2 * FF * D * 2, SZ_WD = (size_t)D * FF * 2, SZ_WABIN = (size_t)AB_IN * D * 2, SZ_WOUT = (size_t)D * D * 2, SZ_WCIN = (size_t)C_IN * D * 2;
constexpr size_t WS_WGU = 2 * MiB;
constexpr size_t WS_WD = WS_WGU + 8 * SZ_WGU;
constexpr size_t WS_WABIN = WS_WD + 8 * SZ_WD;
constexpr size_t WS_WABOUT = WS_WABIN + 2 * SZ_WABIN;
constexpr size_t WS_WCIN = WS_WABOUT + 2 * SZ_WOUT;
constexpr size_t WS_WCOUT = WS_WCIN + 2 * SZ_WCIN;
constexpr size_t WS_H = WS_WCOUT + 2 * SZ_WOUT;
constexpr size_t WS_U = WS_H + (size_t)M * D * 2;
constexpr size_t WS_QKV = WS_U + (size_t)M * FF * 2;
constexpr size_t WS_O = WS_QKV + (size_t)M * C_IN * 2;
constexpr size_t WS_PART = WS_O + (size_t)M * D * 2;
constexpr size_t WS_LSE = WS_PART + (size_t)3 * M * 1024 * 4;
constexpr size_t WS_END = WS_LSE + (size_t)3 * M * 8 * 4;
constexpr int CW_BAR = 4096;
constexpr size_t WS_SSQ = 65536;
constexpr size_t WS_SB = 917504;
static_assert(WS_SB >= WS_SSQ + (size_t)13 * 8192 * 8 && WS_SB + 128 * 17 * 32 <= CTL_ZERO_BYTES, "token-barrier counters inside the memset region");
#ifndef NSTREAMS
#define NSTREAMS 2
#endif
constexpr int NSTREAM = NSTREAMS, MH = M / NSTREAM;
static_assert(WS_SSQ + (size_t)13 * 8192 * 8 <= CTL_ZERO_BYTES, "ssq slots inside the memset region");

constexpr int RING_OFF = 0, RING_BYTES = 131072;
constexpr int LDSCTL_OFF = RING_BYTES, MISC_OFF = LDSCTL_OFF + 320;
constexpr int LDS_BYTES = 147456;
static_assert(MISC_OFF + 128 <= LDS_BYTES, "LDS map");

#define GAS __attribute__((address_space(1)))
#define LAS __attribute__((address_space(3)))
typedef unsigned short bf16;
typedef unsigned v4u __attribute__((ext_vector_type(4)));
typedef unsigned v2u __attribute__((ext_vector_type(2)));
typedef float f32x4 __attribute__((ext_vector_type(4)));
typedef GAS unsigned gu32;
#define RLX_AGENT __ATOMIC_RELAXED, __HIP_MEMORY_SCOPE_AGENT
#define LDS_WAIT() asm volatile("s_waitcnt lgkmcnt(0)" ::: "memory")
#define VM_WAIT() asm volatile("s_waitcnt vmcnt(0)" ::: "memory")
__device__ __forceinline__ unsigned f2bf(float f) { unsigned u = __builtin_bit_cast(unsigned, f); return (u + 0x7fffu + ((u >> 16) & 1u)) >> 16; }
__device__ __forceinline__ unsigned pk2(float lo, float hi) { return f2bf(lo) | (f2bf(hi) << 16); }
typedef _Float16 h2_t __attribute__((ext_vector_type(2))); typedef float f2_t __attribute__((ext_vector_type(2))); typedef _Float16 h4_t __attribute__((ext_vector_type(4)));
__device__ __forceinline__ unsigned pkh2(float lo, float hi) { const f2_t v = {lo, hi}; return __builtin_bit_cast(unsigned, __builtin_convertvector(v, h2_t)); }
__device__ __forceinline__ float bflo(unsigned w) { return __builtin_bit_cast(float, w << 16); }
__device__ __forceinline__ float bfhi(unsigned w) { return __builtin_bit_cast(float, w & 0xffff0000u); }

#define XB_TMO      128
#define XB_XCNT(j)  (256  + 64 * (j))
#define XB_XSUB(j)  (1280 + 64 * (j))
#define XB_XGEN(j)  (2304 + 64 * (j))
#define XB_TOP      3328
#define XB_TOPGEN   3392
#define XCD_BAR_WORDS 3456
#define XB_SPIN_CAP (1u << 18)

__device__ __forceinline__ unsigned xb_ld(unsigned* p)              { return __hip_atomic_load(p, __ATOMIC_RELAXED, __HIP_MEMORY_SCOPE_AGENT); }
__device__ __forceinline__ unsigned xb_add(unsigned* p, unsigned v) { return __hip_atomic_fetch_add(p, v, __ATOMIC_RELAXED, __HIP_MEMORY_SCOPE_AGENT); }
__device__ __forceinline__ unsigned xb_xcc_id() { return (unsigned)__builtin_amdgcn_s_getreg((3 << 11) | 20) & 0xFu; }
#define XB_SPIN(cond, bar) do { unsigned _sp = 0; while (cond) { __builtin_amdgcn_s_sleep(1); \
    if ((++_sp & 255u) == 0u) { if (xb_ld(&(bar)[XB_TMO])) break; if (_sp > XB_SPIN_CAP) { atomicAdd(&(bar)[XB_TMO], 1u); break; } } } } while (0)

struct XcdBarrier {
    int wv;
    unsigned* bar; unsigned x;
    volatile LAS unsigned* st;
};

__device__ __forceinline__ int xb_lane() { int l; asm volatile("v_mbcnt_lo_u32_b32 %0, -1, 0\n\tv_mbcnt_hi_u32_b32 %0, -1, %0" : "=v"(l)); return l; }
__device__ __forceinline__ XcdBarrier xcd_barrier_post(unsigned* bar, volatile LAS unsigned* st, int wv) {
    XcdBarrier b; b.wv = wv; b.bar = bar; b.x = xb_xcc_id(); b.st = st;
    if (wv == 0 && xb_lane() == 0) (void)xb_add(&bar[XB_XCNT(b.x)], 1u);
    return b;
}
__device__ __forceinline__ void xcd_barrier_complete(unsigned* bar, unsigned x, unsigned& nloc, unsigned& nx) {
    const unsigned G = gridDim.x * gridDim.y * gridDim.z;
    unsigned sum, cnt, mine, sp = 0u;
    for (;;) {
        sum = 0u; cnt = 0u; mine = 0u;
#pragma unroll
        for (unsigned j = 0; j < 16; ++j) { const unsigned c = xb_ld(&bar[XB_XCNT(j)]); sum += c; cnt += (c > 0u) ? 1u : 0u; mine = (j == x) ? c : mine; }
        if (sum == G) break;
        __builtin_amdgcn_s_sleep(1);
        if ((++sp & 255u) == 0u) { if (xb_ld(&bar[XB_TMO])) break; if (sp > XB_SPIN_CAP) { atomicAdd(&bar[XB_TMO], 1u); break; } }
    }
    nloc = mine > 0u ? mine : 1u; nx = cnt > 0u ? cnt : 1u;
}

__device__ __forceinline__ void xcd_barrier(const XcdBarrier& b) {
    asm volatile("s_waitcnt vmcnt(0)" ::: "memory");
    __syncthreads();
    if (b.wv == 0 && xb_lane() == 0) {
        unsigned* bar = b.bar; unsigned bx = b.x; asm volatile("" : "+s"(bar), "+s"(bx));
        __builtin_amdgcn_s_waitcnt(0);
        unsigned nloc = b.st[0], nx = b.st[1];
        if (nloc == 0u) { xcd_barrier_complete(bar, bx, nloc, nx); b.st[0] = nloc; b.st[1] = nx; }
        const unsigned old = xb_add(&bar[XB_XSUB(bx)], 1u);
        const unsigned gen = old / nloc;
        if (old + 1u == (gen + 1u) * nloc) {
            __builtin_amdgcn_fence(__ATOMIC_RELEASE, "agent");
            asm volatile("s_waitcnt vmcnt(0)" ::: "memory");
            const unsigned og = xb_add(&bar[XB_TOP], 1u);
            const unsigned tg = og / nx;
            if (og + 1u == (tg + 1u) * nx) xb_add(&bar[XB_TOPGEN], 1u);
            else XB_SPIN(xb_ld(&bar[XB_TOPGEN]) == tg, bar);
            __builtin_amdgcn_fence(__ATOMIC_ACQUIRE, "agent");
            xb_add(&bar[XB_XGEN(bx)], 1u);
            asm volatile("s_waitcnt vmcnt(0)" ::: "memory");
        } else {
            XB_SPIN(xb_ld(&bar[XB_XGEN(bx)]) == gen, bar);
            __builtin_amdgcn_fence(__ATOMIC_ACQUIRE, "agent");
            asm volatile("s_waitcnt vmcnt(0)" ::: "memory");
        }
    }
    __syncthreads();
}

#define SB_TOKEN_WORDS (17 * 8)
__device__ __forceinline__ void sb_arrive(const XcdBarrier& b, unsigned* sb, int T) {
    asm volatile("s_waitcnt vmcnt(0)" ::: "memory");
    __syncthreads();
    if (b.wv == 0 && xb_lane() == 0) {
        unsigned* base = sb + (size_t)T * SB_TOKEN_WORDS; unsigned bx = b.x; asm volatile("" : "+s"(base), "+s"(bx));
        __builtin_amdgcn_s_waitcnt(0);
        const unsigned nloc = b.st[0];
        const unsigned old = xb_add(&base[8 * bx], 1u);
        if (old + 1u == nloc) {
            __builtin_amdgcn_fence(__ATOMIC_RELEASE, "agent");
            asm volatile("s_waitcnt vmcnt(0)" ::: "memory");
            xb_add(&base[8 * 16], 1u);
        }
    }
}
__device__ __forceinline__ void sb_wait(const XcdBarrier& b, unsigned* sb, int T) {
    if (b.wv == 0 && xb_lane() == 0) {
        unsigned* base = sb + (size_t)T * SB_TOKEN_WORDS; asm volatile("" : "+s"(base));
        const unsigned nx = b.st[1];
        XB_SPIN(xb_ld(&base[8 * 16]) < nx, b.bar);
        __builtin_amdgcn_fence(__ATOMIC_ACQUIRE, "agent");
        asm volatile("s_waitcnt vmcnt(0)" ::: "memory");
    }
    __syncthreads();
}

struct Frame {
    LAS unsigned char* lds;
    int tid, lane, wave;
    int G, bid;
};
__device__ __forceinline__ float wave_sum(float v) {
    const int ln_ = pg8::lane_id_here();
#pragma unroll
    for (int o = 1; o < 64; o <<= 1) v += pg8::xor_shfl(v, o, ln_);
    return v;
}
__device__ __forceinline__ float wave_max(float v) {
    const int ln_ = pg8::lane_id_here();
#pragma unroll
    for (int o = 1; o < 64; o <<= 1) v = fmaxf(v, pg8::xor_shfl(v, o, ln_));
    return v;
}
template <bool GAIN>
__device__ __forceinline__ void p0_transpose_item(const float* W, int K, int N, bf16* WT, int k0, int n0, int drow0, LAS float* scr, int lane, const float* gain) {
    const int c = lane & 7;
    f32x4 ga = {1.f, 1.f, 1.f, 1.f}, gb = {1.f, 1.f, 1.f, 1.f};
    if (GAIN) { ga = *(const GAS f32x4*)(gain + k0 + 8 * c); gb = *(const GAS f32x4*)(gain + k0 + 8 * c + 4); }
#pragma unroll 8
    for (int i = 0; i < 32; ++i) { const int kk = 2 * i + (lane >> 5); scr[kk * 33 + (lane & 31)] = __builtin_nontemporal_load(W + (size_t)(k0 + kk) * N + n0 + (lane & 31)); }
    LDS_WAIT(); asm volatile("" ::: "memory");
#pragma unroll
    for (int j = 0; j < 4; ++j) { const int n = (lane >> 3) + 8 * j; const LAS float* s = scr + (8 * c) * 33 + n;
        v4u o;
        if (GAIN && RESID_F16) { o.x = pkh2(s[0 * 33] * ga.x, s[1 * 33] * ga.y); o.y = pkh2(s[2 * 33] * ga.z, s[3 * 33] * ga.w); o.z = pkh2(s[4 * 33] * gb.x, s[5 * 33] * gb.y); o.w = pkh2(s[6 * 33] * gb.z, s[7 * 33] * gb.w); }
        else { o.x = pk2(s[0 * 33] * ga.x, s[1 * 33] * ga.y); o.y = pk2(s[2 * 33] * ga.z, s[3 * 33] * ga.w); o.z = pk2(s[4 * 33] * gb.x, s[5 * 33] * gb.y); o.w = pk2(s[6 * 33] * gb.z, s[7 * 33] * gb.w); }
        __builtin_nontemporal_store(o, (GAS v4u*)(WT + (size_t)(drow0 + n) * K + k0 + 8 * c)); }
    LDS_WAIT(); asm volatile("" ::: "memory");
}
struct Args {
    const float* x; const float* ffn_norm; const float* wg; const float* wu; const float* wd; const float* mix_norm;
    const float* ab_in; const float* ab_out; const float* ab_sink; const float* c_in; const float* c_out; const float* c_rpb; const float* final_norm;
    float* out; unsigned char* ws; int ph_lo, ph_hi;
};
static_assert(sizeof(Args) == 15 * 8 + 8, "Args has no padding");

constexpr int CV_NSLOT = 11, CV_MAXR = 1;
__device__ const int CV_TAB[CV_NSLOT][CV_MAXR][2] = {
    {{0, 164864}},
    {{0, 0}},
    {{0, 0}},
    {{0, 0}},
    {{0, 0}},
    {{0, 0}},
    {{0, 0}},
    {{0, 0}},
    {{0, 0}},
    {{0, 0}},
    {{0, 0}},
};

constexpr int CV_I_GU = (D / 64) * (FF / 32), CV_I_D = (FF / 64) * (D / 32), CV_I_ABIN = (D / 64) * (AB_IN / 32), CV_I_OUT = (D / 64) * (D / 32), CV_I_CIN = (D / 64) * (C_IN / 32);
constexpr int CV_EVEN = 2 * CV_I_GU + CV_I_D + CV_I_ABIN + CV_I_OUT + 2 * CV_I_GU + CV_I_D, CV_ODD = CV_EVEN - CV_I_ABIN + CV_I_CIN;
static_assert(2 * (CV_EVEN + CV_ODD) == 164864, "item count");
__device__ __forceinline__ void cv_item(const Args& a, unsigned char* ws, int it, LAS float* scr, int lane) {
    const int pr = it / (CV_EVEN + CV_ODD); int r = it - pr * (CV_EVEN + CV_ODD); int layer = 2 * pr; if (r >= CV_EVEN) { r -= CV_EVEN; ++layer; }
    const int li = layer >> 1; const bool odd = layer & 1; const int nin = odd ? CV_I_CIN : CV_I_ABIN;
    int f = 0, kind;
    if (r < 2 * CV_I_GU) kind = 0; else { r -= 2 * CV_I_GU; if (r < CV_I_D) kind = 1; else { r -= CV_I_D; if (r < nin) kind = 2; else { r -= nin; if (r < CV_I_OUT) kind = 3; else { r -= CV_I_OUT; f = 1;
        if (r < 2 * CV_I_GU) kind = 0; else { r -= 2 * CV_I_GU; kind = 1; } } } } }
    const int lf = layer * 2 + f;
    if (kind == 0) { const int up = r >= CV_I_GU; if (up) r -= CV_I_GU; const int nblk = FF / 32, kb = r / nblk, nb = r % nblk, n0 = 32 * nb;
        p0_transpose_item<true>((up ? a.wu : a.wg) + (size_t)lf * D * FF, D, FF, (bf16*)(ws + WS_WGU + (size_t)lf * SZ_WGU), 64 * kb, n0, (n0 >> 7) * 256 + (n0 & 127) + up * 128, scr, lane, a.ffn_norm + (size_t)lf * D); }
    else if (kind == 1) { const int nblk = D / 32, kb = r / nblk, nb = r % nblk, n0 = 32 * nb;
        p0_transpose_item<false>(a.wd + (size_t)lf * FF * D, FF, D, (bf16*)(ws + WS_WD + (size_t)lf * SZ_WD), 64 * kb, n0, n0, scr, lane, nullptr); }
    else if (kind == 2) {
        if (!odd) { const int nblk = AB_IN / 32, kb = r / nblk, nb = r % nblk, n0 = 32 * nb;
            p0_transpose_item<true>(a.ab_in + (size_t)li * D * AB_IN, D, AB_IN, (bf16*)(ws + WS_WABIN + (size_t)li * SZ_WABIN), 64 * kb, n0, n0, scr, lane, a.mix_norm + (size_t)layer * D); }
        else { const int nblk = C_IN / 32, kb = r / nblk, nb = r % nblk, n0 = 32 * nb;
            p0_transpose_item<true>(a.c_in + (size_t)li * D * C_IN, D, C_IN, (bf16*)(ws + WS_WCIN + (size_t)li * SZ_WCIN), 64 * kb, n0, n0, scr, lane, a.mix_norm + (size_t)layer * D); } }
    else { const int nblk = D / 32, kb = r / nblk, nb = r % nblk, n0 = 32 * nb;
        p0_transpose_item<false>((odd ? a.c_out : a.ab_out) + (size_t)li * D * D, D, D, (bf16*)(ws + (odd ? WS_WCOUT : WS_WABOUT) + (size_t)li * SZ_WOUT), 64 * kb, n0, n0, scr, lane, nullptr); }
}
__device__ __forceinline__ void cv_run(const Frame& F, const Args& a, unsigned char* ws, int slot, int j, int n) {
    LAS float* scr = (LAS float*)(F.lds + RING_OFF + F.wave * 16384);
    int lane = F.lane; asm volatile("" : "+v"(lane));
    int total = 0;
#pragma unroll
    for (int r = 0; r < CV_MAXR; ++r) total += CV_TAB[slot][r][1] - CV_TAB[slot][r][0];
    for (int idx = j * NWAVES + F.wave; idx < total; idx += n * NWAVES) {
        int rem = idx, it = 0;
#pragma unroll
        for (int r = 0; r < CV_MAXR; ++r) { const int b = CV_TAB[slot][r][0], len = CV_TAB[slot][r][1] - b; if (rem >= 0 && rem < len) it = b + rem; rem -= len; }
        cv_item(a, ws, it, scr, lane);
    }
}
__device__ __forceinline__ void p0_prologue(const Frame& F, const Args& a) {
    const int gw = F.bid * NWAVES + F.wave, NGW = F.G * NWAVES;
    int lane = F.lane; asm volatile("" : "+v"(lane));
    cv_run(F, a, a.ws, 0, F.bid, F.G);
    bf16* const XB = (bf16*)(a.ws + WS_H); pg8::ssq_t* const ssq0 = (pg8::ssq_t*)(a.ws + WS_SSQ);
    for (int m = gw; m < M; m += NGW) {
        const GAS f32x4* xr = (const GAS f32x4*)(a.x + (size_t)m * D) + lane;
        f32x4 v[8]; float s = 0.f;
#pragma unroll
        for (int j = 0; j < 8; ++j) { v[j] = xr[64 * j]; s += (v[j].x * v[j].x + v[j].y * v[j].y) + (v[j].z * v[j].z + v[j].w * v[j].w); }
        s = wave_sum(s);
        s = 0.f;
#pragma unroll
        for (int j = 0; j < 8; ++j) { const h4_t hq = __builtin_convertvector(v[j], h4_t); ((GAS h4_t*)(XB + (size_t)m * D) + lane)[64 * j] = hq; const f32x4 y = __builtin_convertvector(hq, f32x4); s += (y.x * y.x + y.y * y.y) + (y.z * y.z + y.w * y.w); }
        s = wave_sum(s);
        if (lane == 0) ssq0[m] = pg8::ssq_fix(s);
    }
}
__device__ __forceinline__ void final_norm_h_phase(const Frame& F, const bf16* xb, float* out, const float* g, const pg8::ssq_t* ssq, const int stream) {
    const int gw = F.bid * NWAVES + F.wave, NGW = F.G * NWAVES;
    int lane = F.lane; asm volatile("" : "+v"(lane));
    for (int m = stream * MH + gw; m < (stream + 1) * MH; m += NGW) {
        const GAS h4_t* xr = (const GAS h4_t*)(xb + (size_t)m * D) + lane; GAS f32x4* orow = (GAS f32x4*)(out + (size_t)m * D) + lane; const GAS f32x4* gr = (const GAS f32x4*)g + lane;
        const float rstd = 1.0f / sqrtf(pg8::ssq_val(((const GAS pg8::ssq_t*)ssq)[m + (lane & 0)]) * (1.f / D) + RMS_EPS);
#pragma unroll
        for (int j = 0; j < 8; ++j) orow[64 * j] = __builtin_convertvector(xr[64 * j], f32x4) * rstd * gr[64 * j];
    }
}
namespace att {
using bf16x8 = __attribute__((ext_vector_type(8))) short;
using s16x4  = __attribute__((ext_vector_type(4))) short;
using f32x16 = __attribute__((ext_vector_type(16))) float;
using u32x4  = __attribute__((ext_vector_type(4))) unsigned;
constexpr float LOG2E = 1.4426950408889634f;
constexpr float CSC = 0.08838834764831845f * LOG2E;
constexpr float THR_L2 = 4.0f * LOG2E;
#define ATT_KSWZ(row, colB) ((row) * 256 + ((colB) ^ (((row) & 7) << 4)))
__device__ __forceinline__ constexpr int crowc(int r) { return (r & 3) + 8 * (r >> 2); }
__device__ __forceinline__ unsigned cvtpk(float lo, float hi) { unsigned r; asm volatile("v_cvt_pk_bf16_f32 %0, %1, %2" : "=v"(r) : "v"(lo), "v"(hi)); return r; }
__device__ __forceinline__ int swap23(int k) { return (k & ~0xC) | ((k & 4) << 1) | ((k & 8) >> 1); }
__device__ __forceinline__ int v_rd_base(int lane) { return ((lane & 3) << 3) | (((lane >> 2) & 3) << 6) | (((lane >> 4) & 1) << 5) | (((lane >> 5) & 1) << 8); }
constexpr int v_rd_off(int d0, int ks, int half) { return d0 * 512 + ks * 4096 + half * 2048; }
template <int OFF> __device__ __forceinline__ s16x4 tr_read(int vb) { s16x4 r; asm volatile("ds_read_b64_tr_b16 %0, %1 offset:%2" : "=&v"(r) : "v"(vb), "i"(OFF) : "memory"); return r; }
template <int D0> __device__ __forceinline__ void pv_one(f32x16& od, int vb, bf16x8 pa0, bf16x8 pa1) {
    const s16x4 l0 = tr_read<v_rd_off(D0, 0, 0)>(vb), h0 = tr_read<v_rd_off(D0, 0, 1)>(vb), l1 = tr_read<v_rd_off(D0, 1, 0)>(vb), h1 = tr_read<v_rd_off(D0, 1, 1)>(vb);
    asm volatile("s_waitcnt lgkmcnt(0)" ::: "memory"); __builtin_amdgcn_sched_barrier(0);
#define ATT_PK(L, H) (bf16x8){L[0], L[1], L[2], L[3], H[0], H[1], H[2], H[3]}
    od = __builtin_amdgcn_mfma_f32_32x32x16_bf16(pa0, ATT_PK(l0, h0), od, 0, 0, 0);
    od = __builtin_amdgcn_mfma_f32_32x32x16_bf16(pa1, ATT_PK(l1, h1), od, 0, 0, 0);
#undef ATT_PK
}
constexpr int ATT_SCR_OFF = 132096;
constexpr int ATT_RPB_OFF = 136192;
constexpr int RPB_PAD = 8, RPB_FLOATS = 640;
static_assert(ATT_RPB_OFF + 4 * RPB_FLOATS * 4 <= LDS_BYTES && ATT_SCR_OFF >= MISC_OFF + 128, "attention LDS map");

template <int MODE>
__device__ __forceinline__ void attn_mfma(const Frame& F, const bf16* QKV, const int ld, bf16* O, float* part, float* lsebuf, const float* extra, const int stream, const int vc) {
    int lane = F.lane; asm volatile("" : "+v"(lane));
    const int wid = F.wave, pair = wid >> 1, w2 = wid & 1, r32 = lane & 31, hi = lane >> 5;
    LAS unsigned char* const pbase = F.lds + RING_OFF + pair * 32768;
    LAS float* const scr = (LAS float*)(F.lds + ATT_SCR_OFF + wid * 512);
    LAS float* const rpbt = (LAS float*)(F.lds + ATT_RPB_OFF + pair * (RPB_FLOATS * 4));
    constexpr int NT = (MODE == 0) ? 6 : (MODE == 1) ? 10 : 11;
    constexpr int NUNITS = ((MODE == 0) ? 3072 : (MODE == 1) ? 1024 : 2048) / NSTREAM;
    constexpr int HW = (MODE == 0) ? 64 : 128;
    const int vb0 = (int)(uintptr_t)(pbase + 8192) + v_rd_base(lane);
    for (int g = vc; g < NUNITS / 4; g += F.G) {
        const int u = g * 4 + pair;
        int b, h, qcol, kcol, vcol, shift = 0, jres = 0, l0 = 0, L = SEQ, pat = 0, rbase = 0, c0 = 0, qr0 = 0, qc0 = 0;
        if (MODE == 0) { const int blk = u & 31, rest = u >> 5; pat = rest % 3; const int bh = rest / 3; h = bh & 7; b = (BATCH / NSTREAM) * stream + (bh >> 3); shift = 2 * pat; L = SEQ >> shift;
            const int nbs = 5 - shift; jres = blk >> nbs; l0 = 64 * (blk & ((1 << nbs) - 1)); qcol = h * HD; kcol = 1024 + h * HD; vcol = 2048 + h * HD; }
        else if (MODE == 1) { const int blk = u & 31, bh = u >> 5; h = bh & 7; b = (BATCH / NSTREAM) * stream + (bh >> 3); l0 = 64 * blk; qcol = 3072 + h * HD; kcol = 4096 + (h >> 2) * HD; vcol = 4352 + (h >> 2) * HD; }
        else { const int cc = u & 3, ii = (u >> 2) & 7, bh = u >> 5; h = bh & 15; b = (BATCH / NSTREAM) * stream + (bh >> 4); qr0 = 4 * ii; qc0 = 16 * cc; rbase = qr0 - 4; rbase = rbase < 0 ? 0 : (rbase > 21 ? 21 : rbase);
            c0 = (cc == 0) ? 0 : (cc == 1) ? 8 : (cc == 2) ? 24 : 32; qcol = h * HD; kcol = 2048 + h * HD; vcol = 4096 + h * HD; }
        const bf16* const Qb = QKV + (size_t)b * SEQ * ld;
        int lq = 0, qrow = 0, qcl = 0, sq;
        if (MODE == 2) { qrow = qr0 + 2 * w2 + (r32 >> 4); qcl = qc0 + (r32 & 15); sq = qrow * 64 + qcl; }
        else { lq = l0 + 32 * w2 + r32; sq = (lq << shift) + jres; }
        bf16x8 qr[8];
        { const bf16* qp = Qb + (size_t)sq * ld + qcol + hi * 8;
#pragma unroll
          for (int d0 = 0; d0 < 8; ++d0) qr[d0] = *(const bf16x8*)(qp + d0 * 16); }
        float slopeL2 = 0.f; int rs = 0, cs = 0;
        __builtin_amdgcn_s_barrier();
        if (MODE != 2) slopeL2 = exp2f(-(float)(h + 1)) * (float)(1 << shift) * LOG2E;
        else { rs = qrow - 4; rs = rs < 0 ? 0 : (rs > 24 ? 24 : rs); cs = qcl - 8; cs = cs < 0 ? 0 : (cs > 48 ? 48 : cs);
#pragma unroll
            for (int k = 0; k < 4; ++k) { const int i = lane + 64 * w2 + 128 * k; if (i < 15 * 31) rpbt[RPB_PAD + i] = extra[h * 15 * 31 + i] * LOG2E; } }
        const int krow = 16 * w2 + (lane >> 4);
        const int kch = lane & 15;
        const int vst = 8 * w2 + (lane >> 5), vq = lane & 31;
#define ATT_KEYTOK(jj, t) ((MODE == 2) ? ((rbase + (t)) * 64 + c0 + (jj)) : ({ int lk_ = l0 - HW + 32 * (t) + (jj); lk_ = lk_ < 0 ? 0 : (lk_ > L - 1 ? L - 1 : lk_); (lk_ << shift) + jres; }))
#define ATT_STAGE(t) do { LAS unsigned char* const bb_ = pbase + ((t) & 1) * 16384; \
        _Pragma("unroll") for (int i_ = 0; i_ < 4; ++i_) { const int row_ = krow + 4 * i_; const int tok_ = ATT_KEYTOK(row_, t); \
            __builtin_amdgcn_global_load_lds((const unsigned*)(Qb + (size_t)tok_ * ld + kcol + ((kch ^ (row_ & 7)) << 3)), (LAS unsigned*)(bb_ + (w2 * 4 + i_) * 1024), 16, 0, 0); } \
        _Pragma("unroll") for (int i_ = 0; i_ < 4; ++i_) { const int st_ = vst + 2 * i_; const int kk_ = (st_ >> 2) * 8 + (vq >> 2); const int tok_ = ATT_KEYTOK(swap23(kk_), t); \
            __builtin_amdgcn_global_load_lds((const unsigned*)(Qb + (size_t)tok_ * ld + vcol + (st_ & 3) * 32 + (vq & 3) * 8), (LAS unsigned*)(bb_ + 8192 + (w2 * 4 + i_) * 1024), 16, 0, 0); } } while (0)
        float m_reg = -1e30f, l_reg = 0.f;
        f32x16 o[4];
#pragma unroll
        for (int d = 0; d < 4; ++d)
#pragma unroll
            for (int r = 0; r < 16; ++r) o[d][r] = 0.f;
        asm volatile("s_waitcnt lgkmcnt(0)" ::: "memory"); __builtin_amdgcn_s_barrier();
        ATT_STAGE(0);
        for (int t = 0; t < NT; ++t) {
            asm volatile("s_waitcnt vmcnt(0)" ::: "memory"); __builtin_amdgcn_s_barrier(); asm volatile("" ::: "memory");
            if (t + 1 < NT) ATT_STAGE(t + 1);
            bool need = true;
            if (MODE == 0) need = (w2 == 0) ? (t < 5) : (t > 0);
            else if (MODE == 1) need = (w2 == 0) ? (t < 9) : (t > 0);
            else { const int kr = rbase + t, ra = qr0 + 2 * w2; int rsA = ra - 4; rsA = rsA < 0 ? 0 : (rsA > 24 ? 24 : rsA); int rsB = ra - 3; rsB = rsB < 0 ? 0 : (rsB > 24 ? 24 : rsB); need = (kr >= rsA) && (kr < rsB + 8); }
            if (!need) continue;
            LAS unsigned char* const Kb = pbase + (t & 1) * 16384;
            f32x16 p0;
#pragma unroll
            for (int r = 0; r < 16; ++r) p0[r] = 0.f;
#pragma unroll
            for (int d0 = 0; d0 < 8; ++d0) { const int cb = (d0 * 16 + hi * 8) * 2;
                const bf16x8 kf = *(const LAS bf16x8*)(Kb + ATT_KSWZ(r32, cb));
                p0 = __builtin_amdgcn_mfma_f32_32x32x16_bf16(kf, qr[d0], p0, 0, 0, 0); }
            if (MODE != 2) {
                const int kb_i = l0 - HW + 32 * t + 4 * hi;
                const float fb = (float)(kb_i - lq);
#pragma unroll
                for (int r = 0; r < 16; ++r) { const float fd = fb + (float)crowc(r); const bool ok = (fabsf(fd) <= (float)HW) && ((unsigned)(kb_i + crowc(r)) < (unsigned)L);
                    p0[r] = ok ? fmaf(p0[r], CSC, -slopeL2 * fabsf(fd)) : -INFINITY; }
            } else {
                int rs_ = qrow - 4; rs_ = rs_ < 0 ? 0 : (rs_ > 24 ? 24 : rs_); int cs_ = qcl - 8; cs_ = cs_ < 0 ? 0 : (cs_ > 48 ? 48 : cs_);
                const int kr = rbase + t; const bool inr = (unsigned)(kr - rs_) < 8u;
                const int kcb = c0 + 4 * hi;
                const LAS float* bp = rpbt + RPB_PAD + (kr - qrow + 7) * 31 + (kcb - qcl + 15);
#pragma unroll
                for (int r = 0; r < 16; ++r) { const bool ok = inr && ((unsigned)(kcb + crowc(r) - cs_) < 16u);
                    p0[r] = ok ? fmaf(p0[r], CSC, bp[crowc(r)]) : -INFINITY; }
            }
            float pmax = p0[0];
#pragma unroll
            for (int r = 1; r < 16; ++r) pmax = fmaxf(pmax, p0[r]);
            { auto rr = __builtin_amdgcn_permlane32_swap(__float_as_uint(pmax), __float_as_uint(pmax), false, false); pmax = fmaxf(__uint_as_float(rr[0]), __uint_as_float(rr[1])); }
            float alpha = 1.f;
            if (!__all(pmax - m_reg <= THR_L2)) { const float mn = fmaxf(m_reg, pmax); alpha = __builtin_amdgcn_exp2f(m_reg - mn); m_reg = mn; }
            float ps = 0.f;
#pragma unroll
            for (int r = 0; r < 16; ++r) { p0[r] = __builtin_amdgcn_exp2f(p0[r] - m_reg); ps += p0[r]; }
            { auto rr = __builtin_amdgcn_permlane32_swap(__float_as_uint(ps), __float_as_uint(ps), false, false); ps = __uint_as_float(rr[0]) + __uint_as_float(rr[1]); }
            l_reg = l_reg * alpha + ps;
            bf16x8 pa0, pa1;
#define ATT_PK4(P, BASE, OUT) do { unsigned a0 = cvtpk(P[BASE + 0], P[BASE + 1]), a1 = cvtpk(P[BASE + 2], P[BASE + 3]); \
        unsigned b0 = cvtpk(P[BASE + 4], P[BASE + 5]), b1 = cvtpk(P[BASE + 6], P[BASE + 7]); \
        auto r0 = __builtin_amdgcn_permlane32_swap(a0, b0, false, false); auto r1 = __builtin_amdgcn_permlane32_swap(a1, b1, false, false); \
        u32x4 w = {r0[0], r1[0], r0[1], r1[1]}; OUT = *reinterpret_cast<bf16x8*>(&w); } while (0)
            ATT_PK4(p0, 0, pa0); ATT_PK4(p0, 8, pa1);
#undef ATT_PK4
            if (__any(alpha < 1.f)) { if (hi == 0) scr[r32] = alpha; asm volatile("s_waitcnt lgkmcnt(0)" ::: "memory");
#pragma unroll
                for (int r = 0; r < 16; ++r) { const float a = scr[crowc(r) + 4 * hi];
#pragma unroll
                    for (int d = 0; d < 4; ++d) o[d][r] *= a; } }
            const int vb = vb0 + (t & 1) * 16384;
            pv_one<0>(o[0], vb, pa0, pa1); pv_one<1>(o[1], vb, pa0, pa1); pv_one<2>(o[2], vb, pa0, pa1); pv_one<3>(o[3], vb, pa0, pa1);
        }
        float fin;
        if (MODE == 1) { const float sk = extra[h] * LOG2E; const float mf = fmaxf(m_reg, sk); const float a = __builtin_amdgcn_exp2f(m_reg - mf); const float lf = l_reg * a + __builtin_amdgcn_exp2f(sk - mf); fin = a / lf; }
        else fin = 1.0f / l_reg;
        asm volatile("s_waitcnt lgkmcnt(0)" ::: "memory");
        if (hi == 0) scr[r32] = fin;
        asm volatile("s_waitcnt lgkmcnt(0)" ::: "memory");
        if (MODE == 0 && hi == 0) lsebuf[((size_t)pat * M + (size_t)b * SEQ + sq) * 8 + h] = m_reg + __log2f(l_reg);
#pragma unroll
        for (int r = 0; r < 16; ++r) { const int qi = crowc(r) + 4 * hi; const float f = scr[qi];
            int sqi; if (MODE == 2) sqi = (qr0 + 2 * w2 + (qi >> 4)) * 64 + qc0 + (qi & 15); else sqi = ((l0 + 32 * w2 + qi) << shift) + jres;
            const size_t tokq = (size_t)b * SEQ + sqi;
            if (MODE == 0) { _Float16* op = (_Float16*)part + ((size_t)pat * M + tokq) * 1024 + h * HD + r32;
#pragma unroll
                for (int d = 0; d < 4; ++d) op[32 * d] = (_Float16)(o[d][r] * f); }
            else { bf16* op = O + tokq * D + ((MODE == 1) ? 1024 : 0) + h * HD + r32;
#pragma unroll
                for (int d = 0; d < 4; ++d) op[32 * d] = (bf16)f2bf(o[d][r] * f); } }
#undef ATT_STAGE
#undef ATT_KEYTOK
    }
    asm volatile("s_waitcnt vmcnt(0) lgkmcnt(0)" ::: "memory"); __builtin_amdgcn_s_barrier();
}
__device__ __forceinline__ void attn_combine(const Frame& F, const float* part, const float* lsebuf, bf16* O, const int stream) {
    int lane = F.lane; asm volatile("" : "+v"(lane));
    const int gw = F.bid * NWAVES + F.wave, NGW = F.G * NWAVES;
    typedef _Float16 f16x2 __attribute__((ext_vector_type(2)));
    const _Float16* ph = (const _Float16*)part;
    constexpr int CB = 4;
    for (int it0 = gw; it0 < MH * 8; it0 += CB * NGW) {
        float e[CB][3]; f16x2 pv[CB][3]; int tokv[CB], hv[CB]; bool ok[CB];
#pragma unroll
        for (int j = 0; j < CB; ++j) { const int it = it0 + j * NGW; ok[j] = it < MH * 8; const int itc = ok[j] ? it : gw; tokv[j] = stream * MH + (itc >> 3); hv[j] = itc & 7;
#pragma unroll
            for (int p = 0; p < 3; ++p) { e[j][p] = lsebuf[((size_t)p * M + tokv[j]) * 8 + hv[j]]; pv[j][p] = *(const f16x2*)(ph + (size_t)p * M * 1024 + (size_t)tokv[j] * 1024 + hv[j] * HD + 2 * lane); } }
#pragma unroll
        for (int j = 0; j < CB; ++j) {
            const float mx = fmaxf(e[j][0], fmaxf(e[j][1], e[j][2])); float w0 = __builtin_amdgcn_exp2f(e[j][0] - mx), w1 = __builtin_amdgcn_exp2f(e[j][1] - mx), w2 = __builtin_amdgcn_exp2f(e[j][2] - mx);
            const float inv = 1.0f / (w0 + w1 + w2); w0 *= inv; w1 *= inv; w2 *= inv;
            if (ok[j]) ((unsigned*)(O + (size_t)tokv[j] * D + hv[j] * HD))[lane] = pk2(w0 * (float)pv[j][0].x + w1 * (float)pv[j][1].x + w2 * (float)pv[j][2].x, w0 * (float)pv[j][0].y + w1 * (float)pv[j][1].y + w2 * (float)pv[j][2].y);
        }
    }
}
}

__global__ void __launch_bounds__(NWAVES * 64, 2) fwd(Args a) {
    extern __shared__ __attribute__((aligned(16))) unsigned char lds[];
    Frame F;
    F.lds = (LAS unsigned char*)lds;
    F.wave = __builtin_amdgcn_readfirstlane((int)threadIdx.x >> 6); F.lane = 0; F.tid = 0;
    F.G = gridDim.x; F.bid = blockIdx.x;
    for (int u = (int)threadIdx.x; u < (LDS_BYTES - LDSCTL_OFF) / 4; u += NWAVES * 64) ((LAS unsigned*)(F.lds + LDSCTL_OFF))[u] = 0u;
    __syncthreads();
    XcdBarrier bar = xcd_barrier_post((unsigned*)(a.ws + WS_CTL) + CW_BAR, (volatile LAS unsigned*)(F.lds + MISC_OFF) + 8, F.wave);
#define PH_ENTER() Frame Fp = F; unsigned char* ws = a.ws; float* xo = a.out; asm volatile("" : "+s"(Fp.bid), "+s"(Fp.wave), "+s"(Fp.G), "+s"(ws), "+s"(xo)); \
    asm volatile("v_mbcnt_lo_u32_b32 %0, -1, 0\n\tv_mbcnt_hi_u32_b32 %0, -1, %0" : "=v"(Fp.lane)); Fp.tid = Fp.wave * 64 + Fp.lane;     \
    bf16* const Hb = (bf16*)(ws + WS_H); bf16* const Ub = (bf16*)(ws + WS_U); bf16* const QKVb = (bf16*)(ws + WS_QKV); bf16* const Ob = (bf16*)(ws + WS_O); float* const Pb = (float*)(ws + WS_PART); float* const Lb = (float*)(ws + WS_LSE); \
    int vc = Fp.bid - off; if (vc < 0) vc += Fp.G; const size_t rowoff = (size_t)s * MH; \
    (void)Hb; (void)Ub; (void)QKVb; (void)Ob; (void)Pb; (void)Lb; (void)xo; (void)vc; (void)rowoff
#define ITEM_BEGIN() for (int s = 0; s < NSTREAM; ++s) { if (T >= NSTREAM) sb_wait(bar, (unsigned*)(a.ws + WS_SB), T - NSTREAM);
#define ITEM_END(nunits) sb_arrive(bar, (unsigned*)(a.ws + WS_SB), T); ++T; off = (off + (nunits)) % F.G; }
    int T = 0, off = 0;
    { const int s = 0; PH_ENTER(); p0_prologue(Fp, a); }
    xcd_barrier(bar);
    for (int layer = 0; layer < DEPTH; ++layer) {
        const bool even = (layer & 1) == 0; const int li = layer >> 1;
        for (int sub = 0; sub < 3; ++sub) {
            const int lf = layer * 2 + (sub == 2 ? 1 : 0);
            const int sb = layer * 3 + sub;
            const int N1 = (sub == 1) ? (even ? AB_IN : C_IN) : 2 * FF;
            ITEM_BEGIN() { PH_ENTER();
                if (sub == 1) {
                    const bf16* W = even ? (const bf16*)(ws + WS_WABIN + (size_t)li * SZ_WABIN) : (const bf16*)(ws + WS_WCIN + (size_t)li * SZ_WCIN);
                    pg8::Gemm g{Hb + rowoff * D, W, MH, N1, D}; pg8::StaticOrder S; S.init(MH, N1, Fp.G, vc);
                    pg8::EpiBf16 E{QKVb + rowoff * N1, N1, (const pg8::ssq_t*)(ws + WS_SSQ) + (size_t)sb * M + rowoff};
                    pg8::gemm_phase<pg8::EpiBf16, pg8::StaticOrder, true, true, 0, RESID_F16 != 0>(Fp.lds + RING_OFF, g, S, E, Fp.tid);
                } else {
                    pg8::Gemm g{Hb + rowoff * D, (const bf16*)(ws + WS_WGU + (size_t)lf * SZ_WGU), MH, 2 * FF, D}; pg8::StaticOrder S; S.init(MH, 2 * FF, Fp.G, vc);
                    pg8::EpiSwiglu E{Ub + rowoff * FF, FF, (const pg8::ssq_t*)(ws + WS_SSQ) + (size_t)sb * M + rowoff};
                    pg8::gemm_phase<pg8::EpiSwiglu, pg8::StaticOrder, true, true, 0, RESID_F16 != 0>(Fp.lds + RING_OFF, g, S, E, Fp.tid);
                }
            } ITEM_END((MH / 256) * (N1 / 256))
            if (sub == 1) {
                if (even) {
                    ITEM_BEGIN() { PH_ENTER(); att::attn_mfma<0>(Fp, QKVb, AB_IN, Ob, Pb, Lb, nullptr, s, vc); } ITEM_END(3072 / NSTREAM / 4)
                    ITEM_BEGIN() { PH_ENTER(); att::attn_mfma<1>(Fp, QKVb, AB_IN, Ob, Pb, Lb, a.ab_sink + li * 8, s, vc); att::attn_combine(Fp, Pb, Lb, Ob, s); } ITEM_END(1024 / NSTREAM / 4)
                } else {
                    ITEM_BEGIN() { PH_ENTER(); att::attn_mfma<2>(Fp, QKVb, C_IN, Ob, Pb, Lb, a.c_rpb + (size_t)li * 16 * 15 * 31, s, vc); } ITEM_END(2048 / NSTREAM / 4)
                }
            }
            ITEM_BEGIN() { PH_ENTER();
                const bf16* A2 = (sub == 1) ? (const bf16*)(Ob + rowoff * D) : (const bf16*)(Ub + rowoff * FF); const int K2 = (sub == 1) ? D : FF;
                const bf16* W2 = (sub == 1) ? (even ? (const bf16*)(ws + WS_WABOUT + (size_t)li * SZ_WOUT) : (const bf16*)(ws + WS_WCOUT + (size_t)li * SZ_WOUT))
                                            : (const bf16*)(ws + WS_WD + (size_t)lf * SZ_WD);
                pg8::Gemm g{A2, W2, MH, D, K2}; pg8::StaticOrder S; S.init(MH, D, Fp.G, vc);
                pg8::EpiResidH E{Hb + rowoff * D, D, (sub == 1) ? 1.0f : 0.5f, Hb + rowoff * D, (pg8::ssq_t*)(ws + WS_SSQ) + (size_t)(sb + 1) * M + rowoff};
                pg8::gemm_phase<pg8::EpiResidH, pg8::StaticOrder, true, true>(Fp.lds + RING_OFF, g, S, E, Fp.tid);
            } ITEM_END((MH / 256) * (D / 256))
        }
    }
    ITEM_BEGIN() { PH_ENTER(); final_norm_h_phase(Fp, Hb, xo, a.final_norm, (const pg8::ssq_t*)(ws + WS_SSQ) + (size_t)12 * M, s); } ITEM_END(0)
#undef PH_ENTER
#undef ITEM_BEGIN
#undef ITEM_END
}

extern "C" void kernel_launch(void* const* d_in, const int* in_sizes, int n_in, void* d_out, int out_size, void* d_ws, size_t ws_size, hipStream_t stream) {
    static int grid = 0;
    if (grid == 0) {
        if (n_in != 13 || in_sizes[0] != M * D || out_size != M * D || ws_size < WS_END) { fprintf(stderr, "kernel_launch: unexpected shapes (n_in %d, in0 %d, out %d, ws %zu, need %zu); nothing launched\n", n_in, n_in > 0 ? in_sizes[0] : -1, out_size, ws_size, (size_t)WS_END); grid = -1; return; }
        int dev = 0, cus = 0, per_cu = 0;
        if (hipGetDevice(&dev) != hipSuccess || hipDeviceGetAttribute(&cus, hipDeviceAttributeMultiprocessorCount, dev) != hipSuccess) { fprintf(stderr, "kernel_launch: device query failed\n"); grid = -1; return; }
        if (hipFuncSetAttribute((const void*)fwd, hipFuncAttributeMaxDynamicSharedMemorySize, LDS_BYTES) != hipSuccess) { fprintf(stderr, "kernel_launch: hipFuncSetAttribute failed\n"); grid = -1; return; }
        if (hipOccupancyMaxActiveBlocksPerMultiprocessor(&per_cu, (const void*)fwd, NWAVES * 64, LDS_BYTES) != hipSuccess || per_cu < 1)
            fprintf(stderr, "kernel_launch: note: occupancy query reports %d workgroups per CU\n", per_cu);
        (void)hipGetLastError();
        grid = cus;
    }
    if (grid < 0) return;
    if (hipMemsetAsync((char*)d_ws + WS_CTL, 0, CTL_ZERO_BYTES, stream) != hipSuccess) { fprintf(stderr, "kernel_launch: memset failed\n"); return; }
    Args a{};
    a.x = (const float*)d_in[0]; a.ffn_norm = (const float*)d_in[1]; a.wg = (const float*)d_in[2]; a.wu = (const float*)d_in[3]; a.wd = (const float*)d_in[4]; a.mix_norm = (const float*)d_in[5];
    a.ab_in = (const float*)d_in[6]; a.ab_out = (const float*)d_in[7]; a.ab_sink = (const float*)d_in[8]; a.c_in = (const float*)d_in[9]; a.c_out = (const float*)d_in[10]; a.c_rpb = (const float*)d_in[11];
    a.final_norm = (const float*)d_in[12]; a.out = (float*)d_out; a.ws = (unsigned char*)d_ws;
    a.ph_lo = 0; a.ph_hi = 0; hipLaunchKernelGGL(fwd, dim3(grid), dim3(NWAVES * 64), LDS_BYTES, stream, a);
    const hipError_t le = hipPeekAtLastError();
    if (le != hipSuccess) fprintf(stderr, "kernel_launch: launch failed: %s\n", hipGetErrorName(le));
}
```

```cpp
#include <hip/hip_runtime.h>
#include <cstdio>
#include <cstdint>

#ifndef PROBE_ABL
#define PROBE_ABL 0
#endif
#ifndef RESID_F16
#define RESID_F16 1
#endif

namespace pg8 {
#define PG8_LAS __attribute__((address_space(3)))
typedef unsigned short bf16_t;
typedef short bf16x8 __attribute__((ext_vector_type(8)));
typedef _Float16 f16x8 __attribute__((ext_vector_type(8)));
typedef _Float16 f16x4 __attribute__((ext_vector_type(4)));
typedef float f32x4 __attribute__((ext_vector_type(4)));
typedef unsigned u32x4 __attribute__((ext_vector_type(4)));
constexpr int BM = 256, BK = 64, HALF = 128, HTB = HALF * BK * 2  , STAGE_BYTES = 8 * HTB, NXCD = 8, WGM = 8;

__host__ __device__ __forceinline__ int lds_byte(int r, int c) { const int st = (r >> 4) * 2 + (c >> 5), rr = r & 15, cc = c & 31, ob = rr * 64 + cc * 2; return st * 1024 + (ob ^ (((ob >> 9) & 1) << 5)); }
__host__ __device__ __forceinline__ void stage_rc(int b, int& R, int& C) { const int st = b / 1024, sb = b % 1024, swz = sb ^ (((sb >> 9) & 1) << 5); R = (st >> 1) * 16 + swz / 64; C = (st & 1) * 32 + (swz % 64) / 2; }
__host__ __device__ __forceinline__ int perm32(int rho) { const int n = rho >> 4, i = rho & 15; return 8 * (i >> 2) + 4 * n + (i & 3); }

struct Unit { int pm, pn; };
struct Gemm { const bf16_t* A; const bf16_t* Bt; int M, N, K; };

struct StaticOrder {
    int nM, nN, nwg, G, c;
    __host__ __device__ void init(int M, int N, int G_, int c_) { nM = M / BM; nN = N / BM; nwg = nM * nN; G = G_; c = c_; }
    __host__ __device__ bool next(int i, Unit& u) const {
        const long L = (long)i * G + c; if (L >= nwg) return false;
        int wgid = (int)L; { const int q = nwg / NXCD, r = nwg % NXCD, xcd = wgid % NXCD, off = wgid / NXCD; wgid = (xcd < r ? xcd * (q + 1) : r * (q + 1) + (xcd - r) * q) + off; }
        const int nig = WGM * nN, gid = wgid / nig, fm = gid * WGM, gsz = (nM - fm) < WGM ? (nM - fm) : WGM;
        u.pm = fm + ((wgid % nig) % gsz); u.pn = (wgid % nig) / gsz; return true;
    }
    __device__ __forceinline__ void a_ready(const Unit&) const {}
    __device__ __forceinline__ void done(const Unit&) const {}
};


__device__ __forceinline__ unsigned cvt_pk_bf16(float lo, float hi) { unsigned r; asm volatile("v_cvt_pk_bf16_f32 %0, %1, %2" : "=v"(r) : "v"(lo), "v"(hi)); return r; }

__device__ __forceinline__ int lane_id_here() { int l; asm volatile("v_mbcnt_lo_u32_b32 %0, -1, 0\n\tv_mbcnt_hi_u32_b32 %0, -1, %0" : "=v"(l)); return l; }
__device__ __forceinline__ float xor_shfl(float v, int mask, int lane) { return __builtin_bit_cast(float, __builtin_amdgcn_ds_bpermute((lane ^ mask) << 2, __builtin_bit_cast(int, v))); }
typedef unsigned long long ssq_t;
__device__ __forceinline__ ssq_t ssq_fix(float s) { const int hi = (int)s; const int lo = (int)((s - (float)hi) * 16777216.0f); return ((ssq_t)(unsigned)hi << 24) + (ssq_t)(unsigned)lo; }
__device__ __forceinline__ float ssq_val(ssq_t v) { return (float)(unsigned)(v >> 24) + (float)(unsigned)(v & 0xFFFFFFull) * (1.0f / 16777216.0f); }
__device__ __forceinline__ float row_rstd(const ssq_t* ssq, int row) { return 1.0f / sqrtf(ssq_val(ssq[row]) * (1.0f / 2048.0f) + 1e-6f); }
struct PreSsq { ssq_t v[2][4]; };
__device__ __forceinline__ void pre_ssq_issue(PreSsq& p, const ssq_t* ssq, int row0) {
    typedef __attribute__((address_space(1))) const ssq_t gssq_t;
    gssq_t* a = (gssq_t*)ssq + row0;
    asm volatile("global_load_dwordx2 %0, %1, off" : "=v"(p.v[0][0]) : "v"(a));
    asm volatile("global_load_dwordx2 %0, %1, off offset:128" : "=v"(p.v[0][1]) : "v"(a));
    asm volatile("global_load_dwordx2 %0, %1, off offset:256" : "=v"(p.v[0][2]) : "v"(a));
    asm volatile("global_load_dwordx2 %0, %1, off offset:384" : "=v"(p.v[0][3]) : "v"(a));
    asm volatile("global_load_dwordx2 %0, %1, off offset:1024" : "=v"(p.v[1][0]) : "v"(a));
    asm volatile("global_load_dwordx2 %0, %1, off offset:1152" : "=v"(p.v[1][1]) : "v"(a));
    asm volatile("global_load_dwordx2 %0, %1, off offset:1280" : "=v"(p.v[1][2]) : "v"(a));
    asm volatile("global_load_dwordx2 %0, %1, off offset:1408" : "=v"(p.v[1][3]) : "v"(a));
}
__device__ __forceinline__ void pre_ssq_wait(PreSsq& p) {
    asm volatile("s_waitcnt vmcnt(16)" : "+v"(p.v[0][0]), "+v"(p.v[0][1]), "+v"(p.v[0][2]), "+v"(p.v[0][3]), "+v"(p.v[1][0]), "+v"(p.v[1][1]), "+v"(p.v[1][2]), "+v"(p.v[1][3]) :: "memory");
}
__device__ __forceinline__ void rows_rstd(const PreSsq& p, float (&rs)[2][4]) {
#pragma unroll
    for (int ai = 0; ai < 2; ++ai)
#pragma unroll
        for (int m = 0; m < 4; ++m) rs[ai][m] = __builtin_amdgcn_rsqf(ssq_val(p.v[ai][m]) * (1.0f / 2048.0f) + 1e-6f);
}
typedef __attribute__((address_space(1))) u32x4 gu32x4;
struct EpiBf16 {
    static constexpr bool PERM = true, AFTER_DRAIN = false, HAS_INIT = false, HAS_PRE = true;
    typedef PreSsq Pre;
    bf16_t* O; int ldc; const ssq_t* ssq;
    __device__ __forceinline__ void pre_issue(Pre& p, const Unit& u, int wr, int wc, int fr, int fq) const { pre_ssq_issue(p, ssq, u.pm * BM + wr * 64 + fr); }
    __device__ __forceinline__ void pre_wait(Pre& p) const { pre_ssq_wait(p); }
    __device__ __forceinline__ void operator()(const f32x4 (&acc)[2][2][4][2], const Unit& u, int wr, int wc, int fr, int fq, const Pre& pre) const {
        const int row0 = u.pm * BM + wr * 64 + fr; const int col0 = u.pn * BM + wc * 32 + 8 * fq;
        float rsv[2][4]; rows_rstd(pre, rsv);
#pragma unroll
        for (int ai = 0; ai < 2; ++ai)
#pragma unroll
            for (int m = 0; m < 4; ++m) { const int row = row0 + ai * HALF + m * 16; const float rs = rsv[ai][m]; bf16_t* rowp = O + (size_t)row * ldc + col0;
#pragma unroll
                for (int bj = 0; bj < 2; ++bj) { const f32x4 v0 = acc[ai][bj][m][0] * rs, v1 = acc[ai][bj][m][1] * rs;
                    u32x4 w; w.x = cvt_pk_bf16(v0[0], v0[1]); w.y = cvt_pk_bf16(v0[2], v0[3]); w.z = cvt_pk_bf16(v1[0], v1[1]); w.w = cvt_pk_bf16(v1[2], v1[3]);
                    *(gu32x4*)(rowp + bj * HALF) = w; } }
    }
};
struct EpiSwiglu {
    static constexpr bool PERM = true, AFTER_DRAIN = false, HAS_INIT = false, HAS_PRE = true;
    typedef PreSsq Pre;
    bf16_t* O; int ldc; const ssq_t* ssq;
    __device__ __forceinline__ void pre_issue(Pre& p, const Unit& u, int wr, int wc, int fr, int fq) const { pre_ssq_issue(p, ssq, u.pm * BM + wr * 64 + fr); }
    __device__ __forceinline__ void pre_wait(Pre& p) const { pre_ssq_wait(p); }
    __device__ __forceinline__ void operator()(const f32x4 (&acc)[2][2][4][2], const Unit& u, int wr, int wc, int fr, int fq, const Pre& pre) const {
        const int row0 = u.pm * BM + wr * 64 + fr; const int col0 = u.pn * HALF + wc * 32 + 8 * fq;
        float rsv[2][4]; rows_rstd(pre, rsv);
#pragma unroll
        for (int ai = 0; ai < 2; ++ai)
#pragma unroll
            for (int m = 0; m < 4; ++m) { const int row = row0 + ai * HALF + m * 16; const float rs = rsv[ai][m]; bf16_t* rowp = O + (size_t)row * ldc + col0;
                float r[8];
#pragma unroll
                for (int n = 0; n < 2; ++n)
#pragma unroll
                    for (int j = 0; j < 4; ++j) { const float g = acc[ai][0][m][n][j] * rs, up = acc[ai][1][m][n][j] * rs;
                        r[n * 4 + j] = g * __builtin_amdgcn_rcpf(1.0f + __expf(-g)) * up; }
                u32x4 w; w.x = cvt_pk_bf16(r[0], r[1]); w.y = cvt_pk_bf16(r[2], r[3]); w.z = cvt_pk_bf16(r[4], r[5]); w.w = cvt_pk_bf16(r[6], r[7]);
                *(gu32x4*)rowp = w; }
    }
};
struct EpiResidH {
    static constexpr bool PERM = true, AFTER_DRAIN = false, HAS_INIT = false, HAS_PRE = true;
    struct Pre { f16x8 t[2][2]; };
    const bf16_t* xin; int ldc; float scale; bf16_t* xb; ssq_t* ssq_out;
    __device__ __forceinline__ unsigned lane_off(const Unit& u, int wr, int wc, int fr, int fq) const { return (unsigned)(((u.pm * BM + wr * 64 + fr) * ldc + u.pn * BM + wc * 32 + 8 * fq) * 2); }
    __device__ __forceinline__ void issue_batch(f16x8 (&t)[2][2], unsigned voff, int ai, int mp) const {
        const char* xr = (const char*)xin; asm volatile("" : "+s"(xr));
#pragma unroll
        for (int mm = 0; mm < 2; ++mm) { const char* sb = xr + (size_t)((ai * HALF + (2 * mp + mm) * 16) * ldc) * 2;
            asm volatile("global_load_dwordx4 %0, %1, %2" : "=v"(t[mm][0]) : "v"(voff), "s"(sb));
            asm volatile("global_load_dwordx4 %0, %1, %2 offset:256" : "=v"(t[mm][1]) : "v"(voff), "s"(sb)); }
    }
    __device__ __forceinline__ void pre_issue(Pre& p, const Unit& u, int wr, int wc, int fr, int fq) const { issue_batch(p.t, lane_off(u, wr, wc, fr, fq), 0, 0); }
    __device__ __forceinline__ void pre_wait(Pre& p) const { asm volatile("s_waitcnt vmcnt(16)" : "+v"(p.t[0][0]), "+v"(p.t[0][1]), "+v"(p.t[1][0]), "+v"(p.t[1][1]) :: "memory"); }
    __device__ __forceinline__ void batch(f32x4 (&acc)[2][2][4][2], const f16x8 (&t)[2][2], int ai, int mp, int row0, int col0, int fq, ssq_t (&olds)[8], float sc, bf16_t* xb, ssq_t* ssq_out) const {
        typedef __attribute__((address_space(1))) f16x8 gf16x8;
#pragma unroll
        for (int mm = 0; mm < 2; ++mm) { const int m = 2 * mp + mm, row = row0 + ai * HALF + m * 16; const size_t off = (size_t)row * ldc + col0; float s = 0.f;
#pragma unroll
            for (int bj = 0; bj < 2; ++bj) { const f16x8 b8 = t[mm][bj];
                const f32x4 y0 = __builtin_convertvector(__builtin_shufflevector(b8, b8, 0, 1, 2, 3), f32x4) + acc[ai][bj][m][0] * sc, y1 = __builtin_convertvector(__builtin_shufflevector(b8, b8, 4, 5, 6, 7), f32x4) + acc[ai][bj][m][1] * sc;
                const f16x4 h0 = __builtin_convertvector(y0, f16x4), h1 = __builtin_convertvector(y1, f16x4);
                *(gf16x8*)(xb + off + bj * HALF) = __builtin_shufflevector(h0, h1, 0, 1, 2, 3, 4, 5, 6, 7);
                const f32x4 z0 = __builtin_convertvector(h0, f32x4), z1 = __builtin_convertvector(h1, f32x4);
                s += ((z0[0] * z0[0] + z0[1] * z0[1]) + (z0[2] * z0[2] + z0[3] * z0[3])) + ((z1[0] * z1[0] + z1[1] * z1[1]) + (z1[2] * z1[2] + z1[3] * z1[3])); }
            { const int ln_ = lane_id_here(); s += xor_shfl(s, 16, ln_); s += xor_shfl(s, 32, ln_); }
            olds[ai * 4 + m] = 0;
            if (fq == 0) olds[ai * 4 + m] = __hip_atomic_fetch_add((__attribute__((address_space(1))) ssq_t*)(ssq_out + row), ssq_fix(s), __ATOMIC_RELAXED, __HIP_MEMORY_SCOPE_AGENT); }
    }
#define EPI_WAITB(n, t) asm volatile("s_waitcnt vmcnt(" #n ")" : "+v"(t[0][0]), "+v"(t[0][1]), "+v"(t[1][0]), "+v"(t[1][1]) :: "memory")
    __device__ __forceinline__ void operator()(f32x4 (&acc)[2][2][4][2], const Unit& u, int wr, int wc, int fr, int fq, const Pre& pre) const {
        const int row0 = u.pm * BM + wr * 64 + fr, col0 = u.pn * BM + wc * 32 + 8 * fq;
        const unsigned voff = lane_off(u, wr, wc, fr, fq);
        f16x8 t1[2][2], t2[2][2], t3[2][2];
        issue_batch(t1, voff, 0, 1); issue_batch(t2, voff, 1, 0); issue_batch(t3, voff, 1, 1);
        ssq_t olds[8];
        float sc = scale; bf16_t* xo = xb; ssq_t* so = ssq_out; asm volatile("" : "+s"(sc), "+s"(xo), "+s"(so));
        batch(acc, pre.t, 0, 0, row0, col0, fq, olds, sc, xo, so);
        EPI_WAITB(12, t1);
        batch(acc, t1, 0, 1, row0, col0, fq, olds, sc, xo, so);
        EPI_WAITB(12, t2);
        batch(acc, t2, 1, 0, row0, col0, fq, olds, sc, xo, so);
        EPI_WAITB(12, t3);
        batch(acc, t3, 1, 1, row0, col0, fq, olds, sc, xo, so);
#pragma unroll
        for (int i = 0; i < 8; ++i) asm volatile("" :: "v"(olds[i]));
    }
#undef EPI_WAITB
};

template <class Epi, class Sched, bool ALIGN_EPI = false, bool SP2 = false, int ABL = 0  , bool F16 = false  >
__device__ __forceinline__ void gemm_phase(PG8_LAS unsigned char* lds, const Gemm g, const Sched& S, const Epi& E, int tid_in) {
    int tid_ = tid_in; asm volatile("" : "+v"(tid_));
    const int tid = tid_, wid = __builtin_amdgcn_readfirstlane(tid >> 6), lane = tid & 63, wr = wid >> 2, wc = wid & 3, fr = lane & 15, fq = lane >> 4;
    const int K = g.K, nt = K / BK;
    unsigned voffA[2], voffB[2];
#pragma unroll
    for (int i = 0; i < 2; ++i) { const int R = 8 * (wid + 8 * i) + (lane >> 3), C = (((lane & 7) ^ ((R >> 1) & 7)) << 3); const int Rb = Epi::PERM ? ((R & ~31) + perm32(R & 31)) : R;
        voffA[i] = (unsigned)(R * K + C) * 2u; voffB[i] = (unsigned)(Rb * K + C) * 2u; }
    const unsigned kstep = (unsigned)(BK * 2);
    const unsigned hstep = (unsigned)HALF * (unsigned)K * 2u;
    const unsigned tstep = 2u * hstep;
    const __amdgpu_buffer_rsrc_t rA = __builtin_amdgcn_make_buffer_rsrc((void*)g.A, 0, 0x7ffffff0, 0x00020000), rB = __builtin_amdgcn_make_buffer_rsrc((void*)g.Bt, 0, 0x7ffffff0, 0x00020000);
    const unsigned ldsw = (unsigned)wid * 1024u;
    const int arow = wr * 64 + fr, brow = wc * 32 + fr;
    const int aoff0 = arow * 128 + ((fq ^ ((arow >> 1) & 7)) << 4), aoff1 = aoff0 ^ 64, boff0 = brow * 128 + ((fq ^ ((brow >> 1) & 7)) << 4), boff1 = boff0 ^ 64;
#define PG8_SA(b, h) (((b) * 2 + (h)) * HTB)
#define PG8_SB(b, h) ((4 + (b) * 2 + (h)) * HTB)
#define PG8_STAGE(bufoff, rsrc, goff, voff) do { if (ABL != 2) _Pragma("unroll") for (int _i = 0; _i < 2; ++_i) \
        __builtin_amdgcn_raw_ptr_buffer_load_lds(rsrc, (PG8_LAS void*)(lds + (bufoff) + ldsw + _i * 8192), 16, (voff)[_i], (int)(goff), 0, 0); } while (0)
#define PG8_LDA(dst, b, h) do { if (ABL != 3) _Pragma("unroll") for (int m = 0; m < 4; ++m) { dst[m][0] = *(const PG8_LAS bf16x8*)(lds + PG8_SA(b, h) + aoff0 + m * 2048); dst[m][1] = *(const PG8_LAS bf16x8*)(lds + PG8_SA(b, h) + aoff1 + m * 2048); } } while (0)
#define PG8_LDB(dst, b, h) do { if (ABL != 3) _Pragma("unroll") for (int n = 0; n < 2; ++n) { dst[n][0] = *(const PG8_LAS bf16x8*)(lds + PG8_SB(b, h) + boff0 + n * 2048); dst[n][1] = *(const PG8_LAS bf16x8*)(lds + PG8_SB(b, h) + boff1 + n * 2048); } } while (0)
#define PG8_MMA(ai, bj, At, Bt) do { __builtin_amdgcn_s_setprio(1); _Pragma("unroll") for (int m = 0; m < 4; ++m) _Pragma("unroll") for (int n = 0; n < 2; ++n) _Pragma("unroll") for (int k = 0; k < 2; ++k) { \
        if (ABL == 5) { if (((m & 1) == 0)) acc32[((ai) * 2 + (bj)) * 2 + (m >> 1)] = __builtin_amdgcn_mfma_f32_32x32x16_bf16(Bt[n][k], At[m][k], acc32[((ai) * 2 + (bj)) * 2 + (m >> 1)], 0, 0, 0); else asm volatile("" :: "v"(Bt[n][k]), "v"(At[m][k])); } \
        else if (ABL != 1) { if (F16) acc[ai][bj][m][n] = __builtin_amdgcn_mfma_f32_16x16x32_f16(__builtin_bit_cast(f16x8, Bt[n][k]), __builtin_bit_cast(f16x8, At[m][k]), acc[ai][bj][m][n], 0, 0, 0); \
            else acc[ai][bj][m][n] = __builtin_amdgcn_mfma_f32_16x16x32_bf16(Bt[n][k], At[m][k], acc[ai][bj][m][n], 0, 0, 0); } else asm volatile("" :: "v"(Bt[n][k]), "v"(At[m][k])); } __builtin_amdgcn_s_setprio(0); } while (0)
#define PG8_WAIT_V(n) asm volatile("s_waitcnt vmcnt(" #n ")" ::: "memory")
#define PG8_WAIT_L(n) asm volatile("s_waitcnt lgkmcnt(" #n ")" ::: "memory")
#define PG8_BAR __builtin_amdgcn_s_barrier()
#define PG8_SCHED __builtin_amdgcn_sched_barrier(0)
    Unit cur, nxt; int ui = 0;
    if (!S.next(0, cur)) return;
    f32x4 acc[2][2][4][2];
    if constexpr (Epi::HAS_INIT) E.init(acc, cur, wr, wc, fr, fq);
    else {
#pragma unroll
    for (int a = 0; a < 2; ++a)
#pragma unroll
        for (int b = 0; b < 2; ++b)
#pragma unroll
            for (int m = 0; m < 4; ++m)
#pragma unroll
                for (int n = 0; n < 2; ++n) acc[a][b][m][n] = (f32x4){0.f, 0.f, 0.f, 0.f};
    }
    bf16x8 At[4][2], B0[2][2], B1[2][2];
    typename Epi::Pre pre = {};
    typedef float f32x16_t __attribute__((ext_vector_type(16))); f32x16_t acc32[8];
    if (ABL == 5) { _Pragma("unroll") for (int i = 0; i < 8; ++i) _Pragma("unroll") for (int r = 0; r < 16; ++r) acc32[i][r] = 0.f; }
    if (ABL == 3) { _Pragma("unroll") for (int m = 0; m < 4; ++m) _Pragma("unroll") for (int k = 0; k < 2; ++k) At[m][k] = (bf16x8){1, 2, 3, 4, 5, 6, 7, 8}; _Pragma("unroll") for (int n = 0; n < 2; ++n) _Pragma("unroll") for (int k = 0; k < 2; ++k) { B0[n][k] = (bf16x8){8, 7, 6, 5, 4, 3, 2, 1}; B1[n][k] = (bf16x8){1, 1, 2, 2, 3, 3, 4, 4}; } }
    unsigned cA = (unsigned)cur.pm * tstep, cB = (unsigned)cur.pn * tstep;
    S.a_ready(cur);
    if constexpr (SP2) {
        PG8_STAGE(PG8_SB(0, 0), rB, cB, voffB); PG8_STAGE(PG8_SB(0, 1), rB, cB + hstep, voffB); PG8_STAGE(PG8_SA(0, 0), rA, cA, voffA); PG8_STAGE(PG8_SA(0, 1), rA, cA + hstep, voffA);
        if (wr == 1) PG8_BAR;
        PG8_WAIT_V(2); PG8_BAR;
        PG8_STAGE(PG8_SB(1, 0), rB, cB + kstep, voffB); PG8_STAGE(PG8_SA(1, 0), rA, cA + kstep, voffA); PG8_STAGE(PG8_SB(1, 1), rB, cB + hstep + kstep, voffB);
        PG8_WAIT_V(6); PG8_BAR;
    } else {
        PG8_STAGE(PG8_SB(0, 0), rB, cB, voffB); PG8_STAGE(PG8_SA(0, 0), rA, cA, voffA); PG8_STAGE(PG8_SB(0, 1), rB, cB + hstep, voffB); PG8_STAGE(PG8_SA(0, 1), rA, cA + hstep, voffA);
        if (wr == 1) PG8_BAR;
        PG8_WAIT_V(4); PG8_BAR;
        PG8_STAGE(PG8_SB(1, 0), rB, cB + kstep, voffB); PG8_STAGE(PG8_SA(1, 0), rA, cA + kstep, voffA); PG8_STAGE(PG8_SB(1, 1), rB, cB + hstep + kstep, voffB);
        PG8_WAIT_V(6); PG8_BAR;
    }
    for (;;) {
        const bool has_next = S.next(ui + 1, nxt);
        const unsigned nA = has_next ? (unsigned)nxt.pm * tstep : cA, nB = has_next ? (unsigned)nxt.pn * tstep : cB;
        for (int t = 0; t < nt; t += 2) {
            const bool last = (t == nt - 2);
            const unsigned a1 = cA + (unsigned)(t + 1) * kstep;
            const unsigned a2 = last ? nA : cA + (unsigned)(t + 2) * kstep, b2 = last ? nB : cB + (unsigned)(t + 2) * kstep;
            const unsigned a3 = a2 + kstep, b3 = b2 + kstep;
            if (last && has_next) S.a_ready(nxt);
            if constexpr (Epi::HAS_PRE) { if (last) E.pre_issue(pre, cur, wr, wc, fr, fq); }
            if constexpr (SP2) {
            PG8_LDB(B0, 0, 0); PG8_LDB(B1, 0, 1); PG8_SCHED; PG8_LDA(At, 0, 0); PG8_STAGE(PG8_SA(1, 1), rA, a1 + hstep, voffA);
            PG8_WAIT_V(8); PG8_WAIT_L(0); PG8_BAR; PG8_MMA(0, 0, At, B0); PG8_MMA(0, 1, At, B1); PG8_BAR; PG8_SCHED;
            PG8_LDA(At, 0, 1); PG8_STAGE(PG8_SB(0, 0), rB, b2, voffB); PG8_STAGE(PG8_SB(0, 1), rB, b2 + hstep, voffB); PG8_STAGE(PG8_SA(0, 0), rA, a2, voffA);
            PG8_WAIT_V(8); PG8_WAIT_L(0); PG8_BAR; PG8_MMA(1, 0, At, B0); PG8_MMA(1, 1, At, B1); PG8_BAR; PG8_SCHED;
            PG8_LDB(B0, 1, 0); PG8_LDB(B1, 1, 1); PG8_SCHED; PG8_LDA(At, 1, 0); PG8_STAGE(PG8_SA(0, 1), rA, a2 + hstep, voffA);
            PG8_WAIT_V(8); PG8_WAIT_L(0); PG8_BAR; PG8_MMA(0, 0, At, B0); PG8_MMA(0, 1, At, B1); PG8_BAR; PG8_SCHED;
            PG8_LDA(At, 1, 1); PG8_STAGE(PG8_SB(1, 0), rB, b3, voffB); PG8_STAGE(PG8_SB(1, 1), rB, b3 + hstep, voffB); PG8_STAGE(PG8_SA(1, 0), rA, a3, voffA);
            PG8_WAIT_V(8); PG8_WAIT_L(0); PG8_BAR; PG8_MMA(1, 0, At, B0); PG8_MMA(1, 1, At, B1); PG8_BAR; PG8_SCHED;
            } else {
            PG8_LDB(B0, 0, 0); PG8_SCHED; PG8_LDA(At, 0, 0); PG8_STAGE(PG8_SA(1, 1), rA, a1 + hstep, voffA);
            PG8_WAIT_L(8); PG8_BAR; PG8_WAIT_L(0); PG8_MMA(0, 0, At, B0); PG8_BAR; PG8_SCHED;
            PG8_LDB(B1, 0, 1); PG8_STAGE(PG8_SB(0, 0), rB, b2, voffB);
            PG8_BAR; PG8_WAIT_L(0); PG8_MMA(0, 1, At, B1); PG8_BAR;
            PG8_LDA(At, 0, 1); PG8_STAGE(PG8_SA(0, 0), rA, a2, voffA);
            PG8_BAR; PG8_WAIT_L(0); PG8_MMA(1, 0, At, B0); PG8_BAR; PG8_SCHED;
            PG8_STAGE(PG8_SB(0, 1), rB, b2 + hstep, voffB);
            PG8_WAIT_V(6); PG8_BAR; PG8_MMA(1, 1, At, B1); PG8_BAR;
            PG8_LDB(B0, 1, 0); PG8_SCHED; PG8_LDA(At, 1, 0); PG8_STAGE(PG8_SA(0, 1), rA, a2 + hstep, voffA);
            PG8_WAIT_L(8); PG8_BAR; PG8_WAIT_L(0); PG8_MMA(0, 0, At, B0); PG8_BAR; PG8_SCHED;
            PG8_LDB(B1, 1, 1); PG8_STAGE(PG8_SB(1, 0), rB, b3, voffB);
            PG8_BAR; PG8_WAIT_L(0); PG8_MMA(0, 1, At, B1); PG8_BAR;
            PG8_LDA(At, 1, 1); PG8_STAGE(PG8_SA(1, 0), rA, a3, voffA);
            PG8_BAR; PG8_WAIT_L(0); PG8_MMA(1, 0, At, B0); PG8_BAR; PG8_SCHED;
            PG8_STAGE(PG8_SB(1, 1), rB, b3 + hstep, voffB);
            PG8_WAIT_V(6); PG8_BAR; PG8_MMA(1, 1, At, B1); PG8_BAR;
            }
        }
        if constexpr (ALIGN_EPI) { if (wr == 0) PG8_BAR; }
        if constexpr (!Epi::AFTER_DRAIN) { if constexpr (Epi::HAS_PRE) { E.pre_wait(pre); E(acc, cur, wr, wc, fr, fq, pre); } else E(acc, cur, wr, wc, fr, fq); S.done(cur); }
        if (!has_next) break;
        if constexpr (Epi::HAS_INIT) E.init(acc, nxt, wr, wc, fr, fq);
        else {
#pragma unroll
        for (int a = 0; a < 2; ++a)
#pragma unroll
            for (int b = 0; b < 2; ++b)
#pragma unroll
                for (int m = 0; m < 4; ++m)
#pragma unroll
                    for (int n = 0; n < 2; ++n) acc[a][b][m][n] = (f32x4){0.f, 0.f, 0.f, 0.f};
        }
        cur = nxt; cA = nA; cB = nB; ++ui;
        if constexpr (ALIGN_EPI) { if (wr == 1) PG8_BAR; }
    }
    PG8_WAIT_V(0);
    if constexpr (!ALIGN_EPI) { if (wr == 0) PG8_BAR; }
    PG8_BAR;
    if constexpr (Epi::AFTER_DRAIN) { E.fused(acc, cur, wr, wc, fr, fq, lds, wid, lane); S.done(cur); }
    if (ABL == 5) { _Pragma("unroll") for (int i = 0; i < 8; ++i) asm volatile("" :: "v"(acc32[i])); }
#undef PG8_SA
#undef PG8_SB
#undef PG8_STAGE
#undef PG8_LDA
#undef PG8_LDB
#undef PG8_MMA
#undef PG8_WAIT_V
#undef PG8_WAIT_L
#undef PG8_BAR
#undef PG8_SCHED
}
}

constexpr int NWAVES = 8;
constexpr int D = 2048, BATCH = 4, SEQ = 2048, DEPTH = 4, HD = 128, FF = 5632;
constexpr int M = BATCH * SEQ;
constexpr int AB_IN = 4608, C_IN = 6144;
constexpr float RMS_EPS = 1e-6f;
constexpr float QK_SCALE = 0.08838834764831845f;

constexpr size_t MiB = 1u << 20;
constexpr size_t WS_CTL = 0, CTL_ZERO_BYTES = 1 * MiB;
constexpr size_t SZ_WGU = (size_t)2 * FF * D * 2, SZ_WD = (size_t)D * FF * 2, SZ_WABIN = (size_t)AB_IN * D * 2, SZ_WOUT = (size_t)D * D * 2, SZ_WCIN = (size_t)C_IN * D * 2;
constexpr size_t WS_WGU = 2 * MiB;
constexpr size_t WS_WD = WS_WGU + 8 * SZ_WGU;
constexpr size_t WS_WABIN = WS_WD + 8 * SZ_WD;
constexpr size_t WS_WABOUT = WS_WABIN + 2 * SZ_WABIN;
constexpr size_t WS_WCIN = WS_WABOUT + 2 * SZ_WOUT;
constexpr size_t WS_WCOUT = WS_WCIN + 2 * SZ_WCIN;
constexpr size_t WS_H = WS_WCOUT + 2 * SZ_WOUT;
constexpr size_t WS_U = WS_H + (size_t)M * D * 2;
constexpr size_t WS_QKV = WS_U + (size_t)M * FF * 2;
constexpr size_t WS_O = WS_QKV + (size_t)M * C_IN * 2;
constexpr size_t WS_PART = WS_O + (size_t)M * D * 2;
constexpr size_t WS_LSE = WS_PART + (size_t)3 * M * 1024 * 4;
constexpr size_t WS_END = WS_LSE + (size_t)3 * M * 8 * 4;
constexpr int CW_BAR = 4096;
constexpr size_t WS_SSQ = 65536;
constexpr size_t WS_SB = 917504;
static_assert(WS_SB >= WS_SSQ + (size_t)13 * 8192 * 8 && WS_SB + 128 * 17 * 32 <= CTL_ZERO_BYTES, "token-barrier counters inside the memset region");
#ifndef NSTREAMS
#define NSTREAMS 2
#endif
constexpr int NSTREAM = NSTREAMS, MH = M / NSTREAM;
static_assert(WS_SSQ + (size_t)13 * 8192 * 8 <= CTL_ZERO_BYTES, "ssq slots inside the memset region");

constexpr int RING_OFF = 0, RING_BYTES = 131072;
constexpr int LDSCTL_OFF = RING_BYTES, MISC_OFF = LDSCTL_OFF + 320;
constexpr int LDS_BYTES = 147456;
static_assert(MISC_OFF + 128 <= LDS_BYTES, "LDS map");

#define GAS __attribute__((address_space(1)))
#define LAS __attribute__((address_space(3)))
typedef unsigned short bf16;
typedef unsigned v4u __attribute__((ext_vector_type(4)));
typedef unsigned v2u __attribute__((ext_vector_type(2)));
typedef float f32x4 __attribute__((ext_vector_type(4)));
typedef GAS unsigned gu32;
#define RLX_AGENT __ATOMIC_RELAXED, __HIP_MEMORY_SCOPE_AGENT
#define LDS_WAIT() asm volatile("s_waitcnt lgkmcnt(0)" ::: "memory")
#define VM_WAIT() asm volatile("s_waitcnt vmcnt(0)" ::: "memory")
__device__ __forceinline__ unsigned f2bf(float f) { unsigned u = __builtin_bit_cast(unsigned, f); return (u + 0x7fffu + ((u >> 16) & 1u)) >> 16; }
__device__ __forceinline__ unsigned pk2(float lo, float hi) { return f2bf(lo) | (f2bf(hi) << 16); }
typedef _Float16 h2_t __attribute__((ext_vector_type(2))); typedef float f2_t __attribute__((ext_vector_type(2))); typedef _Float16 h4_t __attribute__((ext_vector_type(4)));
__device__ __forceinline__ unsigned pkh2(float lo, float hi) { const f2_t v = {lo, hi}; return __builtin_bit_cast(unsigned, __builtin_convertvector(v, h2_t)); }
__device__ __forceinline__ float bflo(unsigned w) { return __builtin_bit_cast(float, w << 16); }
__device__ __forceinline__ float bfhi(unsigned w) { return __builtin_bit_cast(float, w & 0xffff0000u); }

#define XB_TMO      128
#define XB_XCNT(j)  (256  + 64 * (j))
#define XB_XSUB(j)  (1280 + 64 * (j))
#define XB_XGEN(j)  (2304 + 64 * (j))
#define XB_TOP      3328
#define XB_TOPGEN   3392
#define XCD_BAR_WORDS 3456
#define XB_SPIN_CAP (1u << 18)

__device__ __forceinline__ unsigned xb_ld(unsigned* p)              { return __hip_atomic_load(p, __ATOMIC_RELAXED, __HIP_MEMORY_SCOPE_AGENT); }
__device__ __forceinline__ unsigned xb_add(unsigned* p, unsigned v) { return __hip_atomic_fetch_add(p, v, __ATOMIC_RELAXED, __HIP_MEMORY_SCOPE_AGENT); }
__device__ __forceinline__ unsigned xb_xcc_id() { return (unsigned)__builtin_amdgcn_s_getreg((3 << 11) | 20) & 0xFu; }
#define XB_SPIN(cond, bar) do { unsigned _sp = 0; while (cond) { __builtin_amdgcn_s_sleep(1); \
    if ((++_sp & 255u) == 0u) { if (xb_ld(&(bar)[XB_TMO])) break; if (_sp > XB_SPIN_CAP) { atomicAdd(&(bar)[XB_TMO], 1u); break; } } } } while (0)

struct XcdBarrier {
    int wv;
    unsigned* bar; unsigned x;
    volatile LAS unsigned* st;
};

__device__ __forceinline__ int xb_lane() { int l; asm volatile("v_mbcnt_lo_u32_b32 %0, -1, 0\n\tv_mbcnt_hi_u32_b32 %0, -1, %0" : "=v"(l)); return l; }
__device__ __forceinline__ XcdBarrier xcd_barrier_post(unsigned* bar, volatile LAS unsigned* st, int wv) {
    XcdBarrier b; b.wv = wv; b.bar = bar; b.x = xb_xcc_id(); b.st = st;
    if (wv == 0 && xb_lane() == 0) (void)xb_add(&bar[XB_XCNT(b.x)], 1u);
    return b;
}
__device__ __forceinline__ void xcd_barrier_complete(unsigned* bar, unsigned x, unsigned& nloc, unsigned& nx) {
    const unsigned G = gridDim.x * gridDim.y * gridDim.z;
    unsigned sum, cnt, mine, sp = 0u;
    for (;;) {
        sum = 0u; cnt = 0u; mine = 0u;
#pragma unroll
        for (unsigned j = 0; j < 16; ++j) { const unsigned c = xb_ld(&bar[XB_XCNT(j)]); sum += c; cnt += (c > 0u) ? 1u : 0u; mine = (j == x) ? c : mine; }
        if (sum == G) break;
        __builtin_amdgcn_s_sleep(1);
        if ((++sp & 255u) == 0u) { if (xb_ld(&bar[XB_TMO])) break; if (sp > XB_SPIN_CAP) { atomicAdd(&bar[XB_TMO], 1u); break; } }
    }
    nloc = mine > 0u ? mine : 1u; nx = cnt > 0u ? cnt : 1u;
}

__device__ __forceinline__ void xcd_barrier(const XcdBarrier& b) {
    asm volatile("s_waitcnt vmcnt(0)" ::: "memory");
    __syncthreads();
    if (b.wv == 0 && xb_lane() == 0) {
        unsigned* bar = b.bar; unsigned bx = b.x; asm volatile("" : "+s"(bar), "+s"(bx));
        __builtin_amdgcn_s_waitcnt(0);
        unsigned nloc = b.st[0], nx = b.st[1];
        if (nloc == 0u) { xcd_barrier_complete(bar, bx, nloc, nx); b.st[0] = nloc; b.st[1] = nx; }
        const unsigned old = xb_add(&bar[XB_XSUB(bx)], 1u);
        const unsigned gen = old / nloc;
        if (old + 1u == (gen + 1u) * nloc) {
            __builtin_amdgcn_fence(__ATOMIC_RELEASE, "agent");
            asm volatile("s_waitcnt vmcnt(0)" ::: "memory");
            const unsigned og = xb_add(&bar[XB_TOP], 1u);
            const unsigned tg = og / nx;
            if (og + 1u == (tg + 1u) * nx) xb_add(&bar[XB_TOPGEN], 1u);
            else XB_SPIN(xb_ld(&bar[XB_TOPGEN]) == tg, bar);
            __builtin_amdgcn_fence(__ATOMIC_ACQUIRE, "agent");
            xb_add(&bar[XB_XGEN(bx)], 1u);
            asm volatile("s_waitcnt vmcnt(0)" ::: "memory");
        } else {
            XB_SPIN(xb_ld(&bar[XB_XGEN(bx)]) == gen, bar);
            __builtin_amdgcn_fence(__ATOMIC_ACQUIRE, "agent");
            asm volatile("s_waitcnt vmcnt(0)" ::: "memory");
        }
    }
    __syncthreads();
}

#define SB_TOKEN_WORDS (17 * 8)
__device__ __forceinline__ void sb_arrive(const XcdBarrier& b, unsigned* sb, int T) {
    asm volatile("s_waitcnt vmcnt(0)" ::: "memory");
    __syncthreads();
    if (b.wv == 0 && xb_lane() == 0) {
        unsigned* base = sb + (size_t)T * SB_TOKEN_WORDS; unsigned bx = b.x; asm volatile("" : "+s"(base), "+s"(bx));
        __builtin_amdgcn_s_waitcnt(0);
        const unsigned nloc = b.st[0];
        const unsigned old = xb_add(&base[8 * bx], 1u);
        if (old + 1u == nloc) {
            __builtin_amdgcn_fence(__ATOMIC_RELEASE, "agent");
            asm volatile("s_waitcnt vmcnt(0)" ::: "memory");
            xb_add(&base[8 * 16], 1u);
        }
    }
}
__device__ __forceinline__ void sb_wait(const XcdBarrier& b, unsigned* sb, int T) {
    if (b.wv == 0 && xb_lane() == 0) {
        unsigned* base = sb + (size_t)T * SB_TOKEN_WORDS; asm volatile("" : "+s"(base));
        const unsigned nx = b.st[1];
        XB_SPIN(xb_ld(&base[8 * 16]) < nx, b.bar);
        __builtin_amdgcn_fence(__ATOMIC_ACQUIRE, "agent");
        asm volatile("s_waitcnt vmcnt(0)" ::: "memory");
    }
    __syncthreads();
}

struct Frame {
    LAS unsigned char* lds;
    int tid, lane, wave;
    int G, bid;
};
__device__ __forceinline__ float wave_sum(float v) {
    const int ln_ = pg8::lane_id_here();
#pragma unroll
    for (int o = 1; o < 64; o <<= 1) v += pg8::xor_shfl(v, o, ln_);
    return v;
}
__device__ __forceinline__ float wave_max(float v) {
    const int ln_ = pg8::lane_id_here();
#pragma unroll
    for (int o = 1; o < 64; o <<= 1) v = fmaxf(v, pg8::xor_shfl(v, o, ln_));
    return v;
}
template <bool GAIN>
__device__ __forceinline__ void p0_transpose_item(const float* W, int K, int N, bf16* WT, int k0, int n0, int drow0, LAS float* scr, int lane, const float* gain) {
    const int c = lane & 7;
    f32x4 ga = {1.f, 1.f, 1.f, 1.f}, gb = {1.f, 1.f, 1.f, 1.f};
    if (GAIN) { ga = *(const GAS f32x4*)(gain + k0 + 8 * c); gb = *(const GAS f32x4*)(gain + k0 + 8 * c + 4); }
#pragma unroll 8
    for (int i = 0; i < 32; ++i) { const int kk = 2 * i + (lane >> 5); scr[kk * 33 + (lane & 31)] = __builtin_nontemporal_load(W + (size_t)(k0 + kk) * N + n0 + (lane & 31)); }
    LDS_WAIT(); asm volatile("" ::: "memory");
#pragma unroll
    for (int j = 0; j < 4; ++j) { const int n = (lane >> 3) + 8 * j; const LAS float* s = scr + (8 * c) * 33 + n;
        v4u o;
        if (GAIN && RESID_F16) { o.x = pkh2(s[0 * 33] * ga.x, s[1 * 33] * ga.y); o.y = pkh2(s[2 * 33] * ga.z, s[3 * 33] * ga.w); o.z = pkh2(s[4 * 33] * gb.x, s[5 * 33] * gb.y); o.w = pkh2(s[6 * 33] * gb.z, s[7 * 33] * gb.w); }
        else { o.x = pk2(s[0 * 33] * ga.x, s[1 * 33] * ga.y); o.y = pk2(s[2 * 33] * ga.z, s[3 * 33] * ga.w); o.z = pk2(s[4 * 33] * gb.x, s[5 * 33] * gb.y); o.w = pk2(s[6 * 33] * gb.z, s[7 * 33] * gb.w); }
        __builtin_nontemporal_store(o, (GAS v4u*)(WT + (size_t)(drow0 + n) * K + k0 + 8 * c)); }
    LDS_WAIT(); asm volatile("" ::: "memory");
}
struct Args {
    const float* x; const float* ffn_norm; const float* wg; const float* wu; const float* wd; const float* mix_norm;
    const float* ab_in; const float* ab_out; const float* ab_sink; const float* c_in; const float* c_out; const float* c_rpb; const float* final_norm;
    float* out; unsigned char* ws; int ph_lo, ph_hi;
};
static_assert(sizeof(Args) == 15 * 8 + 8, "Args has no padding");

constexpr int CV_NSLOT = 11, CV_MAXR = 1;
__device__ const int CV_TAB[CV_NSLOT][CV_MAXR][2] = {
    {{0, 164864}},
    {{0, 0}},
    {{0, 0}},
    {{0, 0}},
    {{0, 0}},
    {{0, 0}},
    {{0, 0}},
    {{0, 0}},
    {{0, 0}},
    {{0, 0}},
    {{0, 0}},
};

constexpr int CV_I_GU = (D / 64) * (FF / 32), CV_I_D = (FF / 64) * (D / 32), CV_I_ABIN = (D / 64) * (AB_IN / 32), CV_I_OUT = (D / 64) * (D / 32), CV_I_CIN = (D / 64) * (C_IN / 32);
constexpr int CV_EVEN = 2 * CV_I_GU + CV_I_D + CV_I_ABIN + CV_I_OUT + 2 * CV_I_GU + CV_I_D, CV_ODD = CV_EVEN - CV_I_ABIN + CV_I_CIN;
static_assert(2 * (CV_EVEN + CV_ODD) == 164864, "item count");
__device__ __forceinline__ void cv_item(const Args& a, unsigned char* ws, int it, LAS float* scr, int lane) {
    const int pr = it / (CV_EVEN + CV_ODD); int r = it - pr * (CV_EVEN + CV_ODD); int layer = 2 * pr; if (r >= CV_EVEN) { r -= CV_EVEN; ++layer; }
    const int li = layer >> 1; const bool odd = layer & 1; const int nin = odd ? CV_I_CIN : CV_I_ABIN;
    int f = 0, kind;
    if (r < 2 * CV_I_GU) kind = 0; else { r -= 2 * CV_I_GU; if (r < CV_I_D) kind = 1; else { r -= CV_I_D; if (r < nin) kind = 2; else { r -= nin; if (r < CV_I_OUT) kind = 3; else { r -= CV_I_OUT; f = 1;
        if (r < 2 * CV_I_GU) kind = 0; else { r -= 2 * CV_I_GU; kind = 1; } } } } }
    const int lf = layer * 2 + f;
    if (kind == 0) { const int up = r >= CV_I_GU; if (up) r -= CV_I_GU; const int nblk = FF / 32, kb = r / nblk, nb = r % nblk, n0 = 32 * nb;
        p0_transpose_item<true>((up ? a.wu : a.wg) + (size_t)lf * D * FF, D, FF, (bf16*)(ws + WS_WGU + (size_t)lf * SZ_WGU), 64 * kb, n0, (n0 >> 7) * 256 + (n0 & 127) + up * 128, scr, lane, a.ffn_norm + (size_t)lf * D); }
    else if (kind == 1) { const int nblk = D / 32, kb = r / nblk, nb = r % nblk, n0 = 32 * nb;
        p0_transpose_item<false>(a.wd + (size_t)lf * FF * D, FF, D, (bf16*)(ws + WS_WD + (size_t)lf * SZ_WD), 64 * kb, n0, n0, scr, lane, nullptr); }
    else if (kind == 2) {
        if (!odd) { const int nblk = AB_IN / 32, kb = r / nblk, nb = r % nblk, n0 = 32 * nb;
            p0_transpose_item<true>(a.ab_in + (size_t)li * D * AB_IN, D, AB_IN, (bf16*)(ws + WS_WABIN + (size_t)li * SZ_WABIN), 64 * kb, n0, n0, scr, lane, a.mix_norm + (size_t)layer * D); }
        else { const int nblk = C_IN / 32, kb = r / nblk, nb = r % nblk, n0 = 32 * nb;
            p0_transpose_item<true>(a.c_in + (size_t)li * D * C_IN, D, C_IN, (bf16*)(ws + WS_WCIN + (size_t)li * SZ_WCIN), 64 * kb, n0, n0, scr, lane, a.mix_norm + (size_t)layer * D); } }
    else { const int nblk = D / 32, kb = r / nblk, nb = r % nblk, n0 = 32 * nb;
        p0_transpose_item<false>((odd ? a.c_out : a.ab_out) + (size_t)li * D * D, D, D, (bf16*)(ws + (odd ? WS_WCOUT : WS_WABOUT) + (size_t)li * SZ_WOUT), 64 * kb, n0, n0, scr, lane, nullptr); }
}
__device__ __forceinline__ void cv_run(const Frame& F, const Args& a, unsigned char* ws, int slot, int j, int n) {
    LAS float* scr = (LAS float*)(F.lds + RING_OFF + F.wave * 16384);
    int lane = F.lane; asm volatile("" : "+v"(lane));
    int total = 0;
#pragma unroll
    for (int r = 0; r < CV_MAXR; ++r) total += CV_TAB[slot][r][1] - CV_TAB[slot][r][0];
    for (int idx = j * NWAVES + F.wave; idx < total; idx += n * NWAVES) {
        int rem = idx, it = 0;
#pragma unroll
        for (int r = 0; r < CV_MAXR; ++r) { const int b = CV_TAB[slot][r][0], len = CV_TAB[slot][r][1] - b; if (rem >= 0 && rem < len) it = b + rem; rem -= len; }
        cv_item(a, ws, it, scr, lane);
    }
}
__device__ __forceinline__ void p0_prologue(const Frame& F, const Args& a) {
    const int gw = F.bid * NWAVES + F.wave, NGW = F.G * NWAVES;
    int lane = F.lane; asm volatile("" : "+v"(lane));
    cv_run(F, a, a.ws, 0, F.bid, F.G);
    bf16* const XB = (bf16*)(a.ws + WS_H); pg8::ssq_t* const ssq0 = (pg8::ssq_t*)(a.ws + WS_SSQ);
    for (int m = gw; m < M; m += NGW) {
        const GAS f32x4* xr = (const GAS f32x4*)(a.x + (size_t)m * D) + lane;
        f32x4 v[8]; float s = 0.f;
#pragma unroll
        for (int j = 0; j < 8; ++j) { v[j] = xr[64 * j]; s += (v[j].x * v[j].x + v[j].y * v[j].y) + (v[j].z * v[j].z + v[j].w * v[j].w); }
        s = wave_sum(s);
        s = 0.f;
#pragma unroll
        for (int j = 0; j < 8; ++j) { const h4_t hq = __builtin_convertvector(v[j], h4_t); ((GAS h4_t*)(XB + (size_t)m * D) + lane)[64 * j] = hq; const f32x4 y = __builtin_convertvector(hq, f32x4); s += (y.x * y.x + y.y * y.y) + (y.z * y.z + y.w * y.w); }
        s = wave_sum(s);
        if (lane == 0) ssq0[m] = pg8::ssq_fix(s);
    }
}
__device__ __forceinline__ void final_norm_h_phase(const Frame& F, const bf16* xb, float* out, const float* g, const pg8::ssq_t* ssq, const int stream) {
    const int gw = F.bid * NWAVES + F.wave, NGW = F.G * NWAVES;
    int lane = F.lane; asm volatile("" : "+v"(lane));
    for (int m = stream * MH + gw; m < (stream + 1) * MH; m += NGW) {
        const GAS h4_t* xr = (const GAS h4_t*)(xb + (size_t)m * D) + lane; GAS f32x4* orow = (GAS f32x4*)(out + (size_t)m * D) + lane; const GAS f32x4* gr = (const GAS f32x4*)g + lane;
        const float rstd = 1.0f / sqrtf(pg8::ssq_val(((const GAS pg8::ssq_t*)ssq)[m + (lane & 0)]) * (1.f / D) + RMS_EPS);
        h4_t xv[8]; f32x4 gv[8];
#pragma unroll
        for (int j = 0; j < 8; ++j) { xv[j] = xr[64 * j]; gv[j] = gr[64 * j]; }
#pragma unroll
        for (int j = 0; j < 8; ++j) orow[64 * j] = __builtin_convertvector(xv[j], f32x4) * rstd * gv[j];
    }
}
namespace att {
using bf16x8 = __attribute__((ext_vector_type(8))) short;
using s16x4  = __attribute__((ext_vector_type(4))) short;
using f32x16 = __attribute__((ext_vector_type(16))) float;
using u32x4  = __attribute__((ext_vector_type(4))) unsigned;
constexpr float LOG2E = 1.4426950408889634f;
constexpr float CSC = 0.08838834764831845f * LOG2E;
constexpr float THR_L2 = 4.0f * LOG2E;
#define ATT_KSWZ(row, colB) ((row) * 256 + ((colB) ^ (((row) & 7) << 4)))
__device__ __forceinline__ constexpr int crowc(int r) { return (r & 3) + 8 * (r >> 2); }
__device__ __forceinline__ unsigned cvtpk(float lo, float hi) { unsigned r; asm volatile("v_cvt_pk_bf16_f32 %0, %1, %2" : "=v"(r) : "v"(lo), "v"(hi)); return r; }
__device__ __forceinline__ int swap23(int k) { return (k & ~0xC) | ((k & 4) << 1) | ((k & 8) >> 1); }
__device__ __forceinline__ int v_rd_base(int lane) { return ((lane & 3) << 3) | (((lane >> 2) & 3) << 6) | (((lane >> 4) & 1) << 5) | (((lane >> 5) & 1) << 8); }
constexpr int v_rd_off(int d0, int ks, int half) { return d0 * 512 + ks * 4096 + half * 2048; }
template <int OFF> __device__ __forceinline__ s16x4 tr_read(int vb) { s16x4 r; asm volatile("ds_read_b64_tr_b16 %0, %1 offset:%2" : "=&v"(r) : "v"(vb), "i"(OFF) : "memory"); return r; }
template <int D0> __device__ __forceinline__ void pv_one(f32x16& od, int vb, bf16x8 pa0, bf16x8 pa1) {
    const s16x4 l0 = tr_read<v_rd_off(D0, 0, 0)>(vb), h0 = tr_read<v_rd_off(D0, 0, 1)>(vb), l1 = tr_read<v_rd_off(D0, 1, 0)>(vb), h1 = tr_read<v_rd_off(D0, 1, 1)>(vb);
    asm volatile("s_waitcnt lgkmcnt(0)" ::: "memory"); __builtin_amdgcn_sched_barrier(0);
#define ATT_PK(L, H) (bf16x8){L[0], L[1], L[2], L[3], H[0], H[1], H[2], H[3]}
    od = __builtin_amdgcn_mfma_f32_32x32x16_bf16(pa0, ATT_PK(l0, h0), od, 0, 0, 0);
    od = __builtin_amdgcn_mfma_f32_32x32x16_bf16(pa1, ATT_PK(l1, h1), od, 0, 0, 0);
#undef ATT_PK
}
constexpr int ATT_SCR_OFF = 132096;
constexpr int ATT_RPB_OFF = 136192;
constexpr int RPB_PAD = 8, RPB_FLOATS = 640;
static_assert(ATT_RPB_OFF + 4 * RPB_FLOATS * 4 <= LDS_BYTES && ATT_SCR_OFF >= MISC_OFF + 128, "attention LDS map");

template <int MODE>
__device__ __forceinline__ void attn_mfma(const Frame& F, const bf16* QKV, const int ld, bf16* O, float* part, float* lsebuf, const float* extra, const int stream, const int vc) {
    int lane = F.lane; asm volatile("" : "+v"(lane));
    const int wid = F.wave, pair = wid >> 1, w2 = wid & 1, r32 = lane & 31, hi = lane >> 5;
    LAS unsigned char* const pbase = F.lds + RING_OFF + pair * 32768;
    LAS float* const scr = (LAS float*)(F.lds + ATT_SCR_OFF + wid * 512);
    LAS float* const rpbt = (LAS float*)(F.lds + ATT_RPB_OFF + pair * (RPB_FLOATS * 4));
    constexpr int NT = (MODE == 0) ? 6 : (MODE == 1) ? 10 : 11;
    constexpr int NUNITS = ((MODE == 0) ? 3072 : (MODE == 1) ? 1024 : 2048) / NSTREAM;
    constexpr int HW = (MODE == 0) ? 64 : 128;
    const int vb0 = (int)(uintptr_t)(pbase + 8192) + v_rd_base(lane);
    for (int g = vc; g < NUNITS / 4; g += F.G) {
        const int u = g * 4 + pair;
        int b, h, qcol, kcol, vcol, shift = 0, jres = 0, l0 = 0, L = SEQ, pat = 0, rbase = 0, c0 = 0, qr0 = 0, qc0 = 0;
        if (MODE == 0) { const int blk = u & 31, rest = u >> 5; pat = rest % 3; const int bh = rest / 3; h = bh & 7; b = (BATCH / NSTREAM) * stream + (bh >> 3); shift = 2 * pat; L = SEQ >> shift;
            const int nbs = 5 - shift; jres = blk >> nbs; l0 = 64 * (blk & ((1 << nbs) - 1)); qcol = h * HD; kcol = 1024 + h * HD; vcol = 2048 + h * HD; }
        else if (MODE == 1) { const int blk = u & 31, bh = u >> 5; h = bh & 7; b = (BATCH / NSTREAM) * stream + (bh >> 3); l0 = 64 * blk; qcol = 3072 + h * HD; kcol = 4096 + (h >> 2) * HD; vcol = 4352 + (h >> 2) * HD; }
        else { const int cc = u & 3, ii = (u >> 2) & 7, bh = u >> 5; h = bh & 15; b = (BATCH / NSTREAM) * stream + (bh >> 4); qr0 = 4 * ii; qc0 = 16 * cc; rbase = qr0 - 4; rbase = rbase < 0 ? 0 : (rbase > 21 ? 21 : rbase);
            c0 = (cc == 0) ? 0 : (cc == 1) ? 8 : (cc == 2) ? 24 : 32; qcol = h * HD; kcol = 2048 + h * HD; vcol = 4096 + h * HD; }
        const bf16* const Qb = QKV + (size_t)b * SEQ * ld;
        int lq = 0, qrow = 0, qcl = 0, sq;
        if (MODE == 2) { qrow = qr0 + 2 * w2 + (r32 >> 4); qcl = qc0 + (r32 & 15); sq = qrow * 64 + qcl; }
        else { lq = l0 + 32 * w2 + r32; sq = (lq << shift) + jres; }
        bf16x8 qr[8];
        { const bf16* qp = Qb + (size_t)sq * ld + qcol + hi * 8;
#pragma unroll
          for (int d0 = 0; d0 < 8; ++d0) qr[d0] = *(const bf16x8*)(qp + d0 * 16); }
        float slopeL2 = 0.f; int rs = 0, cs = 0;
        __builtin_amdgcn_s_barrier();
        if (MODE != 2) slopeL2 = exp2f(-(float)(h + 1)) * (float)(1 << shift) * LOG2E;
        else { rs = qrow - 4; rs = rs < 0 ? 0 : (rs > 24 ? 24 : rs); cs = qcl - 8; cs = cs < 0 ? 0 : (cs > 48 ? 48 : cs);
#pragma unroll
            for (int k = 0; k < 4; ++k) { const int i = lane + 64 * w2 + 128 * k; if (i < 15 * 31) rpbt[RPB_PAD + i] = extra[h * 15 * 31 + i] * LOG2E; } }
        const int krow = 16 * w2 + (lane >> 4);
        const int kch = lane & 15;
        const int vst = 8 * w2 + (lane >> 5), vq = lane & 31;
#define ATT_KEYTOK(jj, t) ((MODE == 2) ? ((rbase + (t)) * 64 + c0 + (jj)) : ({ int lk_ = l0 - HW + 32 * (t) + (jj); lk_ = lk_ < 0 ? 0 : (lk_ > L - 1 ? L - 1 : lk_); (lk_ << shift) + jres; }))
#define ATT_STAGE(t) do { LAS unsigned char* const bb_ = pbase + ((t) & 1) * 16384; \
        _Pragma("unroll") for (int i_ = 0; i_ < 4; ++i_) { const int row_ = krow + 4 * i_; const int tok_ = ATT_KEYTOK(row_, t); \
            __builtin_amdgcn_global_load_lds((const unsigned*)(Qb + (size_t)tok_ * ld + kcol + ((kch ^ (row_ & 7)) << 3)), (LAS unsigned*)(bb_ + (w2 * 4 + i_) * 1024), 16, 0, 0); } \
        _Pragma("unroll") for (int i_ = 0; i_ < 4; ++i_) { const int st_ = vst + 2 * i_; const int kk_ = (st_ >> 2) * 8 + (vq >> 2); const int tok_ = ATT_KEYTOK(swap23(kk_), t); \
            __builtin_amdgcn_global_load_lds((const unsigned*)(Qb + (size_t)tok_ * ld + vcol + (st_ & 3) * 32 + (vq & 3) * 8), (LAS unsigned*)(bb_ + 8192 + (w2 * 4 + i_) * 1024), 16, 0, 0); } } while (0)
        float m_reg = -1e30f, l_reg = 0.f;
        f32x16 o[4];
#pragma unroll
        for (int d = 0; d < 4; ++d)
#pragma unroll
            for (int r = 0; r < 16; ++r) o[d][r] = 0.f;
        asm volatile("s_waitcnt lgkmcnt(0)" ::: "memory"); __builtin_amdgcn_s_barrier();
        ATT_STAGE(0);
        for (int t = 0; t < NT; ++t) {
            asm volatile("s_waitcnt vmcnt(0)" ::: "memory"); __builtin_amdgcn_s_barrier(); asm volatile("" ::: "memory");
            if (t + 1 < NT) ATT_STAGE(t + 1);
            bool need = true;
            if (MODE == 0) need = (w2 == 0) ? (t < 5) : (t > 0);
            else if (MODE == 1) need = (w2 == 0) ? (t < 9) : (t > 0);
            else { const int kr = rbase + t, ra = qr0 + 2 * w2; int rsA = ra - 4; rsA = rsA < 0 ? 0 : (rsA > 24 ? 24 : rsA); int rsB = ra - 3; rsB = rsB < 0 ? 0 : (rsB > 24 ? 24 : rsB); need = (kr >= rsA) && (kr < rsB + 8); }
            if (!need) continue;
            LAS unsigned char* const Kb = pbase + (t & 1) * 16384;
            f32x16 p0;
#pragma unroll
            for (int r = 0; r < 16; ++r) p0[r] = 0.f;
#pragma unroll
            for (int d0 = 0; d0 < 8; ++d0) { const int cb = (d0 * 16 + hi * 8) * 2;
                const bf16x8 kf = *(const LAS bf16x8*)(Kb + ATT_KSWZ(r32, cb));
                p0 = __builtin_amdgcn_mfma_f32_32x32x16_bf16(kf, qr[d0], p0, 0, 0, 0); }
            if (MODE != 2) {
                const int kb_i = l0 - HW + 32 * t + 4 * hi;
                const float fb = (float)(kb_i - lq);
#pragma unroll
                for (int r = 0; r < 16; ++r) { const float fd = fb + (float)crowc(r); const bool ok = (fabsf(fd) <= (float)HW) && ((unsigned)(kb_i + crowc(r)) < (unsigned)L);
                    p0[r] = ok ? fmaf(p0[r], CSC, -slopeL2 * fabsf(fd)) : -INFINITY; }
            } else {
                int rs_ = qrow - 4; rs_ = rs_ < 0 ? 0 : (rs_ > 24 ? 24 : rs_); int cs_ = qcl - 8; cs_ = cs_ < 0 ? 0 : (cs_ > 48 ? 48 : cs_);
                const int kr = rbase + t; const bool inr = (unsigned)(kr - rs_) < 8u;
                const int kcb = c0 + 4 * hi;
                const LAS float* bp = rpbt + RPB_PAD + (kr - qrow + 7) * 31 + (kcb - qcl + 15);
#pragma unroll
                for (int r = 0; r < 16; ++r) { const bool ok = inr && ((unsigned)(kcb + crowc(r) - cs_) < 16u);
                    p0[r] = ok ? fmaf(p0[r], CSC, bp[crowc(r)]) : -INFINITY; }
            }
            float pmax = p0[0];
#pragma unroll
            for (int r = 1; r < 16; ++r) pmax = fmaxf(pmax, p0[r]);
            { auto rr = __builtin_amdgcn_permlane32_swap(__float_as_uint(pmax), __float_as_uint(pmax), false, false); pmax = fmaxf(__uint_as_float(rr[0]), __uint_as_float(rr[1])); }
            float alpha = 1.f;
            if (!__all(pmax - m_reg <= THR_L2)) { const float mn = fmaxf(m_reg, pmax); alpha = __builtin_amdgcn_exp2f(m_reg - mn); m_reg = mn; }
            float ps = 0.f;
#pragma unroll
            for (int r = 0; r < 16; ++r) { p0[r] = __builtin_amdgcn_exp2f(p0[r] - m_reg); ps += p0[r]; }
            { auto rr = __builtin_amdgcn_permlane32_swap(__float_as_uint(ps), __float_as_uint(ps), false, false); ps = __uint_as_float(rr[0]) + __uint_as_float(rr[1]); }
            l_reg = l_reg * alpha + ps;
            bf16x8 pa0, pa1;
#define ATT_PK4(P, BASE, OUT) do { unsigned a0 = cvtpk(P[BASE + 0], P[BASE + 1]), a1 = cvtpk(P[BASE + 2], P[BASE + 3]); \
        unsigned b0 = cvtpk(P[BASE + 4], P[BASE + 5]), b1 = cvtpk(P[BASE + 6], P[BASE + 7]); \
        auto r0 = __builtin_amdgcn_permlane32_swap(a0, b0, false, false); auto r1 = __builtin_amdgcn_permlane32_swap(a1, b1, false, false); \
        u32x4 w = {r0[0], r1[0], r0[1], r1[1]}; OUT = *reinterpret_cast<bf16x8*>(&w); } while (0)
            ATT_PK4(p0, 0, pa0); ATT_PK4(p0, 8, pa1);
#undef ATT_PK4
            if (__any(alpha < 1.f)) { if (hi == 0) scr[r32] = alpha; asm volatile("s_waitcnt lgkmcnt(0)" ::: "memory");
#pragma unroll
                for (int r = 0; r < 16; ++r) { const float a = scr[crowc(r) + 4 * hi];
#pragma unroll
                    for (int d = 0; d < 4; ++d) o[d][r] *= a; } }
            const int vb = vb0 + (t & 1) * 16384;
            pv_one<0>(o[0], vb, pa0, pa1); pv_one<1>(o[1], vb, pa0, pa1); pv_one<2>(o[2], vb, pa0, pa1); pv_one<3>(o[3], vb, pa0, pa1);
        }
        float fin;
        if (MODE == 1) { const float sk = extra[h] * LOG2E; const float mf = fmaxf(m_reg, sk); const float a = __builtin_amdgcn_exp2f(m_reg - mf); const float lf = l_reg * a + __builtin_amdgcn_exp2f(sk - mf); fin = a / lf; }
        else fin = 1.0f / l_reg;
        asm volatile("s_waitcnt lgkmcnt(0)" ::: "memory");
        if (hi == 0) scr[r32] = fin;
        asm volatile("s_waitcnt lgkmcnt(0)" ::: "memory");
        if (MODE == 0 && hi == 0) lsebuf[((size_t)pat * M + (size_t)b * SEQ + sq) * 8 + h] = m_reg + __log2f(l_reg);
#pragma unroll
        for (int r = 0; r < 16; ++r) { const int qi = crowc(r) + 4 * hi; const float f = scr[qi];
            int sqi; if (MODE == 2) sqi = (qr0 + 2 * w2 + (qi >> 4)) * 64 + qc0 + (qi & 15); else sqi = ((l0 + 32 * w2 + qi) << shift) + jres;
            const size_t tokq = (size_t)b * SEQ + sqi;
            if (MODE == 0) { _Float16* op = (_Float16*)part + ((size_t)pat * M + tokq) * 1024 + h * HD + r32;
#pragma unroll
                for (int d = 0; d < 4; ++d) op[32 * d] = (_Float16)(o[d][r] * f); }
            else { bf16* op = O + tokq * D + ((MODE == 1) ? 1024 : 0) + h * HD + r32;
#pragma unroll
                for (int d = 0; d < 4; ++d) op[32 * d] = (bf16)f2bf(o[d][r] * f); } }
#undef ATT_STAGE
#undef ATT_KEYTOK
    }
    asm volatile("s_waitcnt vmcnt(0) lgkmcnt(0)" ::: "memory"); __builtin_amdgcn_s_barrier();
}
__device__ __forceinline__ void attn_combine(const Frame& F, const float* part, const float* lsebuf, bf16* O, const int stream) {
    int lane = F.lane; asm volatile("" : "+v"(lane));
    const int gw = F.bid * NWAVES + F.wave, NGW = F.G * NWAVES;
    for (int it = gw; it < MH * 8; it += NGW) {
        const int tok = stream * MH + (it >> 3), h = it & 7;
        const float e0 = lsebuf[((size_t)0 * M + tok) * 8 + h], e1 = lsebuf[((size_t)1 * M + tok) * 8 + h], e2 = lsebuf[((size_t)2 * M + tok) * 8 + h];
        const float mx = fmaxf(e0, fmaxf(e1, e2)); float w0 = __builtin_amdgcn_exp2f(e0 - mx), w1 = __builtin_amdgcn_exp2f(e1 - mx), w2 = __builtin_amdgcn_exp2f(e2 - mx);
        const float inv = 1.0f / (w0 + w1 + w2); w0 *= inv; w1 *= inv; w2 *= inv;
        typedef _Float16 f16x2 __attribute__((ext_vector_type(2)));
        const _Float16* ph = (const _Float16*)part; const size_t off = (size_t)tok * 1024 + h * HD + 2 * lane;
        const f16x2 a = *(const f16x2*)(ph + off), bq = *(const f16x2*)(ph + (size_t)M * 1024 + off), c = *(const f16x2*)(ph + (size_t)2 * M * 1024 + off);
        ((unsigned*)(O + (size_t)tok * D + h * HD))[lane] = pk2(w0 * (float)a.x + w1 * (float)bq.x + w2 * (float)c.x, w0 * (float)a.y + w1 * (float)bq.y + w2 * (float)c.y);
    }
}
}

__global__ void __launch_bounds__(NWAVES * 64, 2) fwd(Args a) {
    extern __shared__ __attribute__((aligned(16))) unsigned char lds[];
    Frame F;
    F.lds = (LAS unsigned char*)lds;
    F.wave = __builtin_amdgcn_readfirstlane((int)threadIdx.x >> 6); F.lane = 0; F.tid = 0;
    F.G = gridDim.x; F.bid = blockIdx.x;
    for (int u = (int)threadIdx.x; u < (LDS_BYTES - LDSCTL_OFF) / 4; u += NWAVES * 64) ((LAS unsigned*)(F.lds + LDSCTL_OFF))[u] = 0u;
    __syncthreads();
    XcdBarrier bar = xcd_barrier_post((unsigned*)(a.ws + WS_CTL) + CW_BAR, (volatile LAS unsigned*)(F.lds + MISC_OFF) + 8, F.wave);
#define PH_ENTER() Frame Fp = F; unsigned char* ws = a.ws; float* xo = a.out; asm volatile("" : "+s"(Fp.bid), "+s"(Fp.wave), "+s"(Fp.G), "+s"(ws), "+s"(xo)); \
    asm volatile("v_mbcnt_lo_u32_b32 %0, -1, 0\n\tv_mbcnt_hi_u32_b32 %0, -1, %0" : "=v"(Fp.lane)); Fp.tid = Fp.wave * 64 + Fp.lane;     \
    bf16* const Hb = (bf16*)(ws + WS_H); bf16* const Ub = (bf16*)(ws + WS_U); bf16* const QKVb = (bf16*)(ws + WS_QKV); bf16* const Ob = (bf16*)(ws + WS_O); float* const Pb = (float*)(ws + WS_PART); float* const Lb = (float*)(ws + WS_LSE); \
    int vc = Fp.bid - off; if (vc < 0) vc += Fp.G; const size_t rowoff = (size_t)s * MH; \
    (void)Hb; (void)Ub; (void)QKVb; (void)Ob; (void)Pb; (void)Lb; (void)xo; (void)vc; (void)rowoff
#define ITEM_BEGIN() for (int s = 0; s < NSTREAM; ++s) { if (T >= NSTREAM) sb_wait(bar, (unsigned*)(a.ws + WS_SB), T - NSTREAM);
#define ITEM_END(nunits) sb_arrive(bar, (unsigned*)(a.ws + WS_SB), T); ++T; off = (off + (nunits)) % F.G; }
    int T = 0, off = 0;
    { const int s = 0; PH_ENTER(); p0_prologue(Fp, a); }
    xcd_barrier(bar);
    for (int layer = 0; layer < DEPTH; ++layer) {
        const bool even = (layer & 1) == 0; const int li = layer >> 1;
        for (int sub = 0; sub < 3; ++sub) {
            const int lf = layer * 2 + (sub == 2 ? 1 : 0);
            const int sb = layer * 3 + sub;
            const int N1 = (sub == 1) ? (even ? AB_IN : C_IN) : 2 * FF;
            ITEM_BEGIN() { PH_ENTER();
                if (sub == 1) {
                    const bf16* W = even ? (const bf16*)(ws + WS_WABIN + (size_t)li * SZ_WABIN) : (const bf16*)(ws + WS_WCIN + (size_t)li * SZ_WCIN);
                    pg8::Gemm g{Hb + rowoff * D, W, MH, N1, D}; pg8::StaticOrder S; S.init(MH, N1, Fp.G, vc);
                    pg8::EpiBf16 E{QKVb + rowoff * N1, N1, (const pg8::ssq_t*)(ws + WS_SSQ) + (size_t)sb * M + rowoff};
                    pg8::gemm_phase<pg8::EpiBf16, pg8::StaticOrder, true, true, 0, RESID_F16 != 0>(Fp.lds + RING_OFF, g, S, E, Fp.tid);
                } else {
                    pg8::Gemm g{Hb + rowoff * D, (const bf16*)(ws + WS_WGU + (size_t)lf * SZ_WGU), MH, 2 * FF, D}; pg8::StaticOrder S; S.init(MH, 2 * FF, Fp.G, vc);
                    pg8::EpiSwiglu E{Ub + rowoff * FF, FF, (const pg8::ssq_t*)(ws + WS_SSQ) + (size_t)sb * M + rowoff};
                    pg8::gemm_phase<pg8::EpiSwiglu, pg8::StaticOrder, true, true, 0, RESID_F16 != 0>(Fp.lds + RING_OFF, g, S, E, Fp.tid);
                }
            } ITEM_END((MH / 256) * (N1 / 256))
            if (sub == 1) {
                if (even) {
                    ITEM_BEGIN() { PH_ENTER(); att::attn_mfma<0>(Fp, QKVb, AB_IN, Ob, Pb, Lb, nullptr, s, vc); } ITEM_END(3072 / NSTREAM / 4)
                    ITEM_BEGIN() { PH_ENTER(); att::attn_mfma<1>(Fp, QKVb, AB_IN, Ob, Pb, Lb, a.ab_sink + li * 8, s, vc); att::attn_combine(Fp, Pb, Lb, Ob, s); } ITEM_END(1024 / NSTREAM / 4)
                } else {
                    ITEM_BEGIN() { PH_ENTER(); att::attn_mfma<2>(Fp, QKVb, C_IN, Ob, Pb, Lb, a.c_rpb + (size_t)li * 16 * 15 * 31, s, vc); } ITEM_END(2048 / NSTREAM / 4)
                }
            }
            ITEM_BEGIN() { PH_ENTER();
                const bf16* A2 = (sub == 1) ? (const bf16*)(Ob + rowoff * D) : (const bf16*)(Ub + rowoff * FF); const int K2 = (sub == 1) ? D : FF;
                const bf16* W2 = (sub == 1) ? (even ? (const bf16*)(ws + WS_WABOUT + (size_t)li * SZ_WOUT) : (const bf16*)(ws + WS_WCOUT + (size_t)li * SZ_WOUT))
                                            : (const bf16*)(ws + WS_WD + (size_t)lf * SZ_WD);
                pg8::Gemm g{A2, W2, MH, D, K2}; pg8::StaticOrder S; S.init(MH, D, Fp.G, vc);
                pg8::EpiResidH E{Hb + rowoff * D, D, (sub == 1) ? 1.0f : 0.5f, Hb + rowoff * D, (pg8::ssq_t*)(ws + WS_SSQ) + (size_t)(sb + 1) * M + rowoff};
                pg8::gemm_phase<pg8::EpiResidH, pg8::StaticOrder, true, true>(Fp.lds + RING_OFF, g, S, E, Fp.tid);
            } ITEM_END((MH / 256) * (D / 256))
        }
    }
    ITEM_BEGIN() { PH_ENTER(); final_norm_h_phase(Fp, Hb, xo, a.final_norm, (const pg8::ssq_t*)(ws + WS_SSQ) + (size_t)12 * M, s); } ITEM_END(0)
#undef PH_ENTER
#undef ITEM_BEGIN
#undef ITEM_END
}

extern "C" void kernel_launch(void* const* d_in, const int* in_sizes, int n_in, void* d_out, int out_size, void* d_ws, size_t ws_size, hipStream_t stream) {
    static int grid = 0;
    if (grid == 0) {
        if (n_in != 13 || in_sizes[0] != M * D || out_size != M * D || ws_size < WS_END) { fprintf(stderr, "kernel_launch: unexpected shapes (n_in %d, in0 %d, out %d, ws %zu, need %zu); nothing launched\n", n_in, n_in > 0 ? in_sizes[0] : -1, out_size, ws_size, (size_t)WS_END); grid = -1; return; }
        int dev = 0, cus = 0, per_cu = 0;
        if (hipGetDevice(&dev) != hipSuccess || hipDeviceGetAttribute(&cus, hipDeviceAttributeMultiprocessorCount, dev) != hipSuccess) { fprintf(stderr, "kernel_launch: device query failed\n"); grid = -1; return; }
        if (hipFuncSetAttribute((const void*)fwd, hipFuncAttributeMaxDynamicSharedMemorySize, LDS_BYTES) != hipSuccess) { fprintf(stderr, "kernel_launch: hipFuncSetAttribute failed\n"); grid = -1; return; }
        if (hipOccupancyMaxActiveBlocksPerMultiprocessor(&per_cu, (const void*)fwd, NWAVES * 64, LDS_BYTES) != hipSuccess || per_cu < 1)
            fprintf(stderr, "kernel_launch: note: occupancy query reports %d workgroups per CU\n", per_cu);
        (void)hipGetLastError();
        grid = cus;
    }
    if (grid < 0) return;
    if (hipMemsetAsync((char*)d_ws + WS_CTL, 0, CTL_ZERO_BYTES, stream) != hipSuccess) { fprintf(stderr, "kernel_launch: memset failed\n"); return; }
    Args a{};
    a.x = (const float*)d_in[0]; a.ffn_norm = (const float*)d_in[1]; a.wg = (const float*)d_in[2]; a.wu = (const float*)d_in[3]; a.wd = (const float*)d_in[4]; a.mix_norm = (const float*)d_in[5];
    a.ab_in = (const float*)d_in[6]; a.ab_out = (const float*)d_in[7]; a.ab_sink = (const float*)d_in[8]; a.c_in = (const float*)d_in[9]; a.c_out = (const float*)d_in[10]; a.c_rpb = (const float*)d_in[11];
    a.final_norm = (const float*)d_in[12]; a.out = (float*)d_out; a.ws = (unsigned char*)d_ws;
    a.ph_lo = 0; a.ph_hi = 0; hipLaunchKernelGGL(fwd, dim3(grid), dim3(NWAVES * 64), LDS_BYTES, stream, a);
    const hipError_t le = hipPeekAtLastError();
    if (le != hipSuccess) fprintf(stderr, "kernel_launch: launch failed: %s\n", hipGetErrorName(le));
}
```

```cpp
#include <hip/hip_runtime.h>
#include <cstdio>
#include <cstdint>

#ifndef PROBE_ABL
#define PROBE_ABL 0
#endif
#ifndef RESID_F16
#define RESID_F16 1
#endif

namespace pg8 {
#define PG8_LAS __attribute__((address_space(3)))
typedef unsigned short bf16_t;
typedef short bf16x8 __attribute__((ext_vector_type(8)));
typedef _Float16 f16x8 __attribute__((ext_vector_type(8)));
typedef _Float16 f16x4 __attribute__((ext_vector_type(4)));
typedef float f32x4 __attribute__((ext_vector_type(4)));
typedef unsigned u32x4 __attribute__((ext_vector_type(4)));
constexpr int BM = 256, BK = 64, HALF = 128, HTB = HALF * BK * 2  , STAGE_BYTES = 8 * HTB, NXCD = 8, WGM = 8;

__host__ __device__ __forceinline__ int lds_byte(int r, int c) { const int st = (r >> 4) * 2 + (c >> 5), rr = r & 15, cc = c & 31, ob = rr * 64 + cc * 2; return st * 1024 + (ob ^ (((ob >> 9) & 1) << 5)); }
__host__ __device__ __forceinline__ void stage_rc(int b, int& R, int& C) { const int st = b / 1024, sb = b % 1024, swz = sb ^ (((sb >> 9) & 1) << 5); R = (st >> 1) * 16 + swz / 64; C = (st & 1) * 32 + (swz % 64) / 2; }
__host__ __device__ __forceinline__ int perm32(int rho) { const int n = rho >> 4, i = rho & 15; return 8 * (i >> 2) + 4 * n + (i & 3); }

struct Unit { int pm, pn; };
struct Gemm { const bf16_t* A; const bf16_t* Bt; int M, N, K; };

struct StaticOrder {
    int nM, nN, nwg, G, c;
    __host__ __device__ void init(int M, int N, int G_, int c_) { nM = M / BM; nN = N / BM; nwg = nM * nN; G = G_; c = c_; }
    __host__ __device__ bool next(int i, Unit& u) const {
        const long L = (long)i * G + c; if (L >= nwg) return false;
        int wgid = (int)L; { const int q = nwg / NXCD, r = nwg % NXCD, xcd = wgid % NXCD, off = wgid / NXCD; wgid = (xcd < r ? xcd * (q + 1) : r * (q + 1) + (xcd - r) * q) + off; }
        const int nig = WGM * nN, gid = wgid / nig, fm = gid * WGM, gsz = (nM - fm) < WGM ? (nM - fm) : WGM;
        u.pm = fm + ((wgid % nig) % gsz); u.pn = (wgid % nig) / gsz; return true;
    }
    __device__ __forceinline__ void a_ready(const Unit&) const {}
    __device__ __forceinline__ void done(const Unit&) const {}
};


__device__ __forceinline__ unsigned cvt_pk_bf16(float lo, float hi) { unsigned r; asm volatile("v_cvt_pk_bf16_f32 %0, %1, %2" : "=v"(r) : "v"(lo), "v"(hi)); return r; }

__device__ __forceinline__ int lane_id_here() { int l; asm volatile("v_mbcnt_lo_u32_b32 %0, -1, 0\n\tv_mbcnt_hi_u32_b32 %0, -1, %0" : "=v"(l)); return l; }
__device__ __forceinline__ float xor_shfl(float v, int mask, int lane) { return __builtin_bit_cast(float, __builtin_amdgcn_ds_bpermute((lane ^ mask) << 2, __builtin_bit_cast(int, v))); }
typedef unsigned long long ssq_t;
__device__ __forceinline__ ssq_t ssq_fix(float s) { const int hi = (int)s; const int lo = (int)((s - (float)hi) * 16777216.0f); return ((ssq_t)(unsigned)hi << 24) + (ssq_t)(unsigned)lo; }
__device__ __forceinline__ float ssq_val(ssq_t v) { return (float)(unsigned)(v >> 24) + (float)(unsigned)(v & 0xFFFFFFull) * (1.0f / 16777216.0f); }
__device__ __forceinline__ float row_rstd(const ssq_t* ssq, int row) { return 1.0f / sqrtf(ssq_val(ssq[row]) * (1.0f / 2048.0f) + 1e-6f); }
struct PreSsq { ssq_t v[2][4]; };
__device__ __forceinline__ void pre_ssq_issue(PreSsq& p, const ssq_t* ssq, int row0) {
    typedef __attribute__((address_space(1))) const ssq_t gssq_t;
    gssq_t* a = (gssq_t*)ssq + row0;
    asm volatile("global_load_dwordx2 %0, %1, off" : "=v"(p.v[0][0]) : "v"(a));
    asm volatile("global_load_dwordx2 %0, %1, off offset:128" : "=v"(p.v[0][1]) : "v"(a));
    asm volatile("global_load_dwordx2 %0, %1, off offset:256" : "=v"(p.v[0][2]) : "v"(a));
    asm volatile("global_load_dwordx2 %0, %1, off offset:384" : "=v"(p.v[0][3]) : "v"(a));
    asm volatile("global_load_dwordx2 %0, %1, off offset:1024" : "=v"(p.v[1][0]) : "v"(a));
    asm volatile("global_load_dwordx2 %0, %1, off offset:1152" : "=v"(p.v[1][1]) : "v"(a));
    asm volatile("global_load_dwordx2 %0, %1, off offset:1280" : "=v"(p.v[1][2]) : "v"(a));
    asm volatile("global_load_dwordx2 %0, %1, off offset:1408" : "=v"(p.v[1][3]) : "v"(a));
}
__device__ __forceinline__ void pre_ssq_wait(PreSsq& p) {
    asm volatile("s_waitcnt vmcnt(16)" : "+v"(p.v[0][0]), "+v"(p.v[0][1]), "+v"(p.v[0][2]), "+v"(p.v[0][3]), "+v"(p.v[1][0]), "+v"(p.v[1][1]), "+v"(p.v[1][2]), "+v"(p.v[1][3]) :: "memory");
}
__device__ __forceinline__ void rows_rstd(const PreSsq& p, float (&rs)[2][4]) {
#pragma unroll
    for (int ai = 0; ai < 2; ++ai)
#pragma unroll
        for (int m = 0; m < 4; ++m) rs[ai][m] = __builtin_amdgcn_rsqf(ssq_val(p.v[ai][m]) * (1.0f / 2048.0f) + 1e-6f);
}
typedef __attribute__((address_space(1))) u32x4 gu32x4;
struct EpiBf16 {
    static constexpr bool PERM = true, AFTER_DRAIN = false, HAS_INIT = false, HAS_PRE = true;
    typedef PreSsq Pre;
    bf16_t* O; int ldc; const ssq_t* ssq;
    __device__ __forceinline__ void pre_issue(Pre& p, const Unit& u, int wr, int wc, int fr, int fq) const { pre_ssq_issue(p, ssq, u.pm * BM + wr * 64 + fr); }
    __device__ __forceinline__ void pre_wait(Pre& p) const { pre_ssq_wait(p); }
    __device__ __forceinline__ void operator()(const f32x4 (&acc)[2][2][4][2], const Unit& u, int wr, int wc, int fr, int fq, const Pre& pre) const {
        const int row0 = u.pm * BM + wr * 64 + fr; const int col0 = u.pn * BM + wc * 32 + 8 * fq;
        float rsv[2][4]; rows_rstd(pre, rsv);
#pragma unroll
        for (int ai = 0; ai < 2; ++ai)
#pragma unroll
            for (int m = 0; m < 4; ++m) { const int row = row0 + ai * HALF + m * 16; const float rs = rsv[ai][m]; bf16_t* rowp = O + (size_t)row * ldc + col0;
#pragma unroll
                for (int bj = 0; bj < 2; ++bj) { const f32x4 v0 = acc[ai][bj][m][0] * rs, v1 = acc[ai][bj][m][1] * rs;
                    u32x4 w; w.x = cvt_pk_bf16(v0[0], v0[1]); w.y = cvt_pk_bf16(v0[2], v0[3]); w.z = cvt_pk_bf16(v1[0], v1[1]); w.w = cvt_pk_bf16(v1[2], v1[3]);
                    *(gu32x4*)(rowp + bj * HALF) = w; } }
    }
};
struct EpiSwiglu {
    static constexpr bool PERM = true, AFTER_DRAIN = false, HAS_INIT = false, HAS_PRE = true;
    typedef PreSsq Pre;
    bf16_t* O; int ldc; const ssq_t* ssq;
    __device__ __forceinline__ void pre_issue(Pre& p, const Unit& u, int wr, int wc, int fr, int fq) const { pre_ssq_issue(p, ssq, u.pm * BM + wr * 64 + fr); }
    __device__ __forceinline__ void pre_wait(Pre& p) const { pre_ssq_wait(p); }
    __device__ __forceinline__ void operator()(const f32x4 (&acc)[2][2][4][2], const Unit& u, int wr, int wc, int fr, int fq, const Pre& pre) const {
        const int row0 = u.pm * BM + wr * 64 + fr; const int col0 = u.pn * HALF + wc * 32 + 8 * fq;
        float rsv[2][4]; rows_rstd(pre, rsv);
#pragma unroll
        for (int ai = 0; ai < 2; ++ai)
#pragma unroll
            for (int m = 0; m < 4; ++m) { const int row = row0 + ai * HALF + m * 16; const float rs = rsv[ai][m]; bf16_t* rowp = O + (size_t)row * ldc + col0;
                float r[8];
                typedef float f32x2 __attribute__((ext_vector_type(2)));
                const f32x2 rsq2 = {rs * rs, rs * rs}, nrs2 = {rs * -1.4426950408889634f, rs * -1.4426950408889634f};
#pragma unroll
                for (int n = 0; n < 2; ++n)
#pragma unroll
                    for (int jp = 0; jp < 2; ++jp) { const f32x4 vg = acc[ai][0][m][n], vu = acc[ai][1][m][n];
                        const f32x2 ag = jp ? __builtin_shufflevector(vg, vg, 2, 3) : __builtin_shufflevector(vg, vg, 0, 1), au = jp ? __builtin_shufflevector(vu, vu, 2, 3) : __builtin_shufflevector(vu, vu, 0, 1);
                        const f32x2 x = ag * nrs2;
                        f32x2 d = {__builtin_amdgcn_exp2f(x.x), __builtin_amdgcn_exp2f(x.y)}; d = d + 1.0f;
                        const f32x2 rc = {__builtin_amdgcn_rcpf(d.x), __builtin_amdgcn_rcpf(d.y)};
                        const f32x2 o = (ag * au) * (rc * rsq2);
                        r[n * 4 + 2 * jp] = o.x; r[n * 4 + 2 * jp + 1] = o.y; }
                u32x4 w; w.x = cvt_pk_bf16(r[0], r[1]); w.y = cvt_pk_bf16(r[2], r[3]); w.z = cvt_pk_bf16(r[4], r[5]); w.w = cvt_pk_bf16(r[6], r[7]);
                *(gu32x4*)rowp = w; }
    }
};
struct EpiResidH {
    static constexpr bool PERM = true, AFTER_DRAIN = false, HAS_INIT = false, HAS_PRE = true;
    struct Pre { f16x8 t[2][2]; };
    const bf16_t* xin; int ldc; float scale; bf16_t* xb; ssq_t* ssq_out;
    __device__ __forceinline__ unsigned lane_off(const Unit& u, int wr, int wc, int fr, int fq) const { return (unsigned)(((u.pm * BM + wr * 64 + fr) * ldc + u.pn * BM + wc * 32 + 8 * fq) * 2); }
    __device__ __forceinline__ void issue_batch(f16x8 (&t)[2][2], unsigned voff, int ai, int mp) const {
        const char* xr = (const char*)xin; asm volatile("" : "+s"(xr));
#pragma unroll
        for (int mm = 0; mm < 2; ++mm) { const char* sb = xr + (size_t)((ai * HALF + (2 * mp + mm) * 16) * ldc) * 2;
            asm volatile("global_load_dwordx4 %0, %1, %2" : "=v"(t[mm][0]) : "v"(voff), "s"(sb));
            asm volatile("global_load_dwordx4 %0, %1, %2 offset:256" : "=v"(t[mm][1]) : "v"(voff), "s"(sb)); }
    }
    __device__ __forceinline__ void pre_issue(Pre& p, const Unit& u, int wr, int wc, int fr, int fq) const { issue_batch(p.t, lane_off(u, wr, wc, fr, fq), 0, 0); }
    __device__ __forceinline__ void pre_wait(Pre& p) const { asm volatile("s_waitcnt vmcnt(16)" : "+v"(p.t[0][0]), "+v"(p.t[0][1]), "+v"(p.t[1][0]), "+v"(p.t[1][1]) :: "memory"); }
    __device__ __forceinline__ void batch(f32x4 (&acc)[2][2][4][2], const f16x8 (&t)[2][2], int ai, int mp, int row0, int col0, int fq, ssq_t (&olds)[8], float sc, bf16_t* xb, ssq_t* ssq_out) const {
        typedef __attribute__((address_space(1))) f16x8 gf16x8;
#pragma unroll
        for (int mm = 0; mm < 2; ++mm) { const int m = 2 * mp + mm, row = row0 + ai * HALF + m * 16; const size_t off = (size_t)row * ldc + col0; float s = 0.f;
#pragma unroll
            for (int bj = 0; bj < 2; ++bj) { const f16x8 b8 = t[mm][bj];
                const f32x4 y0 = __builtin_convertvector(__builtin_shufflevector(b8, b8, 0, 1, 2, 3), f32x4) + acc[ai][bj][m][0] * sc, y1 = __builtin_convertvector(__builtin_shufflevector(b8, b8, 4, 5, 6, 7), f32x4) + acc[ai][bj][m][1] * sc;
                const f16x4 h0 = __builtin_convertvector(y0, f16x4), h1 = __builtin_convertvector(y1, f16x4);
                *(gf16x8*)(xb + off + bj * HALF) = __builtin_shufflevector(h0, h1, 0, 1, 2, 3, 4, 5, 6, 7);
                const f32x4 z0 = __builtin_convertvector(h0, f32x4), z1 = __builtin_convertvector(h1, f32x4);
                s += ((z0[0] * z0[0] + z0[1] * z0[1]) + (z0[2] * z0[2] + z0[3] * z0[3])) + ((z1[0] * z1[0] + z1[1] * z1[1]) + (z1[2] * z1[2] + z1[3] * z1[3])); }
            { const int ln_ = lane_id_here(); s += xor_shfl(s, 16, ln_); s += xor_shfl(s, 32, ln_); }
            olds[ai * 4 + m] = 0;
            if (fq == 0) olds[ai * 4 + m] = __hip_atomic_fetch_add((__attribute__((address_space(1))) ssq_t*)(ssq_out + row), ssq_fix(s), __ATOMIC_RELAXED, __HIP_MEMORY_SCOPE_AGENT); }
    }
#define EPI_WAITB(n, t) asm volatile("s_waitcnt vmcnt(" #n ")" : "+v"(t[0][0]), "+v"(t[0][1]), "+v"(t[1][0]), "+v"(t[1][1]) :: "memory")
    __device__ __forceinline__ void operator()(f32x4 (&acc)[2][2][4][2], const Unit& u, int wr, int wc, int fr, int fq, const Pre& pre) const {
        const int row0 = u.pm * BM + wr * 64 + fr, col0 = u.pn * BM + wc * 32 + 8 * fq;
        const unsigned voff = lane_off(u, wr, wc, fr, fq);
        f16x8 t1[2][2], t2[2][2], t3[2][2];
        issue_batch(t1, voff, 0, 1); issue_batch(t2, voff, 1, 0); issue_batch(t3, voff, 1, 1);
        ssq_t olds[8];
        float sc = scale; bf16_t* xo = xb; ssq_t* so = ssq_out; asm volatile("" : "+s"(sc), "+s"(xo), "+s"(so));
        batch(acc, pre.t, 0, 0, row0, col0, fq, olds, sc, xo, so);
        EPI_WAITB(12, t1);
        batch(acc, t1, 0, 1, row0, col0, fq, olds, sc, xo, so);
        EPI_WAITB(12, t2);
        batch(acc, t2, 1, 0, row0, col0, fq, olds, sc, xo, so);
        EPI_WAITB(12, t3);
        batch(acc, t3, 1, 1, row0, col0, fq, olds, sc, xo, so);
#pragma unroll
        for (int i = 0; i < 8; ++i) asm volatile("" :: "v"(olds[i]));
    }
#undef EPI_WAITB
};

template <class Epi, class Sched, bool ALIGN_EPI = false, bool SP2 = false, int ABL = 0  , bool F16 = false  >
__device__ __forceinline__ void gemm_phase(PG8_LAS unsigned char* lds, const Gemm g, const Sched& S, const Epi& E, int tid_in) {
    int tid_ = tid_in; asm volatile("" : "+v"(tid_));
    const int tid = tid_, wid = __builtin_amdgcn_readfirstlane(tid >> 6), lane = tid & 63, wr = wid >> 2, wc = wid & 3, fr = lane & 15, fq = lane >> 4;
    const int K = g.K, nt = K / BK;
    unsigned voffA[2], voffB[2];
#pragma unroll
    for (int i = 0; i < 2; ++i) { const int R = 8 * (wid + 8 * i) + (lane >> 3), C = (((lane & 7) ^ ((R >> 1) & 7)) << 3); const int Rb = Epi::PERM ? ((R & ~31) + perm32(R & 31)) : R;
        voffA[i] = (unsigned)(R * K + C) * 2u; voffB[i] = (unsigned)(Rb * K + C) * 2u; }
    const unsigned kstep = (unsigned)(BK * 2);
    const unsigned hstep = (unsigned)HALF * (unsigned)K * 2u;
    const unsigned tstep = 2u * hstep;
    const __amdgpu_buffer_rsrc_t rA = __builtin_amdgcn_make_buffer_rsrc((void*)g.A, 0, 0x7ffffff0, 0x00020000), rB = __builtin_amdgcn_make_buffer_rsrc((void*)g.Bt, 0, 0x7ffffff0, 0x00020000);
    const unsigned ldsw = (unsigned)wid * 1024u;
    const int arow = wr * 64 + fr, brow = wc * 32 + fr;
    const int aoff0 = arow * 128 + ((fq ^ ((arow >> 1) & 7)) << 4), aoff1 = aoff0 ^ 64, boff0 = brow * 128 + ((fq ^ ((brow >> 1) & 7)) << 4), boff1 = boff0 ^ 64;
#define PG8_SA(b, h) (((b) * 2 + (h)) * HTB)
#define PG8_SB(b, h) ((4 + (b) * 2 + (h)) * HTB)
#define PG8_STAGE(bufoff, rsrc, goff, voff) do { if (ABL != 2) _Pragma("unroll") for (int _i = 0; _i < 2; ++_i) \
        __builtin_amdgcn_raw_ptr_buffer_load_lds(rsrc, (PG8_LAS void*)(lds + (bufoff) + ldsw + _i * 8192), 16, (voff)[_i], (int)(goff), 0, 0); } while (0)
#define PG8_LDA(dst, b, h) do { if (ABL != 3) _Pragma("unroll") for (int m = 0; m < 4; ++m) { dst[m][0] = *(const PG8_LAS bf16x8*)(lds + PG8_SA(b, h) + aoff0 + m * 2048); dst[m][1] = *(const PG8_LAS bf16x8*)(lds + PG8_SA(b, h) + aoff1 + m * 2048); } } while (0)
#define PG8_LDB(dst, b, h) do { if (ABL != 3) _Pragma("unroll") for (int n = 0; n < 2; ++n) { dst[n][0] = *(const PG8_LAS bf16x8*)(lds + PG8_SB(b, h) + boff0 + n * 2048); dst[n][1] = *(const PG8_LAS bf16x8*)(lds + PG8_SB(b, h) + boff1 + n * 2048); } } while (0)
#define PG8_MMA(ai, bj, At, Bt) do { __builtin_amdgcn_s_setprio(1); _Pragma("unroll") for (int m = 0; m < 4; ++m) _Pragma("unroll") for (int n = 0; n < 2; ++n) _Pragma("unroll") for (int k = 0; k < 2; ++k) { \
        if (ABL == 5) { if (((m & 1) == 0)) acc32[((ai) * 2 + (bj)) * 2 + (m >> 1)] = __builtin_amdgcn_mfma_f32_32x32x16_bf16(Bt[n][k], At[m][k], acc32[((ai) * 2 + (bj)) * 2 + (m >> 1)], 0, 0, 0); else asm volatile("" :: "v"(Bt[n][k]), "v"(At[m][k])); } \
        else if (ABL != 1) { if (F16) acc[ai][bj][m][n] = __builtin_amdgcn_mfma_f32_16x16x32_f16(__builtin_bit_cast(f16x8, Bt[n][k]), __builtin_bit_cast(f16x8, At[m][k]), acc[ai][bj][m][n], 0, 0, 0); \
            else acc[ai][bj][m][n] = __builtin_amdgcn_mfma_f32_16x16x32_bf16(Bt[n][k], At[m][k], acc[ai][bj][m][n], 0, 0, 0); } else asm volatile("" :: "v"(Bt[n][k]), "v"(At[m][k])); } __builtin_amdgcn_s_setprio(0); } while (0)
#define PG8_WAIT_V(n) asm volatile("s_waitcnt vmcnt(" #n ")" ::: "memory")
#define PG8_WAIT_L(n) asm volatile("s_waitcnt lgkmcnt(" #n ")" ::: "memory")
#define PG8_BAR __builtin_amdgcn_s_barrier()
#define PG8_SCHED __builtin_amdgcn_sched_barrier(0)
    Unit cur, nxt; int ui = 0;
    if (!S.next(0, cur)) return;
    f32x4 acc[2][2][4][2];
    if constexpr (Epi::HAS_INIT) E.init(acc, cur, wr, wc, fr, fq);
    else {
    bf16x8 z8 = {0, 0, 0, 0, 0, 0, 0, 0};
#pragma unroll
    for (int a = 0; a < 2; ++a)
#pragma unroll
        for (int b = 0; b < 2; ++b)
#pragma unroll
            for (int m = 0; m < 4; ++m)
#pragma unroll
                for (int n = 0; n < 2; ++n) { asm volatile("" : "+v"(z8)); acc[a][b][m][n] = __builtin_amdgcn_mfma_f32_16x16x32_bf16(z8, z8, (f32x4){0.f, 0.f, 0.f, 0.f}, 0, 0, 0); }
    }
    bf16x8 At[4][2], B0[2][2], B1[2][2];
    typename Epi::Pre pre = {};
    typedef float f32x16_t __attribute__((ext_vector_type(16))); f32x16_t acc32[8];
    if (ABL == 5) { _Pragma("unroll") for (int i = 0; i < 8; ++i) _Pragma("unroll") for (int r = 0; r < 16; ++r) acc32[i][r] = 0.f; }
    if (ABL == 3) { _Pragma("unroll") for (int m = 0; m < 4; ++m) _Pragma("unroll") for (int k = 0; k < 2; ++k) At[m][k] = (bf16x8){1, 2, 3, 4, 5, 6, 7, 8}; _Pragma("unroll") for (int n = 0; n < 2; ++n) _Pragma("unroll") for (int k = 0; k < 2; ++k) { B0[n][k] = (bf16x8){8, 7, 6, 5, 4, 3, 2, 1}; B1[n][k] = (bf16x8){1, 1, 2, 2, 3, 3, 4, 4}; } }
    unsigned cA = (unsigned)cur.pm * tstep, cB = (unsigned)cur.pn * tstep;
    S.a_ready(cur);
    if constexpr (SP2) {
        PG8_STAGE(PG8_SB(0, 0), rB, cB, voffB); PG8_STAGE(PG8_SB(0, 1), rB, cB + hstep, voffB); PG8_STAGE(PG8_SA(0, 0), rA, cA, voffA); PG8_STAGE(PG8_SA(0, 1), rA, cA + hstep, voffA);
        if (wr == 1) PG8_BAR;
        PG8_WAIT_V(2); PG8_BAR;
        PG8_STAGE(PG8_SB(1, 0), rB, cB + kstep, voffB); PG8_STAGE(PG8_SA(1, 0), rA, cA + kstep, voffA); PG8_STAGE(PG8_SB(1, 1), rB, cB + hstep + kstep, voffB);
        PG8_WAIT_V(6); PG8_BAR;
    } else {
        PG8_STAGE(PG8_SB(0, 0), rB, cB, voffB); PG8_STAGE(PG8_SA(0, 0), rA, cA, voffA); PG8_STAGE(PG8_SB(0, 1), rB, cB + hstep, voffB); PG8_STAGE(PG8_SA(0, 1), rA, cA + hstep, voffA);
        if (wr == 1) PG8_BAR;
        PG8_WAIT_V(4); PG8_BAR;
        PG8_STAGE(PG8_SB(1, 0), rB, cB + kstep, voffB); PG8_STAGE(PG8_SA(1, 0), rA, cA + kstep, voffA); PG8_STAGE(PG8_SB(1, 1), rB, cB + hstep + kstep, voffB);
        PG8_WAIT_V(6); PG8_BAR;
    }
    for (;;) {
        const bool has_next = S.next(ui + 1, nxt);
        const unsigned nA = has_next ? (unsigned)nxt.pm * tstep : cA, nB = has_next ? (unsigned)nxt.pn * tstep : cB;
        for (int t = 0; t < nt; t += 2) {
            const bool last = (t == nt - 2);
            const unsigned a1 = cA + (unsigned)(t + 1) * kstep;
            const unsigned a2 = last ? nA : cA + (unsigned)(t + 2) * kstep, b2 = last ? nB : cB + (unsigned)(t + 2) * kstep;
            const unsigned a3 = a2 + kstep, b3 = b2 + kstep;
            if (last && has_next) S.a_ready(nxt);
            if constexpr (Epi::HAS_PRE) { if (last) E.pre_issue(pre, cur, wr, wc, fr, fq); }
            if constexpr (SP2) {
            PG8_LDB(B0, 0, 0); PG8_LDB(B1, 0, 1); PG8_SCHED; PG8_LDA(At, 0, 0); PG8_STAGE(PG8_SA(1, 1), rA, a1 + hstep, voffA);
            PG8_WAIT_V(8); PG8_WAIT_L(0); PG8_BAR; PG8_MMA(0, 0, At, B0); PG8_MMA(0, 1, At, B1); PG8_BAR; PG8_SCHED;
            PG8_LDA(At, 0, 1); PG8_STAGE(PG8_SB(0, 0), rB, b2, voffB); PG8_STAGE(PG8_SB(0, 1), rB, b2 + hstep, voffB); PG8_STAGE(PG8_SA(0, 0), rA, a2, voffA);
            PG8_WAIT_V(8); PG8_WAIT_L(0); PG8_BAR; PG8_MMA(1, 0, At, B0); PG8_MMA(1, 1, At, B1); PG8_BAR; PG8_SCHED;
            PG8_LDB(B0, 1, 0); PG8_LDB(B1, 1, 1); PG8_SCHED; PG8_LDA(At, 1, 0); PG8_STAGE(PG8_SA(0, 1), rA, a2 + hstep, voffA);
            PG8_WAIT_V(8); PG8_WAIT_L(0); PG8_BAR; PG8_MMA(0, 0, At, B0); PG8_MMA(0, 1, At, B1); PG8_BAR; PG8_SCHED;
            PG8_LDA(At, 1, 1); PG8_STAGE(PG8_SB(1, 0), rB, b3, voffB); PG8_STAGE(PG8_SB(1, 1), rB, b3 + hstep, voffB); PG8_STAGE(PG8_SA(1, 0), rA, a3, voffA);
            PG8_WAIT_V(8); PG8_WAIT_L(0); PG8_BAR; PG8_MMA(1, 0, At, B0); PG8_MMA(1, 1, At, B1); PG8_BAR; PG8_SCHED;
            } else {
            PG8_LDB(B0, 0, 0); PG8_SCHED; PG8_LDA(At, 0, 0); PG8_STAGE(PG8_SA(1, 1), rA, a1 + hstep, voffA);
            PG8_WAIT_L(8); PG8_BAR; PG8_WAIT_L(0); PG8_MMA(0, 0, At, B0); PG8_BAR; PG8_SCHED;
            PG8_LDB(B1, 0, 1); PG8_STAGE(PG8_SB(0, 0), rB, b2, voffB);
            PG8_BAR; PG8_WAIT_L(0); PG8_MMA(0, 1, At, B1); PG8_BAR;
            PG8_LDA(At, 0, 1); PG8_STAGE(PG8_SA(0, 0), rA, a2, voffA);
            PG8_BAR; PG8_WAIT_L(0); PG8_MMA(1, 0, At, B0); PG8_BAR; PG8_SCHED;
            PG8_STAGE(PG8_SB(0, 1), rB, b2 + hstep, voffB);
            PG8_WAIT_V(6); PG8_BAR; PG8_MMA(1, 1, At, B1); PG8_BAR;
            PG8_LDB(B0, 1, 0); PG8_SCHED; PG8_LDA(At, 1, 0); PG8_STAGE(PG8_SA(0, 1), rA, a2 + hstep, voffA);
            PG8_WAIT_L(8); PG8_BAR; PG8_WAIT_L(0); PG8_MMA(0, 0, At, B0); PG8_BAR; PG8_SCHED;
            PG8_LDB(B1, 1, 1); PG8_STAGE(PG8_SB(1, 0), rB, b3, voffB);
            PG8_BAR; PG8_WAIT_L(0); PG8_MMA(0, 1, At, B1); PG8_BAR;
            PG8_LDA(At, 1, 1); PG8_STAGE(PG8_SA(1, 0), rA, a3, voffA);
            PG8_BAR; PG8_WAIT_L(0); PG8_MMA(1, 0, At, B0); PG8_BAR; PG8_SCHED;
            PG8_STAGE(PG8_SB(1, 1), rB, b3 + hstep, voffB);
            PG8_WAIT_V(6); PG8_BAR; PG8_MMA(1, 1, At, B1); PG8_BAR;
            }
        }
        if constexpr (ALIGN_EPI) { if (wr == 0) PG8_BAR; }
        if constexpr (!Epi::AFTER_DRAIN) { if constexpr (Epi::HAS_PRE) { E.pre_wait(pre); E(acc, cur, wr, wc, fr, fq, pre); } else E(acc, cur, wr, wc, fr, fq); S.done(cur); }
        if (!has_next) break;
        if constexpr (Epi::HAS_INIT) E.init(acc, nxt, wr, wc, fr, fq);
        else {
        bf16x8 z8 = {0, 0, 0, 0, 0, 0, 0, 0}; asm volatile("" : "+v"(z8));
#pragma unroll
        for (int a = 0; a < 2; ++a)
#pragma unroll
            for (int b = 0; b < 2; ++b)
#pragma unroll
                for (int m = 0; m < 4; ++m)
#pragma unroll
                    for (int n = 0; n < 2; ++n) { asm volatile("" : "+v"(z8));
                        acc[a][b][m][n] = __builtin_amdgcn_mfma_f32_16x16x32_bf16(z8, z8, (f32x4){0.f, 0.f, 0.f, 0.f}, 0, 0, 0); }
        }
        cur = nxt; cA = nA; cB = nB; ++ui;
        if constexpr (ALIGN_EPI) { if (wr == 1) PG8_BAR; }
    }
    PG8_WAIT_V(0);
    if constexpr (!ALIGN_EPI) { if (wr == 0) PG8_BAR; }
    PG8_BAR;
    if constexpr (Epi::AFTER_DRAIN) { E.fused(acc, cur, wr, wc, fr, fq, lds, wid, lane); S.done(cur); }
    if (ABL == 5) { _Pragma("unroll") for (int i = 0; i < 8; ++i) asm volatile("" :: "v"(acc32[i])); }
#undef PG8_SA
#undef PG8_SB
#undef PG8_STAGE
#undef PG8_LDA
#undef PG8_LDB
#undef PG8_MMA
#undef PG8_WAIT_V
#undef PG8_WAIT_L
#undef PG8_BAR
#undef PG8_SCHED
}
}

constexpr int NWAVES = 8;
constexpr int D = 2048, BATCH = 4, SEQ = 2048, DEPTH = 4, HD = 128, FF = 5632;
constexpr int M = BATCH * SEQ;
constexpr int AB_IN = 4608, C_IN = 6144;
constexpr float RMS_EPS = 1e-6f;
constexpr float QK_SCALE = 0.08838834764831845f;

constexpr size_t MiB = 1u << 20;
constexpr size_t WS_CTL = 0, CTL_ZERO_BYTES = 1 * MiB;
constexpr size_t SZ_WGU = (size_t)2 * FF * D * 2, SZ_WD = (size_t)D * FF * 2, SZ_WABIN = (size_t)AB_IN * D * 2, SZ_WOUT = (size_t)D * D * 2, SZ_WCIN = (size_t)C_IN * D * 2;
constexpr size_t WS_WGU = 2 * MiB;
constexpr size_t WS_WD = WS_WGU + 8 * SZ_WGU;
constexpr size_t WS_WABIN = WS_WD + 8 * SZ_WD;
constexpr size_t WS_WABOUT = WS_WABIN + 2 * SZ_WABIN;
constexpr size_t WS_WCIN = WS_WABOUT + 2 * SZ_WOUT;
constexpr size_t WS_WCOUT = WS_WCIN + 2 * SZ_WCIN;
constexpr size_t WS_H = WS_WCOUT + 2 * SZ_WOUT;
constexpr size_t WS_U = WS_H + (size_t)M * D * 2;
constexpr size_t WS_QKV = WS_U + (size_t)M * FF * 2;
constexpr size_t WS_O = WS_QKV + (size_t)M * C_IN * 2;
constexpr size_t WS_PART = WS_O + (size_t)M * D * 2;
constexpr size_t WS_LSE = WS_PART + (size_t)3 * M * 1024 * 4;
constexpr size_t WS_END = WS_LSE + (size_t)3 * M * 8 * 4;
constexpr int CW_BAR = 4096;
constexpr size_t WS_SSQ = 65536;
constexpr size_t WS_SB = 917504;
static_assert(WS_SB >= WS_SSQ + (size_t)13 * 8192 * 8 && WS_SB + 128 * 17 * 32 <= CTL_ZERO_BYTES, "token-barrier counters inside the memset region");
#ifndef NSTREAMS
#define NSTREAMS 2
#endif
constexpr int NSTREAM = NSTREAMS, MH = M / NSTREAM;
static_assert(WS_SSQ + (size_t)13 * 8192 * 8 <= CTL_ZERO_BYTES, "ssq slots inside the memset region");

constexpr int RING_OFF = 0, RING_BYTES = 131072;
constexpr int LDSCTL_OFF = RING_BYTES, MISC_OFF = LDSCTL_OFF + 320;
constexpr int LDS_BYTES = 147456;
static_assert(MISC_OFF + 128 <= LDS_BYTES, "LDS map");

#define GAS __attribute__((address_space(1)))
#define LAS __attribute__((address_space(3)))
typedef unsigned short bf16;
typedef unsigned v4u __attribute__((ext_vector_type(4)));
typedef unsigned v2u __attribute__((ext_vector_type(2)));
typedef float f32x4 __attribute__((ext_vector_type(4)));
typedef GAS unsigned gu32;
#define RLX_AGENT __ATOMIC_RELAXED, __HIP_MEMORY_SCOPE_AGENT
#define LDS_WAIT() asm volatile("s_waitcnt lgkmcnt(0)" ::: "memory")
#define VM_WAIT() asm volatile("s_waitcnt vmcnt(0)" ::: "memory")
__device__ __forceinline__ unsigned f2bf(float f) { unsigned u = __builtin_bit_cast(unsigned, f); return (u + 0x7fffu + ((u >> 16) & 1u)) >> 16; }
__device__ __forceinline__ unsigned pk2(float lo, float hi) { return f2bf(lo) | (f2bf(hi) << 16); }
typedef _Float16 h2_t __attribute__((ext_vector_type(2))); typedef float f2_t __attribute__((ext_vector_type(2))); typedef _Float16 h4_t __attribute__((ext_vector_type(4)));
__device__ __forceinline__ unsigned pkh2(float lo, float hi) { const f2_t v = {lo, hi}; return __builtin_bit_cast(unsigned, __builtin_convertvector(v, h2_t)); }
__device__ __forceinline__ float bflo(unsigned w) { return __builtin_bit_cast(float, w << 16); }
__device__ __forceinline__ float bfhi(unsigned w) { return __builtin_bit_cast(float, w & 0xffff0000u); }

#define XB_TMO      128
#define XB_XCNT(j)  (256  + 64 * (j))
#define XB_XSUB(j)  (1280 + 64 * (j))
#define XB_XGEN(j)  (2304 + 64 * (j))
#define XB_TOP      3328
#define XB_TOPGEN   3392
#define XCD_BAR_WORDS 3456
#define XB_SPIN_CAP (1u << 18)

__device__ __forceinline__ unsigned xb_ld(unsigned* p)              { return __hip_atomic_load(p, __ATOMIC_RELAXED, __HIP_MEMORY_SCOPE_AGENT); }
__device__ __forceinline__ unsigned xb_add(unsigned* p, unsigned v) { return __hip_atomic_fetch_add(p, v, __ATOMIC_RELAXED, __HIP_MEMORY_SCOPE_AGENT); }
__device__ __forceinline__ unsigned xb_xcc_id() { return (unsigned)__builtin_amdgcn_s_getreg((3 << 11) | 20) & 0xFu; }
#define XB_SPIN(cond, bar) do { unsigned _sp = 0; while (cond) { __builtin_amdgcn_s_sleep(1); \
    if ((++_sp & 255u) == 0u) { if (xb_ld(&(bar)[XB_TMO])) break; if (_sp > XB_SPIN_CAP) { atomicAdd(&(bar)[XB_TMO], 1u); break; } } } } while (0)

struct XcdBarrier {
    int wv;
    unsigned* bar; unsigned x;
    volatile LAS unsigned* st;
};

__device__ __forceinline__ int xb_lane() { int l; asm volatile("v_mbcnt_lo_u32_b32 %0, -1, 0\n\tv_mbcnt_hi_u32_b32 %0, -1, %0" : "=v"(l)); return l; }
__device__ __forceinline__ XcdBarrier xcd_barrier_post(unsigned* bar, volatile LAS unsigned* st, int wv) {
    XcdBarrier b; b.wv = wv; b.bar = bar; b.x = xb_xcc_id(); b.st = st;
    if (wv == 0 && xb_lane() == 0) (void)xb_add(&bar[XB_XCNT(b.x)], 1u);
    return b;
}
__device__ __forceinline__ void xcd_barrier_complete(unsigned* bar, unsigned x, unsigned& nloc, unsigned& nx) {
    const unsigned G = gridDim.x * gridDim.y * gridDim.z;
    unsigned sum, cnt, mine, sp = 0u;
    for (;;) {
        sum = 0u; cnt = 0u; mine = 0u;
#pragma unroll
        for (unsigned j = 0; j < 16; ++j) { const unsigned c = xb_ld(&bar[XB_XCNT(j)]); sum += c; cnt += (c > 0u) ? 1u : 0u; mine = (j == x) ? c : mine; }
        if (sum == G) break;
        __builtin_amdgcn_s_sleep(1);
        if ((++sp & 255u) == 0u) { if (xb_ld(&bar[XB_TMO])) break; if (sp > XB_SPIN_CAP) { atomicAdd(&bar[XB_TMO], 1u); break; } }
    }
    nloc = mine > 0u ? mine : 1u; nx = cnt > 0u ? cnt : 1u;
}

__device__ __forceinline__ void xcd_barrier(const XcdBarrier& b) {
    asm volatile("s_waitcnt vmcnt(0)" ::: "memory");
    __syncthreads();
    if (b.wv == 0 && xb_lane() == 0) {
        unsigned* bar = b.bar; unsigned bx = b.x; asm volatile("" : "+s"(bar), "+s"(bx));
        __builtin_amdgcn_s_waitcnt(0);
        unsigned nloc = b.st[0], nx = b.st[1];
        if (nloc == 0u) { xcd_barrier_complete(bar, bx, nloc, nx); b.st[0] = nloc; b.st[1] = nx; }
        const unsigned old = xb_add(&bar[XB_XSUB(bx)], 1u);
        const unsigned gen = old / nloc;
        if (old + 1u == (gen + 1u) * nloc) {
            __builtin_amdgcn_fence(__ATOMIC_RELEASE, "agent");
            asm volatile("s_waitcnt vmcnt(0)" ::: "memory");
            const unsigned og = xb_add(&bar[XB_TOP], 1u);
            const unsigned tg = og / nx;
            if (og + 1u == (tg + 1u) * nx) xb_add(&bar[XB_TOPGEN], 1u);
            else XB_SPIN(xb_ld(&bar[XB_TOPGEN]) == tg, bar);
            __builtin_amdgcn_fence(__ATOMIC_ACQUIRE, "agent");
            xb_add(&bar[XB_XGEN(bx)], 1u);
            asm volatile("s_waitcnt vmcnt(0)" ::: "memory");
        } else {
            XB_SPIN(xb_ld(&bar[XB_XGEN(bx)]) == gen, bar);
            __builtin_amdgcn_fence(__ATOMIC_ACQUIRE, "agent");
            asm volatile("s_waitcnt vmcnt(0)" ::: "memory");
        }
    }
    __syncthreads();
}

#define SB_TOKEN_WORDS (17 * 8)
__device__ __forceinline__ void sb_arrive(const XcdBarrier& b, unsigned* sb, int T) {
    asm volatile("s_waitcnt vmcnt(0)" ::: "memory");
    __syncthreads();
    if (b.wv == 0 && xb_lane() == 0) {
        unsigned* base = sb + (size_t)T * SB_TOKEN_WORDS; unsigned bx = b.x; asm volatile("" : "+s"(base), "+s"(bx));
        __builtin_amdgcn_s_waitcnt(0);
        const unsigned nloc = b.st[0];
        const unsigned old = xb_add(&base[8 * bx], 1u);
        if (old + 1u == nloc) {
            __builtin_amdgcn_fence(__ATOMIC_RELEASE, "agent");
            asm volatile("s_waitcnt vmcnt(0)" ::: "memory");
            xb_add(&base[8 * 16], 1u);
        }
    }
}
__device__ __forceinline__ void sb_wait(const XcdBarrier& b, unsigned* sb, int T) {
    if (b.wv == 0 && xb_lane() == 0) {
        unsigned* base = sb + (size_t)T * SB_TOKEN_WORDS; asm volatile("" : "+s"(base));
        const unsigned nx = b.st[1];
        XB_SPIN(xb_ld(&base[8 * 16]) < nx, b.bar);
        __builtin_amdgcn_fence(__ATOMIC_ACQUIRE, "agent");
        asm volatile("s_waitcnt vmcnt(0)" ::: "memory");
    }
    __syncthreads();
}

struct Frame {
    LAS unsigned char* lds;
    int tid, lane, wave;
    int G, bid;
};
__device__ __forceinline__ float wave_sum(float v) {
    const int ln_ = pg8::lane_id_here();
#pragma unroll
    for (int o = 1; o < 64; o <<= 1) v += pg8::xor_shfl(v, o, ln_);
    return v;
}
__device__ __forceinline__ float wave_max(float v) {
    const int ln_ = pg8::lane_id_here();
#pragma unroll
    for (int o = 1; o < 64; o <<= 1) v = fmaxf(v, pg8::xor_shfl(v, o, ln_));
    return v;
}
template <bool GAIN>
__device__ __forceinline__ void p0_transpose_item(const float* W, int K, int N, bf16* WT, int k0, int n0, int drow0, LAS float* scr, int lane, const float* gain) {
    const int c = lane & 7;
    f32x4 ga = {1.f, 1.f, 1.f, 1.f}, gb = {1.f, 1.f, 1.f, 1.f};
    if (GAIN) { ga = *(const GAS f32x4*)(gain + k0 + 8 * c); gb = *(const GAS f32x4*)(gain + k0 + 8 * c + 4); }
#pragma unroll 8
    for (int i = 0; i < 32; ++i) { const int kk = 2 * i + (lane >> 5); scr[kk * 33 + (lane & 31)] = __builtin_nontemporal_load(W + (size_t)(k0 + kk) * N + n0 + (lane & 31)); }
    LDS_WAIT(); asm volatile("" ::: "memory");
#pragma unroll
    for (int j = 0; j < 4; ++j) { const int n = (lane >> 3) + 8 * j; const LAS float* s = scr + (8 * c) * 33 + n;
        v4u o;
        if (GAIN && RESID_F16) { o.x = pkh2(s[0 * 33] * ga.x, s[1 * 33] * ga.y); o.y = pkh2(s[2 * 33] * ga.z, s[3 * 33] * ga.w); o.z = pkh2(s[4 * 33] * gb.x, s[5 * 33] * gb.y); o.w = pkh2(s[6 * 33] * gb.z, s[7 * 33] * gb.w); }
        else { o.x = pk2(s[0 * 33] * ga.x, s[1 * 33] * ga.y); o.y = pk2(s[2 * 33] * ga.z, s[3 * 33] * ga.w); o.z = pk2(s[4 * 33] * gb.x, s[5 * 33] * gb.y); o.w = pk2(s[6 * 33] * gb.z, s[7 * 33] * gb.w); }
        __builtin_nontemporal_store(o, (GAS v4u*)(WT + (size_t)(drow0 + n) * K + k0 + 8 * c)); }
    LDS_WAIT(); asm volatile("" ::: "memory");
}
struct Args {
    const float* x; const float* ffn_norm; const float* wg; const float* wu; const float* wd; const float* mix_norm;
    const float* ab_in; const float* ab_out; const float* ab_sink; const float* c_in; const float* c_out; const float* c_rpb; const float* final_norm;
    float* out; unsigned char* ws; int ph_lo, ph_hi;
};
static_assert(sizeof(Args) == 15 * 8 + 8, "Args has no padding");

constexpr int CV_NSLOT = 11, CV_MAXR = 1;
__device__ const int CV_TAB[CV_NSLOT][CV_MAXR][2] = {
    {{0, 164864}},
    {{0, 0}},
    {{0, 0}},
    {{0, 0}},
    {{0, 0}},
    {{0, 0}},
    {{0, 0}},
    {{0, 0}},
    {{0, 0}},
    {{0, 0}},
    {{0, 0}},
};

constexpr int CV_I_GU = (D / 64) * (FF / 32), CV_I_D = (FF / 64) * (D / 32), CV_I_ABIN = (D / 64) * (AB_IN / 32), CV_I_OUT = (D / 64) * (D / 32), CV_I_CIN = (D / 64) * (C_IN / 32);
constexpr int CV_EVEN = 2 * CV_I_GU + CV_I_D + CV_I_ABIN + CV_I_OUT + 2 * CV_I_GU + CV_I_D, CV_ODD = CV_EVEN - CV_I_ABIN + CV_I_CIN;
static_assert(2 * (CV_EVEN + CV_ODD) == 164864, "item count");
__device__ __forceinline__ void cv_item(const Args& a, unsigned char* ws, int it, LAS float* scr, int lane) {
    const int pr = it / (CV_EVEN + CV_ODD); int r = it - pr * (CV_EVEN + CV_ODD); int layer = 2 * pr; if (r >= CV_EVEN) { r -= CV_EVEN; ++layer; }
    const int li = layer >> 1; const bool odd = layer & 1; const int nin = odd ? CV_I_CIN : CV_I_ABIN;
    int f = 0, kind;
    if (r < 2 * CV_I_GU) kind = 0; else { r -= 2 * CV_I_GU; if (r < CV_I_D) kind = 1; else { r -= CV_I_D; if (r < nin) kind = 2; else { r -= nin; if (r < CV_I_OUT) kind = 3; else { r -= CV_I_OUT; f = 1;
        if (r < 2 * CV_I_GU) kind = 0; else { r -= 2 * CV_I_GU; kind = 1; } } } } }
    const int lf = layer * 2 + f;
    if (kind == 0) { const int up = r >= CV_I_GU; if (up) r -= CV_I_GU; const int nblk = FF / 32, kb = r / nblk, nb = r % nblk, n0 = 32 * nb;
        p0_transpose_item<true>((up ? a.wu : a.wg) + (size_t)lf * D * FF, D, FF, (bf16*)(ws + WS_WGU + (size_t)lf * SZ_WGU), 64 * kb, n0, (n0 >> 7) * 256 + (n0 & 127) + up * 128, scr, lane, a.ffn_norm + (size_t)lf * D); }
    else if (kind == 1) { const int nblk = D / 32, kb = r / nblk, nb = r % nblk, n0 = 32 * nb;
        p0_transpose_item<false>(a.wd + (size_t)lf * FF * D, FF, D, (bf16*)(ws + WS_WD + (size_t)lf * SZ_WD), 64 * kb, n0, n0, scr, lane, nullptr); }
    else if (kind == 2) {
        if (!odd) { const int nblk = AB_IN / 32, kb = r / nblk, nb = r % nblk, n0 = 32 * nb;
            p0_transpose_item<true>(a.ab_in + (size_t)li * D * AB_IN, D, AB_IN, (bf16*)(ws + WS_WABIN + (size_t)li * SZ_WABIN), 64 * kb, n0, n0, scr, lane, a.mix_norm + (size_t)layer * D); }
        else { const int nblk = C_IN / 32, kb = r / nblk, nb = r % nblk, n0 = 32 * nb;
            p0_transpose_item<true>(a.c_in + (size_t)li * D * C_IN, D, C_IN, (bf16*)(ws + WS_WCIN + (size_t)li * SZ_WCIN), 64 * kb, n0, n0, scr, lane, a.mix_norm + (size_t)layer * D); } }
    else { const int nblk = D / 32, kb = r / nblk, nb = r % nblk, n0 = 32 * nb;
        p0_transpose_item<false>((odd ? a.c_out : a.ab_out) + (size_t)li * D * D, D, D, (bf16*)(ws + (odd ? WS_WCOUT : WS_WABOUT) + (size_t)li * SZ_WOUT), 64 * kb, n0, n0, scr, lane, nullptr); }
}
__device__ __forceinline__ void cv_run(const Frame& F, const Args& a, unsigned char* ws, int slot, int j, int n) {
    LAS float* scr = (LAS float*)(F.lds + RING_OFF + F.wave * 16384);
    int lane = F.lane; asm volatile("" : "+v"(lane));
    int total = 0;
#pragma unroll
    for (int r = 0; r < CV_MAXR; ++r) total += CV_TAB[slot][r][1] - CV_TAB[slot][r][0];
    for (int idx = j * NWAVES + F.wave; idx < total; idx += n * NWAVES) {
        int rem = idx, it = 0;
#pragma unroll
        for (int r = 0; r < CV_MAXR; ++r) { const int b = CV_TAB[slot][r][0], len = CV_TAB[slot][r][1] - b; if (rem >= 0 && rem < len) it = b + rem; rem -= len; }
        cv_item(a, ws, it, scr, lane);
    }
}
__device__ __forceinline__ void p0_prologue(const Frame& F, const Args& a) {
    const int gw = F.bid * NWAVES + F.wave, NGW = F.G * NWAVES;
    int lane = F.lane; asm volatile("" : "+v"(lane));
    cv_run(F, a, a.ws, 0, F.bid, F.G);
    bf16* const XB = (bf16*)(a.ws + WS_H); pg8::ssq_t* const ssq0 = (pg8::ssq_t*)(a.ws + WS_SSQ);
    for (int m = gw; m < M; m += NGW) {
        const GAS f32x4* xr = (const GAS f32x4*)(a.x + (size_t)m * D) + lane;
        f32x4 v[8]; float s = 0.f;
#pragma unroll
        for (int j = 0; j < 8; ++j) { v[j] = xr[64 * j]; s += (v[j].x * v[j].x + v[j].y * v[j].y) + (v[j].z * v[j].z + v[j].w * v[j].w); }
        s = wave_sum(s);
        s = 0.f;
#pragma unroll
        for (int j = 0; j < 8; ++j) { const h4_t hq = __builtin_convertvector(v[j], h4_t); ((GAS h4_t*)(XB + (size_t)m * D) + lane)[64 * j] = hq; const f32x4 y = __builtin_convertvector(hq, f32x4); s += (y.x * y.x + y.y * y.y) + (y.z * y.z + y.w * y.w); }
        s = wave_sum(s);
        if (lane == 0) ssq0[m] = pg8::ssq_fix(s);
    }
}
__device__ __forceinline__ void final_norm_h_phase(const Frame& F, const bf16* xb, float* out, const float* g, const pg8::ssq_t* ssq, const int stream) {
    const int gw = F.bid * NWAVES + F.wave, NGW = F.G * NWAVES;
    int lane = F.lane; asm volatile("" : "+v"(lane));
    for (int m = stream * MH + gw; m < (stream + 1) * MH; m += NGW) {
        const GAS h4_t* xr = (const GAS h4_t*)(xb + (size_t)m * D) + lane; GAS f32x4* orow = (GAS f32x4*)(out + (size_t)m * D) + lane; const GAS f32x4* gr = (const GAS f32x4*)g + lane;
        const float rstd = 1.0f / sqrtf(pg8::ssq_val(((const GAS pg8::ssq_t*)ssq)[m + (lane & 0)]) * (1.f / D) + RMS_EPS);
        h4_t xv[8]; f32x4 gv[8];
#pragma unroll
        for (int j = 0; j < 8; ++j) { xv[j] = xr[64 * j]; gv[j] = gr[64 * j]; }
#pragma unroll
        for (int j = 0; j < 8; ++j) orow[64 * j] = __builtin_convertvector(xv[j], f32x4) * rstd * gv[j];
    }
}
namespace att {
using bf16x8 = __attribute__((ext_vector_type(8))) short;
using s16x4  = __attribute__((ext_vector_type(4))) short;
using f32x16 = __attribute__((ext_vector_type(16))) float;
using u32x4  = __attribute__((ext_vector_type(4))) unsigned;
constexpr float LOG2E = 1.4426950408889634f;
constexpr float CSC = 0.08838834764831845f * LOG2E;
constexpr float THR_L2 = 4.0f * LOG2E;
#define ATT_KSWZ(row, colB) ((row) * 256 + ((colB) ^ (((row) & 7) << 4)))
__device__ __forceinline__ constexpr int crowc(int r) { return (r & 3) + 8 * (r >> 2); }
__device__ __forceinline__ unsigned cvtpk(float lo, float hi) { unsigned r; asm volatile("v_cvt_pk_bf16_f32 %0, %1, %2" : "=v"(r) : "v"(lo), "v"(hi)); return r; }
__device__ __forceinline__ int swap23(int k) { return (k & ~0xC) | ((k & 4) << 1) | ((k & 8) >> 1); }
__device__ __forceinline__ int v_rd_base(int lane) { return ((lane & 3) << 3) | (((lane >> 2) & 3) << 6) | (((lane >> 4) & 1) << 5) | (((lane >> 5) & 1) << 8); }
constexpr int v_rd_off(int d0, int ks, int half) { return d0 * 512 + ks * 4096 + half * 2048; }
template <int OFF> __device__ __forceinline__ s16x4 tr_read(int vb) { s16x4 r; asm volatile("ds_read_b64_tr_b16 %0, %1 offset:%2" : "=&v"(r) : "v"(vb), "i"(OFF) : "memory"); return r; }
template <int D0> __device__ __forceinline__ void pv_one(f32x16& od, int vb, bf16x8 pa0, bf16x8 pa1) {
    const s16x4 l0 = tr_read<v_rd_off(D0, 0, 0)>(vb), h0 = tr_read<v_rd_off(D0, 0, 1)>(vb), l1 = tr_read<v_rd_off(D0, 1, 0)>(vb), h1 = tr_read<v_rd_off(D0, 1, 1)>(vb);
    asm volatile("s_waitcnt lgkmcnt(0)" ::: "memory"); __builtin_amdgcn_sched_barrier(0);
#define ATT_PK(L, H) (bf16x8){L[0], L[1], L[2], L[3], H[0], H[1], H[2], H[3]}
    od = __builtin_amdgcn_mfma_f32_32x32x16_bf16(pa0, ATT_PK(l0, h0), od, 0, 0, 0);
    od = __builtin_amdgcn_mfma_f32_32x32x16_bf16(pa1, ATT_PK(l1, h1), od, 0, 0, 0);
#undef ATT_PK
}
constexpr int ATT_SCR_OFF = 132096;
constexpr int ATT_RPB_OFF = 136192;
constexpr int RPB_PAD = 8, RPB_FLOATS = 640;
static_assert(ATT_RPB_OFF + 4 * RPB_FLOATS * 4 <= LDS_BYTES && ATT_SCR_OFF >= MISC_OFF + 128, "attention LDS map");

template <int MODE>
__device__ __forceinline__ void attn_mfma(const Frame& F, const bf16* QKV, const int ld, bf16* O, float* part, float* lsebuf, const float* extra, const int stream, const int vc) {
    int lane = F.lane; asm volatile("" : "+v"(lane));
    const int wid = F.wave, pair = wid >> 1, w2 = wid & 1, r32 = lane & 31, hi = lane >> 5;
    LAS unsigned char* const pbase = F.lds + RING_OFF + ((MODE == 1) ? 0 : pair * 32768);
    LAS float* const scr = (LAS float*)(F.lds + ATT_SCR_OFF + wid * 512);
    LAS float* const rpbt = (LAS float*)(F.lds + ATT_RPB_OFF + pair * (RPB_FLOATS * 4));
    constexpr int NT = (MODE == 0) ? 6 : (MODE == 1) ? 10 : 11;
    constexpr int NUNITS = ((MODE == 0) ? 3072 : (MODE == 1) ? 1024 : 2048) / NSTREAM;
    constexpr int HW = (MODE == 0) ? 64 : 128;
    const int vb0 = (int)(uintptr_t)(pbase + 8192) + v_rd_base(lane);
    for (int g = vc; g < NUNITS / 4; g += F.G) {
        const int u = g * 4 + pair;
        int b, h, qcol, kcol, vcol, shift = 0, jres = 0, l0 = 0, L = SEQ, pat = 0, rbase = 0, c0 = 0, qr0 = 0, qc0 = 0;
        if (MODE == 0) { const int blk = u & 31, rest = u >> 5; pat = rest % 3; const int bh = rest / 3; h = bh & 7; b = (BATCH / NSTREAM) * stream + (bh >> 3); shift = 2 * pat; L = SEQ >> shift;
            const int nbs = 5 - shift; jres = blk >> nbs; l0 = 64 * (blk & ((1 << nbs) - 1)); qcol = h * HD; kcol = 1024 + h * HD; vcol = 2048 + h * HD; }
        else if (MODE == 1) { const int blk = g & 31, bk = g >> 5; h = 4 * (bk & 1) + pair; b = (BATCH / NSTREAM) * stream + (bk >> 1); l0 = 64 * blk; qcol = 3072 + h * HD; kcol = 4096 + (h >> 2) * HD; vcol = 4352 + (h >> 2) * HD; }
        else { const int cc = u & 3, ii = (u >> 2) & 7, bh = u >> 5; h = bh & 15; b = (BATCH / NSTREAM) * stream + (bh >> 4); qr0 = 4 * ii; qc0 = 16 * cc; rbase = qr0 - 4; rbase = rbase < 0 ? 0 : (rbase > 21 ? 21 : rbase);
            c0 = (cc == 0) ? 0 : (cc == 1) ? 8 : (cc == 2) ? 24 : 32; qcol = h * HD; kcol = 2048 + h * HD; vcol = 4096 + h * HD; }
        const bf16* const Qb = QKV + (size_t)b * SEQ * ld;
        int lq = 0, qrow = 0, qcl = 0, sq;
        if (MODE == 2) { qrow = qr0 + 2 * w2 + (r32 >> 4); qcl = qc0 + (r32 & 15); sq = qrow * 64 + qcl; }
        else { lq = l0 + 32 * w2 + r32; sq = (lq << shift) + jres; }
        bf16x8 qr[8];
        { const bf16* qp = Qb + (size_t)sq * ld + qcol + hi * 8;
#pragma unroll
          for (int d0 = 0; d0 < 8; ++d0) qr[d0] = *(const bf16x8*)(qp + d0 * 16); }
        float slopeL2 = 0.f; int rs = 0, cs = 0;
        __builtin_amdgcn_s_barrier();
        if (MODE != 2) slopeL2 = exp2f(-(float)(h + 1)) * (float)(1 << shift) * LOG2E;
        else { rs = qrow - 4; rs = rs < 0 ? 0 : (rs > 24 ? 24 : rs); cs = qcl - 8; cs = cs < 0 ? 0 : (cs > 48 ? 48 : cs);
#pragma unroll
            for (int k = 0; k < 4; ++k) { const int i = lane + 64 * w2 + 128 * k; if (i < 15 * 31) rpbt[RPB_PAD + i] = extra[h * 15 * 31 + i] * LOG2E; } }
        const int krow = 16 * w2 + (lane >> 4);
        const int kch = lane & 15;
        const int vst = 8 * w2 + (lane >> 5), vq = lane & 31;
#define ATT_KEYTOK(jj, t) ((MODE == 2) ? ((rbase + (t)) * 64 + c0 + (jj)) : ({ int lk_ = l0 - HW + 32 * (t) + (jj); lk_ = lk_ < 0 ? 0 : (lk_ > L - 1 ? L - 1 : lk_); (lk_ << shift) + jres; }))
#define ATT_STAGE(t) do { LAS unsigned char* const bb_ = pbase + ((t) & 1) * 16384; \
        if (MODE == 1) { const int row_ = 4 * wid + (lane >> 4); const int tok_ = ATT_KEYTOK(row_, t);                                 \
            __builtin_amdgcn_global_load_lds((const unsigned*)(Qb + (size_t)tok_ * ld + kcol + ((kch ^ (row_ & 7)) << 3)), (LAS unsigned*)(bb_ + wid * 1024), 16, 0, 0); \
            const int st_ = 2 * wid + (lane >> 5); const int kk_ = (st_ >> 2) * 8 + (vq >> 2); const int tokv_ = ATT_KEYTOK(swap23(kk_), t); \
            __builtin_amdgcn_global_load_lds((const unsigned*)(Qb + (size_t)tokv_ * ld + vcol + (st_ & 3) * 32 + (vq & 3) * 8), (LAS unsigned*)(bb_ + 8192 + wid * 1024), 16, 0, 0); } \
        else { \
        _Pragma("unroll") for (int i_ = 0; i_ < 4; ++i_) { const int row_ = krow + 4 * i_; const int tok_ = ATT_KEYTOK(row_, t); \
            __builtin_amdgcn_global_load_lds((const unsigned*)(Qb + (size_t)tok_ * ld + kcol + ((kch ^ (row_ & 7)) << 3)), (LAS unsigned*)(bb_ + (w2 * 4 + i_) * 1024), 16, 0, 0); } \
        _Pragma("unroll") for (int i_ = 0; i_ < 4; ++i_) { const int st_ = vst + 2 * i_; const int kk_ = (st_ >> 2) * 8 + (vq >> 2); const int tok_ = ATT_KEYTOK(swap23(kk_), t); \
            __builtin_amdgcn_global_load_lds((const unsigned*)(Qb + (size_t)tok_ * ld + vcol + (st_ & 3) * 32 + (vq & 3) * 8), (LAS unsigned*)(bb_ + 8192 + (w2 * 4 + i_) * 1024), 16, 0, 0); } } } while (0)
        float m_reg = -1e30f, l_reg = 0.f;
        f32x16 o[4];
#pragma unroll
        for (int d = 0; d < 4; ++d)
#pragma unroll
            for (int r = 0; r < 16; ++r) o[d][r] = 0.f;
        asm volatile("s_waitcnt lgkmcnt(0)" ::: "memory"); __builtin_amdgcn_s_barrier();
        ATT_STAGE(0);
        for (int t = 0; t < NT; ++t) {
            asm volatile("s_waitcnt vmcnt(0)" ::: "memory"); __builtin_amdgcn_s_barrier(); asm volatile("" ::: "memory");
            if (t + 1 < NT) ATT_STAGE(t + 1);
            bool need = true;
            if (MODE == 0) need = (w2 == 0) ? (t < 5) : (t > 0);
            else if (MODE == 1) need = (w2 == 0) ? (t < 9) : (t > 0);
            else { const int kr = rbase + t, ra = qr0 + 2 * w2; int rsA = ra - 4; rsA = rsA < 0 ? 0 : (rsA > 24 ? 24 : rsA); int rsB = ra - 3; rsB = rsB < 0 ? 0 : (rsB > 24 ? 24 : rsB); need = (kr >= rsA) && (kr < rsB + 8); }
            if (!need) continue;
            LAS unsigned char* const Kb = pbase + (t & 1) * 16384;
            f32x16 p0;
#pragma unroll
            for (int r = 0; r < 16; ++r) p0[r] = 0.f;
#pragma unroll
            for (int d0 = 0; d0 < 8; ++d0) { const int cb = (d0 * 16 + hi * 8) * 2;
                const bf16x8 kf = *(const LAS bf16x8*)(Kb + ATT_KSWZ(r32, cb));
                p0 = __builtin_amdgcn_mfma_f32_32x32x16_bf16(kf, qr[d0], p0, 0, 0, 0); }
            if (MODE != 2) {
                const int kb_i = l0 - HW + 32 * t + 4 * hi;
                const float fb = (float)(kb_i - lq);
#pragma unroll
                for (int r = 0; r < 16; ++r) { const float fd = fb + (float)crowc(r); const bool ok = (fabsf(fd) <= (float)HW) && ((unsigned)(kb_i + crowc(r)) < (unsigned)L);
                    p0[r] = ok ? fmaf(p0[r], CSC, -slopeL2 * fabsf(fd)) : -INFINITY; }
            } else {
                int rs_ = qrow - 4; rs_ = rs_ < 0 ? 0 : (rs_ > 24 ? 24 : rs_); int cs_ = qcl - 8; cs_ = cs_ < 0 ? 0 : (cs_ > 48 ? 48 : cs_);
                const int kr = rbase + t; const bool inr = (unsigned)(kr - rs_) < 8u;
                const int kcb = c0 + 4 * hi;
                const LAS float* bp = rpbt + RPB_PAD + (kr - qrow + 7) * 31 + (kcb - qcl + 15);
                float bv[16];
#pragma unroll
                for (int r = 0; r < 16; ++r) bv[r] = bp[crowc(r)];
#pragma unroll
                for (int r = 0; r < 16; ++r) { const bool ok = inr && ((unsigned)(kcb + crowc(r) - cs_) < 16u);
                    p0[r] = ok ? fmaf(p0[r], CSC, bv[r]) : -INFINITY; }
            }
            float pmax = p0[0];
#pragma unroll
            for (int r = 1; r < 16; ++r) pmax = fmaxf(pmax, p0[r]);
            { auto rr = __builtin_amdgcn_permlane32_swap(__float_as_uint(pmax), __float_as_uint(pmax), false, false); pmax = fmaxf(__uint_as_float(rr[0]), __uint_as_float(rr[1])); }
            float alpha = 1.f;
            if (!__all(pmax - m_reg <= THR_L2)) { const float mn = fmaxf(m_reg, pmax); alpha = __builtin_amdgcn_exp2f(m_reg - mn); m_reg = mn; }
            float ps = 0.f;
#pragma unroll
            for (int r = 0; r < 16; ++r) { p0[r] = __builtin_amdgcn_exp2f(p0[r] - m_reg); ps += p0[r]; }
            { auto rr = __builtin_amdgcn_permlane32_swap(__float_as_uint(ps), __float_as_uint(ps), false, false); ps = __uint_as_float(rr[0]) + __uint_as_float(rr[1]); }
            l_reg = l_reg * alpha + ps;
            bf16x8 pa0, pa1;
#define ATT_PK4(P, BASE, OUT) do { unsigned a0 = cvtpk(P[BASE + 0], P[BASE + 1]), a1 = cvtpk(P[BASE + 2], P[BASE + 3]); \
        unsigned b0 = cvtpk(P[BASE + 4], P[BASE + 5]), b1 = cvtpk(P[BASE + 6], P[BASE + 7]); \
        auto r0 = __builtin_amdgcn_permlane32_swap(a0, b0, false, false); auto r1 = __builtin_amdgcn_permlane32_swap(a1, b1, false, false); \
        u32x4 w = {r0[0], r1[0], r0[1], r1[1]}; OUT = *reinterpret_cast<bf16x8*>(&w); } while (0)
            ATT_PK4(p0, 0, pa0); ATT_PK4(p0, 8, pa1);
#undef ATT_PK4
            if (__any(alpha < 1.f)) { if (hi == 0) scr[r32] = alpha; asm volatile("s_waitcnt lgkmcnt(0)" ::: "memory");
#pragma unroll
                for (int r = 0; r < 16; ++r) { const float a = scr[crowc(r) + 4 * hi];
#pragma unroll
                    for (int d = 0; d < 4; ++d) o[d][r] *= a; } }
            const int vb = vb0 + (t & 1) * 16384;
            pv_one<0>(o[0], vb, pa0, pa1); pv_one<1>(o[1], vb, pa0, pa1); pv_one<2>(o[2], vb, pa0, pa1); pv_one<3>(o[3], vb, pa0, pa1);
        }
        float fin;
        if (MODE == 1) { const float sk = extra[h] * LOG2E; const float mf = fmaxf(m_reg, sk); const float a = __builtin_amdgcn_exp2f(m_reg - mf); const float lf = l_reg * a + __builtin_amdgcn_exp2f(sk - mf); fin = a / lf; }
        else fin = 1.0f / l_reg;
        asm volatile("s_waitcnt lgkmcnt(0)" ::: "memory");
        if (hi == 0) scr[r32] = fin;
        asm volatile("s_waitcnt lgkmcnt(0)" ::: "memory");
        if (MODE == 0 && hi == 0) lsebuf[((size_t)pat * M + (size_t)b * SEQ + sq) * 8 + h] = m_reg + __log2f(l_reg);
#pragma unroll
        for (int r = 0; r < 16; ++r) { const int qi = crowc(r) + 4 * hi; const float f = scr[qi];
            int sqi; if (MODE == 2) sqi = (qr0 + 2 * w2 + (qi >> 4)) * 64 + qc0 + (qi & 15); else sqi = ((l0 + 32 * w2 + qi) << shift) + jres;
            const size_t tokq = (size_t)b * SEQ + sqi;
            if (MODE == 0) { _Float16* op = (_Float16*)part + ((size_t)pat * M + tokq) * 1024 + h * HD + r32;
#pragma unroll
                for (int d = 0; d < 4; ++d) op[32 * d] = (_Float16)(o[d][r] * f); }
            else { bf16* op = O + tokq * D + ((MODE == 1) ? 1024 : 0) + h * HD + r32;
#pragma unroll
                for (int d = 0; d < 4; ++d) op[32 * d] = (bf16)f2bf(o[d][r] * f); } }
#undef ATT_STAGE
#undef ATT_KEYTOK
    }
    asm volatile("s_waitcnt vmcnt(0) lgkmcnt(0)" ::: "memory"); __builtin_amdgcn_s_barrier();
}
__device__ __forceinline__ void attn_combine(const Frame& F, const float* part, const float* lsebuf, bf16* O, const int stream) {
    int lane = F.lane; asm volatile("" : "+v"(lane));
    const int gw = F.bid * NWAVES + F.wave, NGW = F.G * NWAVES;
    for (int it = gw; it < MH * 8; it += NGW) {
        const int tok = stream * MH + (it >> 3), h = it & 7;
        const float e0 = lsebuf[((size_t)0 * M + tok) * 8 + h], e1 = lsebuf[((size_t)1 * M + tok) * 8 + h], e2 = lsebuf[((size_t)2 * M + tok) * 8 + h];
        const float mx = fmaxf(e0, fmaxf(e1, e2)); float w0 = __builtin_amdgcn_exp2f(e0 - mx), w1 = __builtin_amdgcn_exp2f(e1 - mx), w2 = __builtin_amdgcn_exp2f(e2 - mx);
        const float inv = 1.0f / (w0 + w1 + w2); w0 *= inv; w1 *= inv; w2 *= inv;
        typedef _Float16 f16x2 __attribute__((ext_vector_type(2)));
        const _Float16* ph = (const _Float16*)part; const size_t off = (size_t)tok * 1024 + h * HD + 2 * lane;
        const f16x2 a = *(const f16x2*)(ph + off), bq = *(const f16x2*)(ph + (size_t)M * 1024 + off), c = *(const f16x2*)(ph + (size_t)2 * M * 1024 + off);
        ((unsigned*)(O + (size_t)tok * D + h * HD))[lane] = pk2(w0 * (float)a.x + w1 * (float)bq.x + w2 * (float)c.x, w0 * (float)a.y + w1 * (float)bq.y + w2 * (float)c.y);
    }
}
}

__global__ void __launch_bounds__(NWAVES * 64, 2) fwd(Args a) {
    extern __shared__ __attribute__((aligned(16))) unsigned char lds[];
    Frame F;
    F.lds = (LAS unsigned char*)lds;
    F.wave = __builtin_amdgcn_readfirstlane((int)threadIdx.x >> 6); F.lane = 0; F.tid = 0;
    F.G = gridDim.x; F.bid = blockIdx.x;
    for (int u = (int)threadIdx.x; u < (LDS_BYTES - LDSCTL_OFF) / 4; u += NWAVES * 64) ((LAS unsigned*)(F.lds + LDSCTL_OFF))[u] = 0u;
    __syncthreads();
    XcdBarrier bar = xcd_barrier_post((unsigned*)(a.ws + WS_CTL) + CW_BAR, (volatile LAS unsigned*)(F.lds + MISC_OFF) + 8, F.wave);
#define PH_ENTER() Frame Fp = F; unsigned char* ws = a.ws; float* xo = a.out; asm volatile("" : "+s"(Fp.bid), "+s"(Fp.wave), "+s"(Fp.G), "+s"(ws), "+s"(xo)); \
    asm volatile("v_mbcnt_lo_u32_b32 %0, -1, 0\n\tv_mbcnt_hi_u32_b32 %0, -1, %0" : "=v"(Fp.lane)); Fp.tid = Fp.wave * 64 + Fp.lane;     \
    bf16* const Hb = (bf16*)(ws + WS_H); bf16* const Ub = (bf16*)(ws + WS_U); bf16* const QKVb = (bf16*)(ws + WS_QKV); bf16* const Ob = (bf16*)(ws + WS_O); float* const Pb = (float*)(ws + WS_PART); float* const Lb = (float*)(ws + WS_LSE); \
    int vc = Fp.bid - off; if (vc < 0) vc += Fp.G; const size_t rowoff = (size_t)s * MH; \
    (void)Hb; (void)Ub; (void)QKVb; (void)Ob; (void)Pb; (void)Lb; (void)xo; (void)vc; (void)rowoff
#define ITEM_BEGIN() for (int s = 0; s < NSTREAM; ++s) { if (T >= NSTREAM) sb_wait(bar, (unsigned*)(a.ws + WS_SB), T - NSTREAM);
#define ITEM_END(nunits) sb_arrive(bar, (unsigned*)(a.ws + WS_SB), T); ++T; off = (off + (nunits)) % F.G; }
    int T = 0, off = 0;
    { const int s = 0; PH_ENTER(); p0_prologue(Fp, a); }
    xcd_barrier(bar);
    for (int layer = 0; layer < DEPTH; ++layer) {
        const bool even = (layer & 1) == 0; const int li = layer >> 1;
        for (int sub = 0; sub < 3; ++sub) {
            const int lf = layer * 2 + (sub == 2 ? 1 : 0);
            const int sb = layer * 3 + sub;
            const int N1 = (sub == 1) ? (even ? AB_IN : C_IN) : 2 * FF;
            ITEM_BEGIN() { PH_ENTER();
                if (sub == 1) {
                    const bf16* W = even ? (const bf16*)(ws + WS_WABIN + (size_t)li * SZ_WABIN) : (const bf16*)(ws + WS_WCIN + (size_t)li * SZ_WCIN);
                    pg8::Gemm g{Hb + rowoff * D, W, MH, N1, D}; pg8::StaticOrder S; S.init(MH, N1, Fp.G, vc);
                    pg8::EpiBf16 E{QKVb + rowoff * N1, N1, (const pg8::ssq_t*)(ws + WS_SSQ) + (size_t)sb * M + rowoff};
                    pg8::gemm_phase<pg8::EpiBf16, pg8::StaticOrder, true, true, 0, RESID_F16 != 0>(Fp.lds + RING_OFF, g, S, E, Fp.tid);
                } else {
                    pg8::Gemm g{Hb + rowoff * D, (const bf16*)(ws + WS_WGU + (size_t)lf * SZ_WGU), MH, 2 * FF, D}; pg8::StaticOrder S; S.init(MH, 2 * FF, Fp.G, vc);
                    pg8::EpiSwiglu E{Ub + rowoff * FF, FF, (const pg8::ssq_t*)(ws + WS_SSQ) + (size_t)sb * M + rowoff};
                    pg8::gemm_phase<pg8::EpiSwiglu, pg8::StaticOrder, true, true, 0, RESID_F16 != 0>(Fp.lds + RING_OFF, g, S, E, Fp.tid);
                }
            } ITEM_END((MH / 256) * (N1 / 256))
            if (sub == 1) {
                if (even) {
                    ITEM_BEGIN() { PH_ENTER(); att::attn_mfma<0>(Fp, QKVb, AB_IN, Ob, Pb, Lb, nullptr, s, vc); } ITEM_END(3072 / NSTREAM / 4)
                    ITEM_BEGIN() { PH_ENTER(); att::attn_mfma<1>(Fp, QKVb, AB_IN, Ob, Pb, Lb, a.ab_sink + li * 8, s, vc); att::attn_combine(Fp, Pb, Lb, Ob, s); } ITEM_END(1024 / NSTREAM / 4)
                } else {
                    ITEM_BEGIN() { PH_ENTER(); att::attn_mfma<2>(Fp, QKVb, C_IN, Ob, Pb, Lb, a.c_rpb + (size_t)li * 16 * 15 * 31, s, vc); } ITEM_END(2048 / NSTREAM / 4)
                }
            }
            ITEM_BEGIN() { PH_ENTER();
                const bf16* A2 = (sub == 1) ? (const bf16*)(Ob + rowoff * D) : (const bf16*)(Ub + rowoff * FF); const int K2 = (sub == 1) ? D : FF;
                const bf16* W2 = (sub == 1) ? (even ? (const bf16*)(ws + WS_WABOUT + (size_t)li * SZ_WOUT) : (const bf16*)(ws + WS_WCOUT + (size_t)li * SZ_WOUT))
                                            : (const bf16*)(ws + WS_WD + (size_t)lf * SZ_WD);
                pg8::Gemm g{A2, W2, MH, D, K2}; pg8::StaticOrder S; S.init(MH, D, Fp.G, vc);
                pg8::EpiResidH E{Hb + rowoff * D, D, (sub == 1) ? 1.0f : 0.5f, Hb + rowoff * D, (pg8::ssq_t*)(ws + WS_SSQ) + (size_t)(sb + 1) * M + rowoff};
                pg8::gemm_phase<pg8::EpiResidH, pg8::StaticOrder, true, true>(Fp.lds + RING_OFF, g, S, E, Fp.tid);
            } ITEM_END((MH / 256) * (D / 256))
        }
    }
    ITEM_BEGIN() { PH_ENTER(); final_norm_h_phase(Fp, Hb, xo, a.final_norm, (const pg8::ssq_t*)(ws + WS_SSQ) + (size_t)12 * M, s); } ITEM_END(0)
#undef PH_ENTER
#undef ITEM_BEGIN
#undef ITEM_END
}

extern "C" void kernel_launch(void* const* d_in, const int* in_sizes, int n_in, void* d_out, int out_size, void* d_ws, size_t ws_size, hipStream_t stream) {
    static int grid = 0;
    if (grid == 0) {
        if (n_in != 13 || in_sizes[0] != M * D || out_size != M * D || ws_size < WS_END) { fprintf(stderr, "kernel_launch: unexpected shapes (n_in %d, in0 %d, out %d, ws %zu, need %zu); nothing launched\n", n_in, n_in > 0 ? in_sizes[0] : -1, out_size, ws_size, (size_t)WS_END); grid = -1; return; }
        int dev = 0, cus = 0, per_cu = 0;
        if (hipGetDevice(&dev) != hipSuccess || hipDeviceGetAttribute(&cus, hipDeviceAttributeMultiprocessorCount, dev) != hipSuccess) { fprintf(stderr, "kernel_launch: device query failed\n"); grid = -1; return; }
        if (hipFuncSetAttribute((const void*)fwd, hipFuncAttributeMaxDynamicSharedMemorySize, LDS_BYTES) != hipSuccess) { fprintf(stderr, "kernel_launch: hipFuncSetAttribute failed\n"); grid = -1; return; }
        if (hipOccupancyMaxActiveBlocksPerMultiprocessor(&per_cu, (const void*)fwd, NWAVES * 64, LDS_BYTES) != hipSuccess || per_cu < 1)
            fprintf(stderr, "kernel_launch: note: occupancy query reports %d workgroups per CU\n", per_cu);
        (void)hipGetLastError();
        grid = cus;
    }
    if (grid < 0) return;
    if (hipMemsetAsync((char*)d_ws + WS_CTL, 0, CTL_ZERO_BYTES, stream) != hipSuccess) { fprintf(stderr, "kernel_launch: memset failed\n"); return; }
    Args a{};
    a.x = (const float*)d_in[0]; a.ffn_norm = (const float*)d_in[1]; a.wg = (const float*)d_in[2]; a.wu = (const float*)d_in[3]; a.wd = (const float*)d_in[4]; a.mix_norm = (const float*)d_in[5];
    a.ab_in = (const float*)d_in[6]; a.ab_out = (const float*)d_in[7]; a.ab_sink = (const float*)d_in[8]; a.c_in = (const float*)d_in[9]; a.c_out = (const float*)d_in[10]; a.c_rpb = (const float*)d_in[11];
    a.final_norm = (const float*)d_in[12]; a.out = (float*)d_out; a.ws = (unsigned char*)d_ws;
    a.ph_lo = 0; a.ph_hi = 0; hipLaunchKernelGGL(fwd, dim3(grid), dim3(NWAVES * 64), LDS_BYTES, stream, a);
    const hipError_t le = hipPeekAtLastError();
    if (le != hipSuccess) fprintf(stderr, "kernel_launch: launch failed: %s\n", hipGetErrorName(le));
}
```

```cpp
#include <hip/hip_runtime.h>
#include <cstdio>
#include <cstdint>

#ifndef PROBE_ABL
#define PROBE_ABL 0
#endif
#ifndef RESID_F16
#define RESID_F16 1
#endif

namespace pg8 {
#define PG8_LAS __attribute__((address_space(3)))
typedef unsigned short bf16_t;
typedef short bf16x8 __attribute__((ext_vector_type(8)));
typedef _Float16 f16x8 __attribute__((ext_vector_type(8)));
typedef _Float16 f16x4 __attribute__((ext_vector_type(4)));
typedef float f32x4 __attribute__((ext_vector_type(4)));
typedef unsigned u32x4 __attribute__((ext_vector_type(4)));
constexpr int BM = 256, BK = 64, HALF = 128, HTB = HALF * BK * 2  , STAGE_BYTES = 8 * HTB, NXCD = 8, WGM = 8;

__host__ __device__ __forceinline__ int lds_byte(int r, int c) { const int st = (r >> 4) * 2 + (c >> 5), rr = r & 15, cc = c & 31, ob = rr * 64 + cc * 2; return st * 1024 + (ob ^ (((ob >> 9) & 1) << 5)); }
__host__ __device__ __forceinline__ void stage_rc(int b, int& R, int& C) { const int st = b / 1024, sb = b % 1024, swz = sb ^ (((sb >> 9) & 1) << 5); R = (st >> 1) * 16 + swz / 64; C = (st & 1) * 32 + (swz % 64) / 2; }
__host__ __device__ __forceinline__ int perm32(int rho) { const int n = rho >> 4, i = rho & 15; return 8 * (i >> 2) + 4 * n + (i & 3); }

struct Unit { int pm, pn; };
struct Gemm { const bf16_t* A; const bf16_t* Bt; int M, N, K; };

struct StaticOrder {
    int nM, nN, nwg, G, c;
    __host__ __device__ void init(int M, int N, int G_, int c_) { nM = M / BM; nN = N / BM; nwg = nM * nN; G = G_; c = c_; }
    __host__ __device__ bool next(int i, Unit& u) const {
        const long L = (long)i * G + c; if (L >= nwg) return false;
        int wgid = (int)L; { const int q = nwg / NXCD, r = nwg % NXCD, xcd = wgid % NXCD, off = wgid / NXCD; wgid = (xcd < r ? xcd * (q + 1) : r * (q + 1) + (xcd - r) * q) + off; }
        const int nig = WGM * nN, gid = wgid / nig, fm = gid * WGM, gsz = (nM - fm) < WGM ? (nM - fm) : WGM;
        u.pm = fm + ((wgid % nig) % gsz); u.pn = (wgid % nig) / gsz; return true;
    }
    __device__ __forceinline__ void a_ready(const Unit&) const {}
    __device__ __forceinline__ void done(const Unit&) const {}
};


__device__ __forceinline__ unsigned cvt_pk_bf16(float lo, float hi) { unsigned r; asm volatile("v_cvt_pk_bf16_f32 %0, %1, %2" : "=v"(r) : "v"(lo), "v"(hi)); return r; }

__device__ __forceinline__ int lane_id_here() { int l; asm volatile("v_mbcnt_lo_u32_b32 %0, -1, 0\n\tv_mbcnt_hi_u32_b32 %0, -1, %0" : "=v"(l)); return l; }
__device__ __forceinline__ float xor_shfl(float v, int mask, int lane) { return __builtin_bit_cast(float, __builtin_amdgcn_ds_bpermute((lane ^ mask) << 2, __builtin_bit_cast(int, v))); }
typedef unsigned long long ssq_t;
__device__ __forceinline__ ssq_t ssq_fix(float s) { const int hi = (int)s; const int lo = (int)((s - (float)hi) * 16777216.0f); return ((ssq_t)(unsigned)hi << 24) + (ssq_t)(unsigned)lo; }
__device__ __forceinline__ float ssq_val(ssq_t v) { return (float)(unsigned)(v >> 24) + (float)(unsigned)(v & 0xFFFFFFull) * (1.0f / 16777216.0f); }
__device__ __forceinline__ float row_rstd(const ssq_t* ssq, int row) { return 1.0f / sqrtf(ssq_val(ssq[row]) * (1.0f / 2048.0f) + 1e-6f); }
struct PreSsq { ssq_t v[2][4]; };
__device__ __forceinline__ void pre_ssq_issue(PreSsq& p, const ssq_t* ssq, int row0) {
    typedef __attribute__((address_space(1))) const ssq_t gssq_t;
    gssq_t* a = (gssq_t*)ssq + row0;
    asm volatile("global_load_dwordx2 %0, %1, off" : "=v"(p.v[0][0]) : "v"(a));
    asm volatile("global_load_dwordx2 %0, %1, off offset:128" : "=v"(p.v[0][1]) : "v"(a));
    asm volatile("global_load_dwordx2 %0, %1, off offset:256" : "=v"(p.v[0][2]) : "v"(a));
    asm volatile("global_load_dwordx2 %0, %1, off offset:384" : "=v"(p.v[0][3]) : "v"(a));
    asm volatile("global_load_dwordx2 %0, %1, off offset:1024" : "=v"(p.v[1][0]) : "v"(a));
    asm volatile("global_load_dwordx2 %0, %1, off offset:1152" : "=v"(p.v[1][1]) : "v"(a));
    asm volatile("global_load_dwordx2 %0, %1, off offset:1280" : "=v"(p.v[1][2]) : "v"(a));
    asm volatile("global_load_dwordx2 %0, %1, off offset:1408" : "=v"(p.v[1][3]) : "v"(a));
}
__device__ __forceinline__ void pre_ssq_wait(PreSsq& p) {
    asm volatile("s_waitcnt vmcnt(16)" : "+v"(p.v[0][0]), "+v"(p.v[0][1]), "+v"(p.v[0][2]), "+v"(p.v[0][3]), "+v"(p.v[1][0]), "+v"(p.v[1][1]), "+v"(p.v[1][2]), "+v"(p.v[1][3]) :: "memory");
}
__device__ __forceinline__ void rows_rstd(const PreSsq& p, float (&rs)[2][4]) {
#pragma unroll
    for (int ai = 0; ai < 2; ++ai)
#pragma unroll
        for (int m = 0; m < 4; ++m) rs[ai][m] = __builtin_amdgcn_rsqf(ssq_val(p.v[ai][m]) * (1.0f / 2048.0f) + 1e-6f);
}
typedef __attribute__((address_space(1))) u32x4 gu32x4;
struct EpiBf16 {
    static constexpr bool PERM = true, AFTER_DRAIN = false, HAS_INIT = false, HAS_PRE = true;
    typedef PreSsq Pre;
    bf16_t* O; int ldc; const ssq_t* ssq;
    __device__ __forceinline__ void pre_issue(Pre& p, const Unit& u, int wr, int wc, int fr, int fq) const { pre_ssq_issue(p, ssq, u.pm * BM + wr * 64 + fr); }
    __device__ __forceinline__ void pre_wait(Pre& p) const { pre_ssq_wait(p); }
    __device__ __forceinline__ void operator()(const f32x4 (&acc)[2][2][4][2], const Unit& u, int wr, int wc, int fr, int fq, const Pre& pre) const {
        const int row0 = u.pm * BM + wr * 64 + fr; const int col0 = u.pn * BM + wc * 32 + 8 * fq;
        float rsv[2][4]; rows_rstd(pre, rsv);
#pragma unroll
        for (int ai = 0; ai < 2; ++ai)
#pragma unroll
            for (int m = 0; m < 4; ++m) { const int row = row0 + ai * HALF + m * 16; const float rs = rsv[ai][m]; bf16_t* rowp = O + (size_t)row * ldc + col0;
#pragma unroll
                for (int bj = 0; bj < 2; ++bj) { const f32x4 v0 = acc[ai][bj][m][0] * rs, v1 = acc[ai][bj][m][1] * rs;
                    u32x4 w; w.x = cvt_pk_bf16(v0[0], v0[1]); w.y = cvt_pk_bf16(v0[2], v0[3]); w.z = cvt_pk_bf16(v1[0], v1[1]); w.w = cvt_pk_bf16(v1[2], v1[3]);
                    *(gu32x4*)(rowp + bj * HALF) = w; } }
    }
};
struct EpiSwiglu {
    static constexpr bool PERM = true, AFTER_DRAIN = false, HAS_INIT = false, HAS_PRE = true;
    typedef PreSsq Pre;
    bf16_t* O; int ldc; const ssq_t* ssq;
    __device__ __forceinline__ void pre_issue(Pre& p, const Unit& u, int wr, int wc, int fr, int fq) const { pre_ssq_issue(p, ssq, u.pm * BM + wr * 64 + fr); }
    __device__ __forceinline__ void pre_wait(Pre& p) const { pre_ssq_wait(p); }
    __device__ __forceinline__ void operator()(const f32x4 (&acc)[2][2][4][2], const Unit& u, int wr, int wc, int fr, int fq, const Pre& pre) const {
        const int row0 = u.pm * BM + wr * 64 + fr; const int col0 = u.pn * HALF + wc * 32 + 8 * fq;
        float rsv[2][4]; rows_rstd(pre, rsv);
#pragma unroll
        for (int ai = 0; ai < 2; ++ai)
#pragma unroll
            for (int m = 0; m < 4; ++m) { const int row = row0 + ai * HALF + m * 16; const float rs = rsv[ai][m]; bf16_t* rowp = O + (size_t)row * ldc + col0;
                float r[8];
                typedef float f32x2 __attribute__((ext_vector_type(2)));
                const f32x2 rsq2 = {rs * rs, rs * rs}, nrs2 = {rs * -1.4426950408889634f, rs * -1.4426950408889634f};
#pragma unroll
                for (int n = 0; n < 2; ++n)
#pragma unroll
                    for (int jp = 0; jp < 2; ++jp) { const f32x4 vg = acc[ai][0][m][n], vu = acc[ai][1][m][n];
                        const f32x2 ag = jp ? __builtin_shufflevector(vg, vg, 2, 3) : __builtin_shufflevector(vg, vg, 0, 1), au = jp ? __builtin_shufflevector(vu, vu, 2, 3) : __builtin_shufflevector(vu, vu, 0, 1);
                        const f32x2 x = ag * nrs2;
                        f32x2 d = {__builtin_amdgcn_exp2f(x.x), __builtin_amdgcn_exp2f(x.y)}; d = d + 1.0f;
                        const f32x2 rc = {__builtin_amdgcn_rcpf(d.x), __builtin_amdgcn_rcpf(d.y)};
                        const f32x2 o = (ag * au) * (rc * rsq2);
                        r[n * 4 + 2 * jp] = o.x; r[n * 4 + 2 * jp + 1] = o.y; }
                u32x4 w; w.x = cvt_pk_bf16(r[0], r[1]); w.y = cvt_pk_bf16(r[2], r[3]); w.z = cvt_pk_bf16(r[4], r[5]); w.w = cvt_pk_bf16(r[6], r[7]);
                *(gu32x4*)rowp = w; }
    }
};
struct EpiResidH {
    static constexpr bool PERM = true, AFTER_DRAIN = false, HAS_INIT = false, HAS_PRE = true;
    struct Pre { f16x8 t[2][2]; };
    const bf16_t* xin; int ldc; float scale; bf16_t* xb; ssq_t* ssq_out;
    __device__ __forceinline__ unsigned lane_off(const Unit& u, int wr, int wc, int fr, int fq) const { return (unsigned)(((u.pm * BM + wr * 64 + fr) * ldc + u.pn * BM + wc * 32 + 8 * fq) * 2); }
    __device__ __forceinline__ void issue_batch(f16x8 (&t)[2][2], unsigned voff, int ai, int mp) const {
        const char* xr = (const char*)xin; asm volatile("" : "+s"(xr));
#pragma unroll
        for (int mm = 0; mm < 2; ++mm) { const char* sb = xr + (size_t)((ai * HALF + (2 * mp + mm) * 16) * ldc) * 2;
            asm volatile("global_load_dwordx4 %0, %1, %2" : "=v"(t[mm][0]) : "v"(voff), "s"(sb));
            asm volatile("global_load_dwordx4 %0, %1, %2 offset:256" : "=v"(t[mm][1]) : "v"(voff), "s"(sb)); }
    }
    __device__ __forceinline__ void pre_issue(Pre& p, const Unit& u, int wr, int wc, int fr, int fq) const { issue_batch(p.t, lane_off(u, wr, wc, fr, fq), 0, 0); }
    __device__ __forceinline__ void pre_wait(Pre& p) const { asm volatile("s_waitcnt vmcnt(16)" : "+v"(p.t[0][0]), "+v"(p.t[0][1]), "+v"(p.t[1][0]), "+v"(p.t[1][1]) :: "memory"); }
    __device__ __forceinline__ void batch(f32x4 (&acc)[2][2][4][2], const f16x8 (&t)[2][2], int ai, int mp, int row0, int col0, int fq, ssq_t (&olds)[8], float sc, bf16_t* xb, ssq_t* ssq_out) const {
        typedef __attribute__((address_space(1))) f16x8 gf16x8;
#pragma unroll
        for (int mm = 0; mm < 2; ++mm) { const int m = 2 * mp + mm, row = row0 + ai * HALF + m * 16; const size_t off = (size_t)row * ldc + col0; float s = 0.f;
#pragma unroll
            for (int bj = 0; bj < 2; ++bj) { const f16x8 b8 = t[mm][bj];
                const f32x4 y0 = __builtin_convertvector(__builtin_shufflevector(b8, b8, 0, 1, 2, 3), f32x4) + acc[ai][bj][m][0] * sc, y1 = __builtin_convertvector(__builtin_shufflevector(b8, b8, 4, 5, 6, 7), f32x4) + acc[ai][bj][m][1] * sc;
                const f16x4 h0 = __builtin_convertvector(y0, f16x4), h1 = __builtin_convertvector(y1, f16x4);
                *(gf16x8*)(xb + off + bj * HALF) = __builtin_shufflevector(h0, h1, 0, 1, 2, 3, 4, 5, 6, 7);
                const f32x4 z0 = __builtin_convertvector(h0, f32x4), z1 = __builtin_convertvector(h1, f32x4);
                s += ((z0[0] * z0[0] + z0[1] * z0[1]) + (z0[2] * z0[2] + z0[3] * z0[3])) + ((z1[0] * z1[0] + z1[1] * z1[1]) + (z1[2] * z1[2] + z1[3] * z1[3])); }
            { const int ln_ = lane_id_here(); s += xor_shfl(s, 16, ln_); s += xor_shfl(s, 32, ln_); }
            olds[ai * 4 + m] = 0;
            if (fq == 0) olds[ai * 4 + m] = __hip_atomic_fetch_add((__attribute__((address_space(1))) ssq_t*)(ssq_out + row), ssq_fix(s), __ATOMIC_RELAXED, __HIP_MEMORY_SCOPE_AGENT); }
    }
#define EPI_WAITB(n, t) asm volatile("s_waitcnt vmcnt(" #n ")" : "+v"(t[0][0]), "+v"(t[0][1]), "+v"(t[1][0]), "+v"(t[1][1]) :: "memory")
    __device__ __forceinline__ void operator()(f32x4 (&acc)[2][2][4][2], const Unit& u, int wr, int wc, int fr, int fq, const Pre& pre) const {
        const int row0 = u.pm * BM + wr * 64 + fr, col0 = u.pn * BM + wc * 32 + 8 * fq;
        const unsigned voff = lane_off(u, wr, wc, fr, fq);
        f16x8 t1[2][2], t2[2][2], t3[2][2];
        issue_batch(t1, voff, 0, 1); issue_batch(t2, voff, 1, 0); issue_batch(t3, voff, 1, 1);
        ssq_t olds[8];
        float sc = scale; bf16_t* xo = xb; ssq_t* so = ssq_out; asm volatile("" : "+s"(sc), "+s"(xo), "+s"(so));
        batch(acc, pre.t, 0, 0, row0, col0, fq, olds, sc, xo, so);
        EPI_WAITB(12, t1);
        batch(acc, t1, 0, 1, row0, col0, fq, olds, sc, xo, so);
        EPI_WAITB(12, t2);
        batch(acc, t2, 1, 0, row0, col0, fq, olds, sc, xo, so);
        EPI_WAITB(12, t3);
        batch(acc, t3, 1, 1, row0, col0, fq, olds, sc, xo, so);
#pragma unroll
        for (int i = 0; i < 8; ++i) asm volatile("" :: "v"(olds[i]));
    }
#undef EPI_WAITB
};

template <class Epi, class Sched, bool ALIGN_EPI = false, bool SP2 = false, int ABL = 0  , bool F16 = false  >
__device__ __forceinline__ void gemm_phase(PG8_LAS unsigned char* lds, const Gemm g, const Sched& S, const Epi& E, int tid_in) {
    int tid_ = tid_in; asm volatile("" : "+v"(tid_));
    const int tid = tid_, wid = __builtin_amdgcn_readfirstlane(tid >> 6), lane = tid & 63, wr = wid >> 2, wc = wid & 3, fr = lane & 15, fq = lane >> 4;
    const int K = g.K, nt = K / BK;
    unsigned voffA[2], voffB[2];
#pragma unroll
    for (int i = 0; i < 2; ++i) { const int R = 8 * (wid + 8 * i) + (lane >> 3), C = (((lane & 7) ^ ((R >> 1) & 7)) << 3); const int Rb = Epi::PERM ? ((R & ~31) + perm32(R & 31)) : R;
        voffA[i] = (unsigned)(R * K + C) * 2u; voffB[i] = (unsigned)(Rb * K + C) * 2u; }
    const unsigned kstep = (unsigned)(BK * 2);
    const unsigned hstep = (unsigned)HALF * (unsigned)K * 2u;
    const unsigned tstep = 2u * hstep;
    const __amdgpu_buffer_rsrc_t rA = __builtin_amdgcn_make_buffer_rsrc((void*)g.A, 0, 0x7ffffff0, 0x00020000), rB = __builtin_amdgcn_make_buffer_rsrc((void*)g.Bt, 0, 0x7ffffff0, 0x00020000);
    const unsigned ldsw = (unsigned)wid * 1024u;
    const int arow = wr * 64 + fr, brow = wc * 32 + fr;
    const int aoff0 = arow * 128 + ((fq ^ ((arow >> 1) & 7)) << 4), aoff1 = aoff0 ^ 64, boff0 = brow * 128 + ((fq ^ ((brow >> 1) & 7)) << 4), boff1 = boff0 ^ 64;
#define PG8_SA(b, h) (((b) * 2 + (h)) * HTB)
#define PG8_SB(b, h) ((4 + (b) * 2 + (h)) * HTB)
#define PG8_STAGE(bufoff, rsrc, goff, voff) do { if (ABL != 2) _Pragma("unroll") for (int _i = 0; _i < 2; ++_i) \
        __builtin_amdgcn_raw_ptr_buffer_load_lds(rsrc, (PG8_LAS void*)(lds + (bufoff) + ldsw + _i * 8192), 16, (voff)[_i], (int)(goff), 0, 0); } while (0)
#define PG8_LDA(dst, b, h) do { if (ABL != 3) _Pragma("unroll") for (int m = 0; m < 4; ++m) { dst[m][0] = *(const PG8_LAS bf16x8*)(lds + PG8_SA(b, h) + aoff0 + m * 2048); dst[m][1] = *(const PG8_LAS bf16x8*)(lds + PG8_SA(b, h) + aoff1 + m * 2048); } } while (0)
#define PG8_LDB(dst, b, h) do { if (ABL != 3) _Pragma("unroll") for (int n = 0; n < 2; ++n) { dst[n][0] = *(const PG8_LAS bf16x8*)(lds + PG8_SB(b, h) + boff0 + n * 2048); dst[n][1] = *(const PG8_LAS bf16x8*)(lds + PG8_SB(b, h) + boff1 + n * 2048); } } while (0)
#define PG8_MMA(ai, bj, At, Bt) do { __builtin_amdgcn_s_setprio(1); _Pragma("unroll") for (int m = 0; m < 4; ++m) _Pragma("unroll") for (int n = 0; n < 2; ++n) _Pragma("unroll") for (int k = 0; k < 2; ++k) { \
        if (ABL == 5) { if (((m & 1) == 0)) acc32[((ai) * 2 + (bj)) * 2 + (m >> 1)] = __builtin_amdgcn_mfma_f32_32x32x16_bf16(Bt[n][k], At[m][k], acc32[((ai) * 2 + (bj)) * 2 + (m >> 1)], 0, 0, 0); else asm volatile("" :: "v"(Bt[n][k]), "v"(At[m][k])); } \
        else if (ABL != 1) { if (F16) acc[ai][bj][m][n] = __builtin_amdgcn_mfma_f32_16x16x32_f16(__builtin_bit_cast(f16x8, Bt[n][k]), __builtin_bit_cast(f16x8, At[m][k]), acc[ai][bj][m][n], 0, 0, 0); \
            else acc[ai][bj][m][n] = __builtin_amdgcn_mfma_f32_16x16x32_bf16(Bt[n][k], At[m][k], acc[ai][bj][m][n], 0, 0, 0); } else asm volatile("" :: "v"(Bt[n][k]), "v"(At[m][k])); } __builtin_amdgcn_s_setprio(0); } while (0)
#define PG8_WAIT_V(n) asm volatile("s_waitcnt vmcnt(" #n ")" ::: "memory")
#define PG8_WAIT_L(n) asm volatile("s_waitcnt lgkmcnt(" #n ")" ::: "memory")
#define PG8_BAR __builtin_amdgcn_s_barrier()
#define PG8_SCHED __builtin_amdgcn_sched_barrier(0)
    Unit cur, nxt; int ui = 0;
    if (!S.next(0, cur)) return;
    f32x4 acc[2][2][4][2];
    if constexpr (Epi::HAS_INIT) E.init(acc, cur, wr, wc, fr, fq);
    else {
    bf16x8 z8 = {0, 0, 0, 0, 0, 0, 0, 0};
#pragma unroll
    for (int a = 0; a < 2; ++a)
#pragma unroll
        for (int b = 0; b < 2; ++b)
#pragma unroll
            for (int m = 0; m < 4; ++m)
#pragma unroll
                for (int n = 0; n < 2; ++n) { asm volatile("" : "+v"(z8)); acc[a][b][m][n] = __builtin_amdgcn_mfma_f32_16x16x32_bf16(z8, z8, (f32x4){0.f, 0.f, 0.f, 0.f}, 0, 0, 0); }
    }
    bf16x8 At[4][2], B0[2][2], B1[2][2];
    typename Epi::Pre pre = {};
    typedef float f32x16_t __attribute__((ext_vector_type(16))); f32x16_t acc32[8];
    if (ABL == 5) { _Pragma("unroll") for (int i = 0; i < 8; ++i) _Pragma("unroll") for (int r = 0; r < 16; ++r) acc32[i][r] = 0.f; }
    if (ABL == 3) { _Pragma("unroll") for (int m = 0; m < 4; ++m) _Pragma("unroll") for (int k = 0; k < 2; ++k) At[m][k] = (bf16x8){1, 2, 3, 4, 5, 6, 7, 8}; _Pragma("unroll") for (int n = 0; n < 2; ++n) _Pragma("unroll") for (int k = 0; k < 2; ++k) { B0[n][k] = (bf16x8){8, 7, 6, 5, 4, 3, 2, 1}; B1[n][k] = (bf16x8){1, 1, 2, 2, 3, 3, 4, 4}; } }
    unsigned cA = (unsigned)cur.pm * tstep, cB = (unsigned)cur.pn * tstep;
    S.a_ready(cur);
    if constexpr (SP2) {
        PG8_STAGE(PG8_SB(0, 0), rB, cB, voffB); PG8_STAGE(PG8_SB(0, 1), rB, cB + hstep, voffB); PG8_STAGE(PG8_SA(0, 0), rA, cA, voffA); PG8_STAGE(PG8_SA(0, 1), rA, cA + hstep, voffA);
        if (wr == 1) PG8_BAR;
        PG8_WAIT_V(2); PG8_BAR;
        PG8_STAGE(PG8_SB(1, 0), rB, cB + kstep, voffB); PG8_STAGE(PG8_SA(1, 0), rA, cA + kstep, voffA); PG8_STAGE(PG8_SB(1, 1), rB, cB + hstep + kstep, voffB);
        PG8_WAIT_V(6); PG8_BAR;
    } else {
        PG8_STAGE(PG8_SB(0, 0), rB, cB, voffB); PG8_STAGE(PG8_SA(0, 0), rA, cA, voffA); PG8_STAGE(PG8_SB(0, 1), rB, cB + hstep, voffB); PG8_STAGE(PG8_SA(0, 1), rA, cA + hstep, voffA);
        if (wr == 1) PG8_BAR;
        PG8_WAIT_V(4); PG8_BAR;
        PG8_STAGE(PG8_SB(1, 0), rB, cB + kstep, voffB); PG8_STAGE(PG8_SA(1, 0), rA, cA + kstep, voffA); PG8_STAGE(PG8_SB(1, 1), rB, cB + hstep + kstep, voffB);
        PG8_WAIT_V(6); PG8_BAR;
    }
    for (;;) {
        const bool has_next = S.next(ui + 1, nxt);
        const unsigned nA = has_next ? (unsigned)nxt.pm * tstep : cA, nB = has_next ? (unsigned)nxt.pn * tstep : cB;
        for (int t = 0; t < nt; t += 2) {
            const bool last = (t == nt - 2);
            const unsigned a1 = cA + (unsigned)(t + 1) * kstep;
            const unsigned a2 = last ? nA : cA + (unsigned)(t + 2) * kstep, b2 = last ? nB : cB + (unsigned)(t + 2) * kstep;
            const unsigned a3 = a2 + kstep, b3 = b2 + kstep;
            if (last && has_next) S.a_ready(nxt);
            if constexpr (Epi::HAS_PRE) { if (last) E.pre_issue(pre, cur, wr, wc, fr, fq); }
            if constexpr (SP2) {
            PG8_LDB(B0, 0, 0); PG8_LDB(B1, 0, 1); PG8_SCHED; PG8_LDA(At, 0, 0); PG8_STAGE(PG8_SA(1, 1), rA, a1 + hstep, voffA);
            PG8_WAIT_V(8); PG8_WAIT_L(0); PG8_BAR; PG8_MMA(0, 0, At, B0); PG8_MMA(0, 1, At, B1); PG8_BAR; PG8_SCHED;
            PG8_LDA(At, 0, 1); PG8_STAGE(PG8_SB(0, 0), rB, b2, voffB); PG8_STAGE(PG8_SB(0, 1), rB, b2 + hstep, voffB); PG8_STAGE(PG8_SA(0, 0), rA, a2, voffA);
            PG8_WAIT_V(8); PG8_WAIT_L(0); PG8_BAR; PG8_MMA(1, 0, At, B0); PG8_MMA(1, 1, At, B1); PG8_BAR; PG8_SCHED;
            PG8_LDB(B0, 1, 0); PG8_LDB(B1, 1, 1); PG8_SCHED; PG8_LDA(At, 1, 0); PG8_STAGE(PG8_SA(0, 1), rA, a2 + hstep, voffA);
            PG8_WAIT_V(8); PG8_WAIT_L(0); PG8_BAR; PG8_MMA(0, 0, At, B0); PG8_MMA(0, 1, At, B1); PG8_BAR; PG8_SCHED;
            PG8_LDA(At, 1, 1); PG8_STAGE(PG8_SB(1, 0), rB, b3, voffB); PG8_STAGE(PG8_SB(1, 1), rB, b3 + hstep, voffB); PG8_STAGE(PG8_SA(1, 0), rA, a3, voffA);
            PG8_WAIT_V(8); PG8_WAIT_L(0); PG8_BAR; PG8_MMA(1, 0, At, B0); PG8_MMA(1, 1, At, B1); PG8_BAR; PG8_SCHED;
            } else {
            PG8_LDB(B0, 0, 0); PG8_SCHED; PG8_LDA(At, 0, 0); PG8_STAGE(PG8_SA(1, 1), rA, a1 + hstep, voffA);
            PG8_WAIT_L(8); PG8_BAR; PG8_WAIT_L(0); PG8_MMA(0, 0, At, B0); PG8_BAR; PG8_SCHED;
            PG8_LDB(B1, 0, 1); PG8_STAGE(PG8_SB(0, 0), rB, b2, voffB);
            PG8_BAR; PG8_WAIT_L(0); PG8_MMA(0, 1, At, B1); PG8_BAR;
            PG8_LDA(At, 0, 1); PG8_STAGE(PG8_SA(0, 0), rA, a2, voffA);
            PG8_BAR; PG8_WAIT_L(0); PG8_MMA(1, 0, At, B0); PG8_BAR; PG8_SCHED;
            PG8_STAGE(PG8_SB(0, 1), rB, b2 + hstep, voffB);
            PG8_WAIT_V(6); PG8_BAR; PG8_MMA(1, 1, At, B1); PG8_BAR;
            PG8_LDB(B0, 1, 0); PG8_SCHED; PG8_LDA(At, 1, 0); PG8_STAGE(PG8_SA(0, 1), rA, a2 + hstep, voffA);
            PG8_WAIT_L(8); PG8_BAR; PG8_WAIT_L(0); PG8_MMA(0, 0, At, B0); PG8_BAR; PG8_SCHED;
            PG8_LDB(B1, 1, 1); PG8_STAGE(PG8_SB(1, 0), rB, b3, voffB);
            PG8_BAR; PG8_WAIT_L(0); PG8_MMA(0, 1, At, B1); PG8_BAR;
            PG8_LDA(At, 1, 1); PG8_STAGE(PG8_SA(1, 0), rA, a3, voffA);
            PG8_BAR; PG8_WAIT_L(0); PG8_MMA(1, 0, At, B0); PG8_BAR; PG8_SCHED;
            PG8_STAGE(PG8_SB(1, 1), rB, b3 + hstep, voffB);
            PG8_WAIT_V(6); PG8_BAR; PG8_MMA(1, 1, At, B1); PG8_BAR;
            }
        }
        if constexpr (ALIGN_EPI) { if (wr == 0) PG8_BAR; }
        if constexpr (!Epi::AFTER_DRAIN) { if constexpr (Epi::HAS_PRE) { E.pre_wait(pre); E(acc, cur, wr, wc, fr, fq, pre); } else E(acc, cur, wr, wc, fr, fq); S.done(cur); }
        if (!has_next) break;
        if constexpr (Epi::HAS_INIT) E.init(acc, nxt, wr, wc, fr, fq);
        else {
        bf16x8 z8 = {0, 0, 0, 0, 0, 0, 0, 0}; asm volatile("" : "+v"(z8));
#pragma unroll
        for (int a = 0; a < 2; ++a)
#pragma unroll
            for (int b = 0; b < 2; ++b)
#pragma unroll
                for (int m = 0; m < 4; ++m)
#pragma unroll
                    for (int n = 0; n < 2; ++n) { asm volatile("" : "+v"(z8));
                        acc[a][b][m][n] = __builtin_amdgcn_mfma_f32_16x16x32_bf16(z8, z8, (f32x4){0.f, 0.f, 0.f, 0.f}, 0, 0, 0); }
        }
        cur = nxt; cA = nA; cB = nB; ++ui;
        if constexpr (ALIGN_EPI) { if (wr == 1) PG8_BAR; }
    }
    PG8_WAIT_V(0);
    if constexpr (!ALIGN_EPI) { if (wr == 0) PG8_BAR; }
    PG8_BAR;
    if constexpr (Epi::AFTER_DRAIN) { E.fused(acc, cur, wr, wc, fr, fq, lds, wid, lane); S.done(cur); }
    if (ABL == 5) { _Pragma("unroll") for (int i = 0; i < 8; ++i) asm volatile("" :: "v"(acc32[i])); }
#undef PG8_SA
#undef PG8_SB
#undef PG8_STAGE
#undef PG8_LDA
#undef PG8_LDB
#undef PG8_MMA
#undef PG8_WAIT_V
#undef PG8_WAIT_L
#undef PG8_BAR
#undef PG8_SCHED
}
}

constexpr int NWAVES = 8;
constexpr int D = 2048, BATCH = 4, SEQ = 2048, DEPTH = 4, HD = 128, FF = 5632;
constexpr int M = BATCH * SEQ;
constexpr int AB_IN = 4608, C_IN = 6144;
constexpr float RMS_EPS = 1e-6f;
constexpr float QK_SCALE = 0.08838834764831845f;

constexpr size_t MiB = 1u << 20;
constexpr size_t WS_CTL = 0, CTL_ZERO_BYTES = 1 * MiB;
constexpr size_t SZ_WGU = (size_t)2 * FF * D * 2, SZ_WD = (size_t)D * FF * 2, SZ_WABIN = (size_t)AB_IN * D * 2, SZ_WOUT = (size_t)D * D * 2, SZ_WCIN = (size_t)C_IN * D * 2;
constexpr size_t WS_WGU = 2 * MiB;
constexpr size_t WS_WD = WS_WGU + 8 * SZ_WGU;
constexpr size_t WS_WABIN = WS_WD + 8 * SZ_WD;
constexpr size_t WS_WABOUT = WS_WABIN + 2 * SZ_WABIN;
constexpr size_t WS_WCIN = WS_WABOUT + 2 * SZ_WOUT;
constexpr size_t WS_WCOUT = WS_WCIN + 2 * SZ_WCIN;
constexpr size_t WS_H = WS_WCOUT + 2 * SZ_WOUT;
constexpr size_t WS_U = WS_H + (size_t)M * D * 2;
constexpr size_t WS_QKV = WS_U + (size_t)M * FF * 2;
constexpr size_t WS_O = WS_QKV + (size_t)M * C_IN * 2;
constexpr size_t WS_PART = WS_O + (size_t)M * D * 2;
constexpr size_t WS_LSE = WS_PART + (size_t)3 * M * 1024 * 4;
constexpr size_t WS_END = WS_LSE + (size_t)3 * M * 8 * 4;
constexpr int CW_BAR = 4096;
constexpr size_t WS_SSQ = 65536;
constexpr size_t WS_SB = 917504;
static_assert(WS_SB >= WS_SSQ + (size_t)13 * 8192 * 8 && WS_SB + 128 * 17 * 32 <= CTL_ZERO_BYTES, "token-barrier counters inside the memset region");
#ifndef NSTREAMS
#define NSTREAMS 2
#endif
constexpr int NSTREAM = NSTREAMS, MH = M / NSTREAM;
static_assert(WS_SSQ + (size_t)13 * 8192 * 8 <= CTL_ZERO_BYTES, "ssq slots inside the memset region");

constexpr int RING_OFF = 0, RING_BYTES = 131072;
constexpr int LDSCTL_OFF = RING_BYTES, MISC_OFF = LDSCTL_OFF + 320;
constexpr int LDS_BYTES = 147456;
static_assert(MISC_OFF + 128 <= LDS_BYTES, "LDS map");

#define GAS __attribute__((address_space(1)))
#define LAS __attribute__((address_space(3)))
typedef unsigned short bf16;
typedef unsigned v4u __attribute__((ext_vector_type(4)));
typedef unsigned v2u __attribute__((ext_vector_type(2)));
typedef float f32x4 __attribute__((ext_vector_type(4)));
typedef GAS unsigned gu32;
#define RLX_AGENT __ATOMIC_RELAXED, __HIP_MEMORY_SCOPE_AGENT
#define LDS_WAIT() asm volatile("s_waitcnt lgkmcnt(0)" ::: "memory")
#define VM_WAIT() asm volatile("s_waitcnt vmcnt(0)" ::: "memory")
__device__ __forceinline__ unsigned f2bf(float f) { unsigned u = __builtin_bit_cast(unsigned, f); return (u + 0x7fffu + ((u >> 16) & 1u)) >> 16; }
__device__ __forceinline__ unsigned pk2(float lo, float hi) { return f2bf(lo) | (f2bf(hi) << 16); }
typedef _Float16 h2_t __attribute__((ext_vector_type(2))); typedef float f2_t __attribute__((ext_vector_type(2))); typedef _Float16 h4_t __attribute__((ext_vector_type(4)));
__device__ __forceinline__ unsigned pkh2(float lo, float hi) { const f2_t v = {lo, hi}; return __builtin_bit_cast(unsigned, __builtin_convertvector(v, h2_t)); }
__device__ __forceinline__ float bflo(unsigned w) { return __builtin_bit_cast(float, w << 16); }
__device__ __forceinline__ float bfhi(unsigned w) { return __builtin_bit_cast(float, w & 0xffff0000u); }

#define XB_TMO      128
#define XB_XCNT(j)  (256  + 64 * (j))
#define XB_XSUB(j)  (1280 + 64 * (j))
#define XB_XGEN(j)  (2304 + 64 * (j))
#define XB_TOP      3328
#define XB_TOPGEN   3392
#define XCD_BAR_WORDS 3456
#define XB_SPIN_CAP (1u << 18)

__device__ __forceinline__ unsigned xb_ld(unsigned* p)              { return __hip_atomic_load(p, __ATOMIC_RELAXED, __HIP_MEMORY_SCOPE_AGENT); }
__device__ __forceinline__ unsigned xb_add(unsigned* p, unsigned v) { return __hip_atomic_fetch_add(p, v, __ATOMIC_RELAXED, __HIP_MEMORY_SCOPE_AGENT); }
__device__ __forceinline__ unsigned xb_xcc_id() { return (unsigned)__builtin_amdgcn_s_getreg((3 << 11) | 20) & 0xFu; }
#define XB_SPIN(cond, bar) do { unsigned _sp = 0; while (cond) { __builtin_amdgcn_s_sleep(1); \
    if ((++_sp & 255u) == 0u) { if (xb_ld(&(bar)[XB_TMO])) break; if (_sp > XB_SPIN_CAP) { atomicAdd(&(bar)[XB_TMO], 1u); break; } } } } while (0)

struct XcdBarrier {
    int wv;
    unsigned* bar; unsigned x;
    volatile LAS unsigned* st;
};

__device__ __forceinline__ int xb_lane() { int l; asm volatile("v_mbcnt_lo_u32_b32 %0, -1, 0\n\tv_mbcnt_hi_u32_b32 %0, -1, %0" : "=v"(l)); return l; }
__device__ __forceinline__ XcdBarrier xcd_barrier_post(unsigned* bar, volatile LAS unsigned* st, int wv) {
    XcdBarrier b; b.wv = wv; b.bar = bar; b.x = xb_xcc_id(); b.st = st;
    if (wv == 0 && xb_lane() == 0) (void)xb_add(&bar[XB_XCNT(b.x)], 1u);
    return b;
}
__device__ __forceinline__ void xcd_barrier_complete(unsigned* bar, unsigned x, unsigned& nloc, unsigned& nx) {
    const unsigned G = gridDim.x * gridDim.y * gridDim.z;
    unsigned sum, cnt, mine, sp = 0u;
    for (;;) {
        sum = 0u; cnt = 0u; mine = 0u;
#pragma unroll
        for (unsigned j = 0; j < 16; ++j) { const unsigned c = xb_ld(&bar[XB_XCNT(j)]); sum += c; cnt += (c > 0u) ? 1u : 0u; mine = (j == x) ? c : mine; }
        if (sum == G) break;
        __builtin_amdgcn_s_sleep(1);
        if ((++sp & 255u) == 0u) { if (xb_ld(&bar[XB_TMO])) break; if (sp > XB_SPIN_CAP) { atomicAdd(&bar[XB_TMO], 1u); break; } }
    }
    nloc = mine > 0u ? mine : 1u; nx = cnt > 0u ? cnt : 1u;
}

__device__ __forceinline__ void xcd_barrier(const XcdBarrier& b) {
    asm volatile("s_waitcnt vmcnt(0)" ::: "memory");
    __syncthreads();
    if (b.wv == 0 && xb_lane() == 0) {
        unsigned* bar = b.bar; unsigned bx = b.x; asm volatile("" : "+s"(bar), "+s"(bx));
        __builtin_amdgcn_s_waitcnt(0);
        unsigned nloc = b.st[0], nx = b.st[1];
        if (nloc == 0u) { xcd_barrier_complete(bar, bx, nloc, nx); b.st[0] = nloc; b.st[1] = nx; }
        const unsigned old = xb_add(&bar[XB_XSUB(bx)], 1u);
        const unsigned gen = old / nloc;
        if (old + 1u == (gen + 1u) * nloc) {
            __builtin_amdgcn_fence(__ATOMIC_RELEASE, "agent");
            asm volatile("s_waitcnt vmcnt(0)" ::: "memory");
            const unsigned og = xb_add(&bar[XB_TOP], 1u);
            const unsigned tg = og / nx;
            if (og + 1u == (tg + 1u) * nx) xb_add(&bar[XB_TOPGEN], 1u);
            else XB_SPIN(xb_ld(&bar[XB_TOPGEN]) == tg, bar);
            __builtin_amdgcn_fence(__ATOMIC_ACQUIRE, "agent");
            xb_add(&bar[XB_XGEN(bx)], 1u);
            asm volatile("s_waitcnt vmcnt(0)" ::: "memory");
        } else {
            XB_SPIN(xb_ld(&bar[XB_XGEN(bx)]) == gen, bar);
            __builtin_amdgcn_fence(__ATOMIC_ACQUIRE, "agent");
            asm volatile("s_waitcnt vmcnt(0)" ::: "memory");
        }
    }
    __syncthreads();
}

#define SB_TOKEN_WORDS (17 * 8)
__device__ __forceinline__ void sb_arrive(const XcdBarrier& b, unsigned* sb, int T) {
    asm volatile("s_waitcnt vmcnt(0)" ::: "memory");
    __syncthreads();
    if (b.wv == 0 && xb_lane() == 0) {
        unsigned* base = sb + (size_t)T * SB_TOKEN_WORDS; unsigned bx = b.x; asm volatile("" : "+s"(base), "+s"(bx));
        __builtin_amdgcn_s_waitcnt(0);
        const unsigned nloc = b.st[0];
        const unsigned old = xb_add(&base[8 * bx], 1u);
        if (old + 1u == nloc) {
            __builtin_amdgcn_fence(__ATOMIC_RELEASE, "agent");
            asm volatile("s_waitcnt vmcnt(0)" ::: "memory");
            xb_add(&base[8 * 16], 1u);
        }
    }
}
__device__ __forceinline__ void sb_wait(const XcdBarrier& b, unsigned* sb, int T) {
    if (b.wv == 0 && xb_lane() == 0) {
        unsigned* base = sb + (size_t)T * SB_TOKEN_WORDS; asm volatile("" : "+s"(base));
        const unsigned nx = b.st[1];
        XB_SPIN(xb_ld(&base[8 * 16]) < nx, b.bar);
        __builtin_amdgcn_fence(__ATOMIC_ACQUIRE, "agent");
        asm volatile("s_waitcnt vmcnt(0)" ::: "memory");
    }
    __syncthreads();
}

struct Frame {
    LAS unsigned char* lds;
    int tid, lane, wave;
    int G, bid;
};
__device__ __forceinline__ float wave_sum(float v) {
    const int ln_ = pg8::lane_id_here();
#pragma unroll
    for (int o = 1; o < 64; o <<= 1) v += pg8::xor_shfl(v, o, ln_);
    return v;
}
__device__ __forceinline__ float wave_max(float v) {
    const int ln_ = pg8::lane_id_here();
#pragma unroll
    for (int o = 1; o < 64; o <<= 1) v = fmaxf(v, pg8::xor_shfl(v, o, ln_));
    return v;
}
template <bool GAIN>
__device__ __forceinline__ void p0_transpose_item(const float* W, int K, int N, bf16* WT, int k0, int n0, int drow0, LAS float* scr, int lane, const float* gain) {
    const int c = lane & 7;
    f32x4 ga = {1.f, 1.f, 1.f, 1.f}, gb = {1.f, 1.f, 1.f, 1.f};
    if (GAIN) { ga = *(const GAS f32x4*)(gain + k0 + 8 * c); gb = *(const GAS f32x4*)(gain + k0 + 8 * c + 4); }
#pragma unroll 8
    for (int i = 0; i < 32; ++i) { const int kk = 2 * i + (lane >> 5); scr[kk * 33 + (lane & 31)] = __builtin_nontemporal_load(W + (size_t)(k0 + kk) * N + n0 + (lane & 31)); }
    LDS_WAIT(); asm volatile("" ::: "memory");
#pragma unroll
    for (int j = 0; j < 4; ++j) { const int n = (lane >> 3) + 8 * j; const LAS float* s = scr + (8 * c) * 33 + n;
        v4u o;
        if (GAIN && RESID_F16) { o.x = pkh2(s[0 * 33] * ga.x, s[1 * 33] * ga.y); o.y = pkh2(s[2 * 33] * ga.z, s[3 * 33] * ga.w); o.z = pkh2(s[4 * 33] * gb.x, s[5 * 33] * gb.y); o.w = pkh2(s[6 * 33] * gb.z, s[7 * 33] * gb.w); }
        else { o.x = pk2(s[0 * 33] * ga.x, s[1 * 33] * ga.y); o.y = pk2(s[2 * 33] * ga.z, s[3 * 33] * ga.w); o.z = pk2(s[4 * 33] * gb.x, s[5 * 33] * gb.y); o.w = pk2(s[6 * 33] * gb.z, s[7 * 33] * gb.w); }
        __builtin_nontemporal_store(o, (GAS v4u*)(WT + (size_t)(drow0 + n) * K + k0 + 8 * c)); }
    LDS_WAIT(); asm volatile("" ::: "memory");
}
struct Args {
    const float* x; const float* ffn_norm; const float* wg; const float* wu; const float* wd; const float* mix_norm;
    const float* ab_in; const float* ab_out; const float* ab_sink; const float* c_in; const float* c_out; const float* c_rpb; const float* final_norm;
    float* out; unsigned char* ws; int ph_lo, ph_hi;
};
static_assert(sizeof(Args) == 15 * 8 + 8, "Args has no padding");

constexpr int CV_NSLOT = 11, CV_MAXR = 1;
__device__ const int CV_TAB[CV_NSLOT][CV_MAXR][2] = {
    {{0, 164864}},
    {{0, 0}},
    {{0, 0}},
    {{0, 0}},
    {{0, 0}},
    {{0, 0}},
    {{0, 0}},
    {{0, 0}},
    {{0, 0}},
    {{0, 0}},
    {{0, 0}},
};

constexpr int CV_I_GU = (D / 64) * (FF / 32), CV_I_D = (FF / 64) * (D / 32), CV_I_ABIN = (D / 64) * (AB_IN / 32), CV_I_OUT = (D / 64) * (D / 32), CV_I_CIN = (D / 64) * (C_IN / 32);
constexpr int CV_EVEN = 2 * CV_I_GU + CV_I_D + CV_I_ABIN + CV_I_OUT + 2 * CV_I_GU + CV_I_D, CV_ODD = CV_EVEN - CV_I_ABIN + CV_I_CIN;
static_assert(2 * (CV_EVEN + CV_ODD) == 164864, "item count");
__device__ __forceinline__ void cv_item(const Args& a, unsigned char* ws, int it, LAS float* scr, int lane) {
    const int pr = it / (CV_EVEN + CV_ODD); int r = it - pr * (CV_EVEN + CV_ODD); int layer = 2 * pr; if (r >= CV_EVEN) { r -= CV_EVEN; ++layer; }
    const int li = layer >> 1; const bool odd = layer & 1; const int nin = odd ? CV_I_CIN : CV_I_ABIN;
    int f = 0, kind;
    if (r < 2 * CV_I_GU) kind = 0; else { r -= 2 * CV_I_GU; if (r < CV_I_D) kind = 1; else { r -= CV_I_D; if (r < nin) kind = 2; else { r -= nin; if (r < CV_I_OUT) kind = 3; else { r -= CV_I_OUT; f = 1;
        if (r < 2 * CV_I_GU) kind = 0; else { r -= 2 * CV_I_GU; kind = 1; } } } } }
    const int lf = layer * 2 + f;
    if (kind == 0) { const int up = r >= CV_I_GU; if (up) r -= CV_I_GU; const int nblk = FF / 32, kb = r / nblk, nb = r % nblk, n0 = 32 * nb;
        p0_transpose_item<true>((up ? a.wu : a.wg) + (size_t)lf * D * FF, D, FF, (bf16*)(ws + WS_WGU + (size_t)lf * SZ_WGU), 64 * kb, n0, (n0 >> 7) * 256 + (n0 & 127) + up * 128, scr, lane, a.ffn_norm + (size_t)lf * D); }
    else if (kind == 1) { const int nblk = D / 32, kb = r / nblk, nb = r % nblk, n0 = 32 * nb;
        p0_transpose_item<false>(a.wd + (size_t)lf * FF * D, FF, D, (bf16*)(ws + WS_WD + (size_t)lf * SZ_WD), 64 * kb, n0, n0, scr, lane, nullptr); }
    else if (kind == 2) {
        if (!odd) { const int nblk = AB_IN / 32, kb = r / nblk, nb = r % nblk, n0 = 32 * nb;
            p0_transpose_item<true>(a.ab_in + (size_t)li * D * AB_IN, D, AB_IN, (bf16*)(ws + WS_WABIN + (size_t)li * SZ_WABIN), 64 * kb, n0, n0, scr, lane, a.mix_norm + (size_t)layer * D); }
        else { const int nblk = C_IN / 32, kb = r / nblk, nb = r % nblk, n0 = 32 * nb;
            p0_transpose_item<true>(a.c_in + (size_t)li * D * C_IN, D, C_IN, (bf16*)(ws + WS_WCIN + (size_t)li * SZ_WCIN), 64 * kb, n0, n0, scr, lane, a.mix_norm + (size_t)layer * D); } }
    else { const int nblk = D / 32, kb = r / nblk, nb = r % nblk, n0 = 32 * nb;
        p0_transpose_item<false>((odd ? a.c_out : a.ab_out) + (size_t)li * D * D, D, D, (bf16*)(ws + (odd ? WS_WCOUT : WS_WABOUT) + (size_t)li * SZ_WOUT), 64 * kb, n0, n0, scr, lane, nullptr); }
}
__device__ __forceinline__ void cv_run(const Frame& F, const Args& a, unsigned char* ws, int slot, int j, int n) {
    LAS float* scr = (LAS float*)(F.lds + RING_OFF + F.wave * 16384);
    int lane = F.lane; asm volatile("" : "+v"(lane));
    int total = 0;
#pragma unroll
    for (int r = 0; r < CV_MAXR; ++r) total += CV_TAB[slot][r][1] - CV_TAB[slot][r][0];
    for (int idx = j * NWAVES + F.wave; idx < total; idx += n * NWAVES) {
        int rem = idx, it = 0;
#pragma unroll
        for (int r = 0; r < CV_MAXR; ++r) { const int b = CV_TAB[slot][r][0], len = CV_TAB[slot][r][1] - b; if (rem >= 0 && rem < len) it = b + rem; rem -= len; }
        cv_item(a, ws, it, scr, lane);
    }
}
__device__ __forceinline__ void p0_prologue(const Frame& F, const Args& a) {
    const int gw = F.bid * NWAVES + F.wave, NGW = F.G * NWAVES;
    int lane = F.lane; asm volatile("" : "+v"(lane));
    cv_run(F, a, a.ws, 0, F.bid, F.G);
    bf16* const XB = (bf16*)(a.ws + WS_H); pg8::ssq_t* const ssq0 = (pg8::ssq_t*)(a.ws + WS_SSQ);
    for (int m = gw; m < M; m += NGW) {
        const GAS f32x4* xr = (const GAS f32x4*)(a.x + (size_t)m * D) + lane;
        f32x4 v[8]; float s = 0.f;
#pragma unroll
        for (int j = 0; j < 8; ++j) { v[j] = xr[64 * j]; s += (v[j].x * v[j].x + v[j].y * v[j].y) + (v[j].z * v[j].z + v[j].w * v[j].w); }
        s = wave_sum(s);
        s = 0.f;
#pragma unroll
        for (int j = 0; j < 8; ++j) { const h4_t hq = __builtin_convertvector(v[j], h4_t); ((GAS h4_t*)(XB + (size_t)m * D) + lane)[64 * j] = hq; const f32x4 y = __builtin_convertvector(hq, f32x4); s += (y.x * y.x + y.y * y.y) + (y.z * y.z + y.w * y.w); }
        s = wave_sum(s);
        if (lane == 0) ssq0[m] = pg8::ssq_fix(s);
    }
}
__device__ __forceinline__ void final_norm_h_phase(const Frame& F, const bf16* xb, float* out, const float* g, const pg8::ssq_t* ssq, const int stream) {
    const int gw = F.bid * NWAVES + F.wave, NGW = F.G * NWAVES;
    int lane = F.lane; asm volatile("" : "+v"(lane));
    for (int m = stream * MH + gw; m < (stream + 1) * MH; m += NGW) {
        const GAS h4_t* xr = (const GAS h4_t*)(xb + (size_t)m * D) + lane; GAS f32x4* orow = (GAS f32x4*)(out + (size_t)m * D) + lane; const GAS f32x4* gr = (const GAS f32x4*)g + lane;
        const float rstd = 1.0f / sqrtf(pg8::ssq_val(((const GAS pg8::ssq_t*)ssq)[m + (lane & 0)]) * (1.f / D) + RMS_EPS);
        h4_t xv[8]; f32x4 gv[8];
#pragma unroll
        for (int j = 0; j < 8; ++j) { xv[j] = xr[64 * j]; gv[j] = gr[64 * j]; }
#pragma unroll
        for (int j = 0; j < 8; ++j) orow[64 * j] = __builtin_convertvector(xv[j], f32x4) * rstd * gv[j];
    }
}
namespace att {
using bf16x8 = __attribute__((ext_vector_type(8))) short;
using s16x4  = __attribute__((ext_vector_type(4))) short;
using f32x16 = __attribute__((ext_vector_type(16))) float;
using u32x4  = __attribute__((ext_vector_type(4))) unsigned;
constexpr float LOG2E = 1.4426950408889634f;
constexpr float CSC = 0.08838834764831845f * LOG2E;
constexpr float THR_L2 = 4.0f * LOG2E;
#define ATT_KSWZ(row, colB) ((row) * 256 + ((colB) ^ (((row) & 7) << 4)))
__device__ __forceinline__ constexpr int crowc(int r) { return (r & 3) + 8 * (r >> 2); }
__device__ __forceinline__ unsigned cvtpk(float lo, float hi) { unsigned r; asm volatile("v_cvt_pk_bf16_f32 %0, %1, %2" : "=v"(r) : "v"(lo), "v"(hi)); return r; }
__device__ __forceinline__ int swap23(int k) { return (k & ~0xC) | ((k & 4) << 1) | ((k & 8) >> 1); }
__device__ __forceinline__ int v_rd_base(int lane) { return ((lane & 3) << 3) | (((lane >> 2) & 3) << 6) | (((lane >> 4) & 1) << 5) | (((lane >> 5) & 1) << 8); }
constexpr int v_rd_off(int d0, int ks, int half) { return d0 * 512 + ks * 4096 + half * 2048; }
template <int OFF> __device__ __forceinline__ s16x4 tr_read(int vb) { s16x4 r; asm volatile("ds_read_b64_tr_b16 %0, %1 offset:%2" : "=&v"(r) : "v"(vb), "i"(OFF) : "memory"); return r; }
template <int D0> __device__ __forceinline__ void pv_one(f32x16& od, int vb, bf16x8 pa0, bf16x8 pa1) {
    const s16x4 l0 = tr_read<v_rd_off(D0, 0, 0)>(vb), h0 = tr_read<v_rd_off(D0, 0, 1)>(vb), l1 = tr_read<v_rd_off(D0, 1, 0)>(vb), h1 = tr_read<v_rd_off(D0, 1, 1)>(vb);
    asm volatile("s_waitcnt lgkmcnt(0)" ::: "memory"); __builtin_amdgcn_sched_barrier(0);
#define ATT_PK(L, H) (bf16x8){L[0], L[1], L[2], L[3], H[0], H[1], H[2], H[3]}
    od = __builtin_amdgcn_mfma_f32_32x32x16_bf16(pa0, ATT_PK(l0, h0), od, 0, 0, 0);
    od = __builtin_amdgcn_mfma_f32_32x32x16_bf16(pa1, ATT_PK(l1, h1), od, 0, 0, 0);
#undef ATT_PK
}
constexpr int ATT_SCR_OFF = 132096;
constexpr int ATT_RPB_OFF = 136192;
constexpr int RPB_PAD = 8, RPB_FLOATS = 640;
static_assert(ATT_RPB_OFF + 4 * RPB_FLOATS * 4 <= LDS_BYTES && ATT_SCR_OFF >= MISC_OFF + 128, "attention LDS map");

template <int MODE>
__device__ __forceinline__ void attn_mfma(const Frame& F, const bf16* QKV, const int ld, bf16* O, float* part, float* lsebuf, const float* extra, const int stream, const int vc) {
    int lane = F.lane; asm volatile("" : "+v"(lane));
    const int wid = F.wave, pair = wid >> 1, w2 = wid & 1, r32 = lane & 31, hi = lane >> 5;
    LAS unsigned char* const pbase = F.lds + RING_OFF + ((MODE == 1) ? 0 : pair * 32768);
    LAS float* const scr = (LAS float*)(F.lds + ATT_SCR_OFF + wid * 512);
    LAS float* const rpbt = (LAS float*)(F.lds + ATT_RPB_OFF + pair * (RPB_FLOATS * 4));
    constexpr int NT = (MODE == 0) ? 6 : (MODE == 1) ? 10 : 11;
    constexpr int NUNITS = ((MODE == 0) ? 3072 : (MODE == 1) ? 1024 : 2048) / NSTREAM;
    constexpr int HW = (MODE == 0) ? 64 : 128;
    const int vb0 = (int)(uintptr_t)(pbase + 8192) + v_rd_base(lane);
    for (int g = vc; g < NUNITS / 4; g += F.G) {
        const int u = g * 4 + pair;
        int b, h, qcol, kcol, vcol, shift = 0, jres = 0, l0 = 0, L = SEQ, pat = 0, rbase = 0, c0 = 0, qr0 = 0, qc0 = 0;
        if (MODE == 0) { const int blk = u & 31, rest = u >> 5; pat = rest % 3; const int bh = rest / 3; h = bh & 7; b = (BATCH / NSTREAM) * stream + (bh >> 3); shift = 2 * pat; L = SEQ >> shift;
            const int nbs = 5 - shift; jres = blk >> nbs; l0 = 64 * (blk & ((1 << nbs) - 1)); qcol = h * HD; kcol = 1024 + h * HD; vcol = 2048 + h * HD; }
        else if (MODE == 1) { const int blk = g & 31, bk = g >> 5; h = 4 * (bk & 1) + pair; b = (BATCH / NSTREAM) * stream + (bk >> 1); l0 = 64 * blk; qcol = 3072 + h * HD; kcol = 4096 + (h >> 2) * HD; vcol = 4352 + (h >> 2) * HD; }
        else { const int cc = u & 3, ii = (u >> 2) & 7, bh = u >> 5; h = bh & 15; b = (BATCH / NSTREAM) * stream + (bh >> 4); qr0 = 4 * ii; qc0 = 16 * cc; rbase = qr0 - 4; rbase = rbase < 0 ? 0 : (rbase > 21 ? 21 : rbase);
            c0 = (cc == 0) ? 0 : (cc == 1) ? 8 : (cc == 2) ? 24 : 32; qcol = h * HD; kcol = 2048 + h * HD; vcol = 4096 + h * HD; }
        const bf16* const Qb = QKV + (size_t)b * SEQ * ld;
        int lq = 0, qrow = 0, qcl = 0, sq;
        if (MODE == 2) { qrow = qr0 + 2 * w2 + (r32 >> 4); qcl = qc0 + (r32 & 15); sq = qrow * 64 + qcl; }
        else { lq = l0 + 32 * w2 + r32; sq = (lq << shift) + jres; }
        bf16x8 qr[8];
        { const bf16* qp = Qb + (size_t)sq * ld + qcol + hi * 8;
#pragma unroll
          for (int d0 = 0; d0 < 8; ++d0) qr[d0] = *(const bf16x8*)(qp + d0 * 16); }
        float slopeL2 = 0.f; int rs = 0, cs = 0;
        __builtin_amdgcn_s_barrier();
        if (MODE != 2) slopeL2 = exp2f(-(float)(h + 1)) * (float)(1 << shift) * LOG2E;
        else { rs = qrow - 4; rs = rs < 0 ? 0 : (rs > 24 ? 24 : rs); cs = qcl - 8; cs = cs < 0 ? 0 : (cs > 48 ? 48 : cs);
            float rv[4];
#pragma unroll
            for (int k = 0; k < 4; ++k) { int i = lane + 64 * w2 + 128 * k; i = i < 15 * 31 ? i : 15 * 31 - 1; rv[k] = ((const GAS float*)extra)[h * 15 * 31 + i]; }
#pragma unroll
            for (int k = 0; k < 4; ++k) { const int i = lane + 64 * w2 + 128 * k; if (i < 15 * 31) rpbt[RPB_PAD + i] = rv[k] * LOG2E; } }
        const int krow = 16 * w2 + (lane >> 4);
        const int kch = lane & 15;
        const int vst = 8 * w2 + (lane >> 5), vq = lane & 31;
#define ATT_KEYTOK(jj, t) ((MODE == 2) ? ((rbase + (t)) * 64 + c0 + (jj)) : ({ int lk_ = l0 - HW + 32 * (t) + (jj); lk_ = lk_ < 0 ? 0 : (lk_ > L - 1 ? L - 1 : lk_); (lk_ << shift) + jres; }))
#define ATT_STAGE(t) do { LAS unsigned char* const bb_ = pbase + ((t) & 1) * 16384; \
        if (MODE == 1) { const int row_ = 4 * wid + (lane >> 4); const int tok_ = ATT_KEYTOK(row_, t);                                 \
            __builtin_amdgcn_global_load_lds((const unsigned*)(Qb + (size_t)tok_ * ld + kcol + ((kch ^ (row_ & 7)) << 3)), (LAS unsigned*)(bb_ + wid * 1024), 16, 0, 0); \
            const int st_ = 2 * wid + (lane >> 5); const int kk_ = (st_ >> 2) * 8 + (vq >> 2); const int tokv_ = ATT_KEYTOK(swap23(kk_), t); \
            __builtin_amdgcn_global_load_lds((const unsigned*)(Qb + (size_t)tokv_ * ld + vcol + (st_ & 3) * 32 + (vq & 3) * 8), (LAS unsigned*)(bb_ + 8192 + wid * 1024), 16, 0, 0); } \
        else { \
        _Pragma("unroll") for (int i_ = 0; i_ < 4; ++i_) { const int row_ = krow + 4 * i_; const int tok_ = ATT_KEYTOK(row_, t); \
            __builtin_amdgcn_global_load_lds((const unsigned*)(Qb + (size_t)tok_ * ld + kcol + ((kch ^ (row_ & 7)) << 3)), (LAS unsigned*)(bb_ + (w2 * 4 + i_) * 1024), 16, 0, 0); } \
        _Pragma("unroll") for (int i_ = 0; i_ < 4; ++i_) { const int st_ = vst + 2 * i_; const int kk_ = (st_ >> 2) * 8 + (vq >> 2); const int tok_ = ATT_KEYTOK(swap23(kk_), t); \
            __builtin_amdgcn_global_load_lds((const unsigned*)(Qb + (size_t)tok_ * ld + vcol + (st_ & 3) * 32 + (vq & 3) * 8), (LAS unsigned*)(bb_ + 8192 + (w2 * 4 + i_) * 1024), 16, 0, 0); } } } while (0)
        float m_reg = -1e30f, l_reg = 0.f;
        f32x16 o[4];
#pragma unroll
        for (int d = 0; d < 4; ++d)
#pragma unroll
            for (int r = 0; r < 16; ++r) o[d][r] = 0.f;
        asm volatile("s_waitcnt lgkmcnt(0)" ::: "memory"); __builtin_amdgcn_s_barrier();
        ATT_STAGE(0);
        for (int t = 0; t < NT; ++t) {
            asm volatile("s_waitcnt vmcnt(0)" ::: "memory"); __builtin_amdgcn_s_barrier(); asm volatile("" ::: "memory");
            if (t + 1 < NT) ATT_STAGE(t + 1);
            bool need = true;
            if (MODE == 0) need = (w2 == 0) ? (t < 5) : (t > 0);
            else if (MODE == 1) need = (w2 == 0) ? (t < 9) : (t > 0);
            else { const int kr = rbase + t, ra = qr0 + 2 * w2; int rsA = ra - 4; rsA = rsA < 0 ? 0 : (rsA > 24 ? 24 : rsA); int rsB = ra - 3; rsB = rsB < 0 ? 0 : (rsB > 24 ? 24 : rsB); need = (kr >= rsA) && (kr < rsB + 8); }
            if (!need) continue;
            LAS unsigned char* const Kb = pbase + (t & 1) * 16384;
            f32x16 p0;
#pragma unroll
            for (int r = 0; r < 16; ++r) p0[r] = 0.f;
#pragma unroll
            for (int d0 = 0; d0 < 8; ++d0) { const int cb = (d0 * 16 + hi * 8) * 2;
                const bf16x8 kf = *(const LAS bf16x8*)(Kb + ATT_KSWZ(r32, cb));
                p0 = __builtin_amdgcn_mfma_f32_32x32x16_bf16(kf, qr[d0], p0, 0, 0, 0); }
            if (MODE != 2) {
                const int kb_i = l0 - HW + 32 * t + 4 * hi;
                const float fb = (float)(kb_i - lq);
#pragma unroll
                for (int r = 0; r < 16; ++r) { const float fd = fb + (float)crowc(r); const bool ok = (fabsf(fd) <= (float)HW) && ((unsigned)(kb_i + crowc(r)) < (unsigned)L);
                    p0[r] = ok ? fmaf(p0[r], CSC, -slopeL2 * fabsf(fd)) : -INFINITY; }
            } else {
                int rs_ = qrow - 4; rs_ = rs_ < 0 ? 0 : (rs_ > 24 ? 24 : rs_); int cs_ = qcl - 8; cs_ = cs_ < 0 ? 0 : (cs_ > 48 ? 48 : cs_);
                const int kr = rbase + t; const bool inr = (unsigned)(kr - rs_) < 8u;
                const int kcb = c0 + 4 * hi;
                const LAS float* bp = rpbt + RPB_PAD + (kr - qrow + 7) * 31 + (kcb - qcl + 15);
                float bv[16];
#pragma unroll
                for (int r = 0; r < 16; ++r) bv[r] = bp[crowc(r)];
#pragma unroll
                for (int r = 0; r < 16; ++r) { const bool ok = inr && ((unsigned)(kcb + crowc(r) - cs_) < 16u);
                    p0[r] = ok ? fmaf(p0[r], CSC, bv[r]) : -INFINITY; }
            }
            float pmax = p0[0];
#pragma unroll
            for (int r = 1; r < 16; ++r) pmax = fmaxf(pmax, p0[r]);
            { auto rr = __builtin_amdgcn_permlane32_swap(__float_as_uint(pmax), __float_as_uint(pmax), false, false); pmax = fmaxf(__uint_as_float(rr[0]), __uint_as_float(rr[1])); }
            float alpha = 1.f;
            if (!__all(pmax - m_reg <= THR_L2)) { const float mn = fmaxf(m_reg, pmax); alpha = __builtin_amdgcn_exp2f(m_reg - mn); m_reg = mn; }
            float ps = 0.f;
#pragma unroll
            for (int r = 0; r < 16; ++r) { p0[r] = __builtin_amdgcn_exp2f(p0[r] - m_reg); ps += p0[r]; }
            { auto rr = __builtin_amdgcn_permlane32_swap(__float_as_uint(ps), __float_as_uint(ps), false, false); ps = __uint_as_float(rr[0]) + __uint_as_float(rr[1]); }
            l_reg = l_reg * alpha + ps;
            bf16x8 pa0, pa1;
#define ATT_PK4(P, BASE, OUT) do { unsigned a0 = cvtpk(P[BASE + 0], P[BASE + 1]), a1 = cvtpk(P[BASE + 2], P[BASE + 3]); \
        unsigned b0 = cvtpk(P[BASE + 4], P[BASE + 5]), b1 = cvtpk(P[BASE + 6], P[BASE + 7]); \
        auto r0 = __builtin_amdgcn_permlane32_swap(a0, b0, false, false); auto r1 = __builtin_amdgcn_permlane32_swap(a1, b1, false, false); \
        u32x4 w = {r0[0], r1[0], r0[1], r1[1]}; OUT = *reinterpret_cast<bf16x8*>(&w); } while (0)
            ATT_PK4(p0, 0, pa0); ATT_PK4(p0, 8, pa1);
#undef ATT_PK4
            if (__any(alpha < 1.f)) { if (hi == 0) scr[r32] = alpha; asm volatile("s_waitcnt lgkmcnt(0)" ::: "memory");
#pragma unroll
                for (int r = 0; r < 16; ++r) { const float a = scr[crowc(r) + 4 * hi];
#pragma unroll
                    for (int d = 0; d < 4; ++d) o[d][r] *= a; } }
            const int vb = vb0 + (t & 1) * 16384;
            pv_one<0>(o[0], vb, pa0, pa1); pv_one<1>(o[1], vb, pa0, pa1); pv_one<2>(o[2], vb, pa0, pa1); pv_one<3>(o[3], vb, pa0, pa1);
        }
        float fin;
        if (MODE == 1) { const float sk = extra[h] * LOG2E; const float mf = fmaxf(m_reg, sk); const float a = __builtin_amdgcn_exp2f(m_reg - mf); const float lf = l_reg * a + __builtin_amdgcn_exp2f(sk - mf); fin = a / lf; }
        else fin = 1.0f / l_reg;
        asm volatile("s_waitcnt lgkmcnt(0)" ::: "memory");
        if (hi == 0) scr[r32] = fin;
        asm volatile("s_waitcnt lgkmcnt(0)" ::: "memory");
        if (MODE == 0 && hi == 0) lsebuf[((size_t)pat * M + (size_t)b * SEQ + sq) * 8 + h] = m_reg + __log2f(l_reg);
#pragma unroll
        for (int r = 0; r < 16; ++r) { const int qi = crowc(r) + 4 * hi; const float f = scr[qi];
            int sqi; if (MODE == 2) sqi = (qr0 + 2 * w2 + (qi >> 4)) * 64 + qc0 + (qi & 15); else sqi = ((l0 + 32 * w2 + qi) << shift) + jres;
            const size_t tokq = (size_t)b * SEQ + sqi;
            if (MODE == 0) { _Float16* op = (_Float16*)part + ((size_t)pat * M + tokq) * 1024 + h * HD + r32;
#pragma unroll
                for (int d = 0; d < 4; ++d) op[32 * d] = (_Float16)(o[d][r] * f); }
            else { bf16* op = O + tokq * D + ((MODE == 1) ? 1024 : 0) + h * HD + r32;
#pragma unroll
                for (int d = 0; d < 4; ++d) op[32 * d] = (bf16)f2bf(o[d][r] * f); } }
#undef ATT_STAGE
#undef ATT_KEYTOK
    }
    asm volatile("s_waitcnt vmcnt(0) lgkmcnt(0)" ::: "memory"); __builtin_amdgcn_s_barrier();
}
__device__ __forceinline__ void attn_combine(const Frame& F, const float* part, const float* lsebuf, bf16* O, const int stream) {
    int lane = F.lane; asm volatile("" : "+v"(lane));
    const int gw = F.bid * NWAVES + F.wave, NGW = F.G * NWAVES;
    for (int it = gw; it < MH * 8; it += NGW) {
        const int tok = stream * MH + (it >> 3), h = it & 7;
        const float e0 = lsebuf[((size_t)0 * M + tok) * 8 + h], e1 = lsebuf[((size_t)1 * M + tok) * 8 + h], e2 = lsebuf[((size_t)2 * M + tok) * 8 + h];
        const float mx = fmaxf(e0, fmaxf(e1, e2)); float w0 = __builtin_amdgcn_exp2f(e0 - mx), w1 = __builtin_amdgcn_exp2f(e1 - mx), w2 = __builtin_amdgcn_exp2f(e2 - mx);
        const float inv = 1.0f / (w0 + w1 + w2); w0 *= inv; w1 *= inv; w2 *= inv;
        typedef _Float16 f16x2 __attribute__((ext_vector_type(2)));
        const _Float16* ph = (const _Float16*)part; const size_t off = (size_t)tok * 1024 + h * HD + 2 * lane;
        const f16x2 a = *(const f16x2*)(ph + off), bq = *(const f16x2*)(ph + (size_t)M * 1024 + off), c = *(const f16x2*)(ph + (size_t)2 * M * 1024 + off);
        ((unsigned*)(O + (size_t)tok * D + h * HD))[lane] = pk2(w0 * (float)a.x + w1 * (float)bq.x + w2 * (float)c.x, w0 * (float)a.y + w1 * (float)bq.y + w2 * (float)c.y);
    }
}
}

__global__ void __launch_bounds__(NWAVES * 64, 2) fwd(Args a) {
    extern __shared__ __attribute__((aligned(16))) unsigned char lds[];
    Frame F;
    F.lds = (LAS unsigned char*)lds;
    F.wave = __builtin_amdgcn_readfirstlane((int)threadIdx.x >> 6); F.lane = 0; F.tid = 0;
    F.G = gridDim.x; F.bid = blockIdx.x;
    for (int u = (int)threadIdx.x; u < (LDS_BYTES - LDSCTL_OFF) / 4; u += NWAVES * 64) ((LAS unsigned*)(F.lds + LDSCTL_OFF))[u] = 0u;
    __syncthreads();
    XcdBarrier bar = xcd_barrier_post((unsigned*)(a.ws + WS_CTL) + CW_BAR, (volatile LAS unsigned*)(F.lds + MISC_OFF) + 8, F.wave);
#define PH_ENTER() Frame Fp = F; unsigned char* ws = a.ws; float* xo = a.out; asm volatile("" : "+s"(Fp.bid), "+s"(Fp.wave), "+s"(Fp.G), "+s"(ws), "+s"(xo)); \
    asm volatile("v_mbcnt_lo_u32_b32 %0, -1, 0\n\tv_mbcnt_hi_u32_b32 %0, -1, %0" : "=v"(Fp.lane)); Fp.tid = Fp.wave * 64 + Fp.lane;     \
    bf16* const Hb = (bf16*)(ws + WS_H); bf16* const Ub = (bf16*)(ws + WS_U); bf16* const QKVb = (bf16*)(ws + WS_QKV); bf16* const Ob = (bf16*)(ws + WS_O); float* const Pb = (float*)(ws + WS_PART); float* const Lb = (float*)(ws + WS_LSE); \
    int vc = Fp.bid - off; if (vc < 0) vc += Fp.G; const size_t rowoff = (size_t)s * MH; \
    (void)Hb; (void)Ub; (void)QKVb; (void)Ob; (void)Pb; (void)Lb; (void)xo; (void)vc; (void)rowoff
#define ITEM_BEGIN() for (int s = 0; s < NSTREAM; ++s) { if (T >= NSTREAM) sb_wait(bar, (unsigned*)(a.ws + WS_SB), T - NSTREAM);
#define ITEM_END(nunits) sb_arrive(bar, (unsigned*)(a.ws + WS_SB), T); ++T; off = (off + (nunits)) % F.G; }
    int T = 0, off = 0;
    { const int s = 0; PH_ENTER(); p0_prologue(Fp, a); }
    xcd_barrier(bar);
    for (int layer = 0; layer < DEPTH; ++layer) {
        const bool even = (layer & 1) == 0; const int li = layer >> 1;
        for (int sub = 0; sub < 3; ++sub) {
            const int lf = layer * 2 + (sub == 2 ? 1 : 0);
            const int sb = layer * 3 + sub;
            const int N1 = (sub == 1) ? (even ? AB_IN : C_IN) : 2 * FF;
            ITEM_BEGIN() { PH_ENTER();
                if (sub == 1) {
                    const bf16* W = even ? (const bf16*)(ws + WS_WABIN + (size_t)li * SZ_WABIN) : (const bf16*)(ws + WS_WCIN + (size_t)li * SZ_WCIN);
                    pg8::Gemm g{Hb + rowoff * D, W, MH, N1, D}; pg8::StaticOrder S; S.init(MH, N1, Fp.G, vc);
                    pg8::EpiBf16 E{QKVb + rowoff * N1, N1, (const pg8::ssq_t*)(ws + WS_SSQ) + (size_t)sb * M + rowoff};
                    pg8::gemm_phase<pg8::EpiBf16, pg8::StaticOrder, true, true, 0, RESID_F16 != 0>(Fp.lds + RING_OFF, g, S, E, Fp.tid);
                } else {
                    pg8::Gemm g{Hb + rowoff * D, (const bf16*)(ws + WS_WGU + (size_t)lf * SZ_WGU), MH, 2 * FF, D}; pg8::StaticOrder S; S.init(MH, 2 * FF, Fp.G, vc);
                    pg8::EpiSwiglu E{Ub + rowoff * FF, FF, (const pg8::ssq_t*)(ws + WS_SSQ) + (size_t)sb * M + rowoff};
                    pg8::gemm_phase<pg8::EpiSwiglu, pg8::StaticOrder, true, true, 0, RESID_F16 != 0>(Fp.lds + RING_OFF, g, S, E, Fp.tid);
                }
            } ITEM_END((MH / 256) * (N1 / 256))
            if (sub == 1) {
                if (even) {
                    ITEM_BEGIN() { PH_ENTER(); att::attn_mfma<0>(Fp, QKVb, AB_IN, Ob, Pb, Lb, nullptr, s, vc); } ITEM_END(3072 / NSTREAM / 4)
                    ITEM_BEGIN() { PH_ENTER(); att::attn_mfma<1>(Fp, QKVb, AB_IN, Ob, Pb, Lb, a.ab_sink + li * 8, s, vc); att::attn_combine(Fp, Pb, Lb, Ob, s); } ITEM_END(1024 / NSTREAM / 4)
                } else {
                    ITEM_BEGIN() { PH_ENTER(); att::attn_mfma<2>(Fp, QKVb, C_IN, Ob, Pb, Lb, a.c_rpb + (size_t)li * 16 * 15 * 31, s, vc); } ITEM_END(2048 / NSTREAM / 4)
                }
            }
            ITEM_BEGIN() { PH_ENTER();
                const bf16* A2 = (sub == 1) ? (const bf16*)(Ob + rowoff * D) : (const bf16*)(Ub + rowoff * FF); const int K2 = (sub == 1) ? D : FF;
                const bf16* W2 = (sub == 1) ? (even ? (const bf16*)(ws + WS_WABOUT + (size_t)li * SZ_WOUT) : (const bf16*)(ws + WS_WCOUT + (size_t)li * SZ_WOUT))
                                            : (const bf16*)(ws + WS_WD + (size_t)lf * SZ_WD);
                pg8::Gemm g{A2, W2, MH, D, K2}; pg8::StaticOrder S; S.init(MH, D, Fp.G, vc);
                pg8::EpiResidH E{Hb + rowoff * D, D, (sub == 1) ? 1.0f : 0.5f, Hb + rowoff * D, (pg8::ssq_t*)(ws + WS_SSQ) + (size_t)(sb + 1) * M + rowoff};
                pg8::gemm_phase<pg8::EpiResidH, pg8::StaticOrder, true, true>(Fp.lds + RING_OFF, g, S, E, Fp.tid);
            } ITEM_END((MH / 256) * (D / 256))
        }
    }
    ITEM_BEGIN() { PH_ENTER(); final_norm_h_phase(Fp, Hb, xo, a.final_norm, (const pg8::ssq_t*)(ws + WS_SSQ) + (size_t)12 * M, s); } ITEM_END(0)
#undef PH_ENTER
#undef ITEM_BEGIN
#undef ITEM_END
}

extern "C" void kernel_launch(void* const* d_in, const int* in_sizes, int n_in, void* d_out, int out_size, void* d_ws, size_t ws_size, hipStream_t stream) {
    static int grid = 0;
    if (grid == 0) {
        if (n_in != 13 || in_sizes[0] != M * D || out_size != M * D || ws_size < WS_END) { fprintf(stderr, "kernel_launch: unexpected shapes (n_in %d, in0 %d, out %d, ws %zu, need %zu); nothing launched\n", n_in, n_in > 0 ? in_sizes[0] : -1, out_size, ws_size, (size_t)WS_END); grid = -1; return; }
        int dev = 0, cus = 0, per_cu = 0;
        if (hipGetDevice(&dev) != hipSuccess || hipDeviceGetAttribute(&cus, hipDeviceAttributeMultiprocessorCount, dev) != hipSuccess) { fprintf(stderr, "kernel_launch: device query failed\n"); grid = -1; return; }
        if (hipFuncSetAttribute((const void*)fwd, hipFuncAttributeMaxDynamicSharedMemorySize, LDS_BYTES) != hipSuccess) { fprintf(stderr, "kernel_launch: hipFuncSetAttribute failed\n"); grid = -1; return; }
        if (hipOccupancyMaxActiveBlocksPerMultiprocessor(&per_cu, (const void*)fwd, NWAVES * 64, LDS_BYTES) != hipSuccess || per_cu < 1)
            fprintf(stderr, "kernel_launch: note: occupancy query reports %d workgroups per CU\n", per_cu);
        (void)hipGetLastError();
        grid = cus;
    }
    if (grid < 0) return;
    if (hipMemsetAsync((char*)d_ws + WS_CTL, 0, CTL_ZERO_BYTES, stream) != hipSuccess) { fprintf(stderr, "kernel_launch: memset failed\n"); return; }
    Args a{};
    a.x = (const float*)d_in[0]; a.ffn_norm = (const float*)d_in[1]; a.wg = (const float*)d_in[2]; a.wu = (const float*)d_in[3]; a.wd = (const float*)d_in[4]; a.mix_norm = (const float*)d_in[5];
    a.ab_in = (const float*)d_in[6]; a.ab_out = (const float*)d_in[7]; a.ab_sink = (const float*)d_in[8]; a.c_in = (const float*)d_in[9]; a.c_out = (const float*)d_in[10]; a.c_rpb = (const float*)d_in[11];
    a.final_norm = (const float*)d_in[12]; a.out = (float*)d_out; a.ws = (unsigned char*)d_ws;
    a.ph_lo = 0; a.ph_hi = 0; hipLaunchKernelGGL(fwd, dim3(grid), dim3(NWAVES * 64), LDS_BYTES, stream, a);
    const hipError_t le = hipPeekAtLastError();
    if (le != hipSuccess) fprintf(stderr, "kernel_launch: launch failed: %s\n", hipGetErrorName(le));
}
```

```cpp
#include <hip/hip_runtime.h>
#include <cstdio>
#include <cstdint>

#ifndef PROBE_ABL
#define PROBE_ABL 0
#endif
#ifndef RESID_F16
#define RESID_F16 1
#endif

namespace pg8 {
#define PG8_LAS __attribute__((address_space(3)))
typedef unsigned short bf16_t;
typedef short bf16x8 __attribute__((ext_vector_type(8)));
typedef _Float16 f16x8 __attribute__((ext_vector_type(8)));
typedef _Float16 f16x4 __attribute__((ext_vector_type(4)));
typedef float f32x4 __attribute__((ext_vector_type(4)));
typedef unsigned u32x4 __attribute__((ext_vector_type(4)));
constexpr int BM = 256, BK = 64, HALF = 128, HTB = HALF * BK * 2  , STAGE_BYTES = 8 * HTB, NXCD = 8, WGM = 8;

__host__ __device__ __forceinline__ int lds_byte(int r, int c) { const int st = (r >> 4) * 2 + (c >> 5), rr = r & 15, cc = c & 31, ob = rr * 64 + cc * 2; return st * 1024 + (ob ^ (((ob >> 9) & 1) << 5)); }
__host__ __device__ __forceinline__ void stage_rc(int b, int& R, int& C) { const int st = b / 1024, sb = b % 1024, swz = sb ^ (((sb >> 9) & 1) << 5); R = (st >> 1) * 16 + swz / 64; C = (st & 1) * 32 + (swz % 64) / 2; }
__host__ __device__ __forceinline__ int perm32(int rho) { const int n = rho >> 4, i = rho & 15; return 8 * (i >> 2) + 4 * n + (i & 3); }

struct Unit { int pm, pn; };
struct Gemm { const bf16_t* A; const bf16_t* Bt; int M, N, K; };

struct StaticOrder {
    int nM, nN, nwg, G, c;
    __host__ __device__ void init(int M, int N, int G_, int c_) { nM = M / BM; nN = N / BM; nwg = nM * nN; G = G_; c = c_; }
    __host__ __device__ bool next(int i, Unit& u) const {
        const long L = (long)i * G + c; if (L >= nwg) return false;
        int wgid = (int)L; { const int q = nwg / NXCD, r = nwg % NXCD, xcd = wgid % NXCD, off = wgid / NXCD; wgid = (xcd < r ? xcd * (q + 1) : r * (q + 1) + (xcd - r) * q) + off; }
        const int nig = WGM * nN, gid = wgid / nig, fm = gid * WGM, gsz = (nM - fm) < WGM ? (nM - fm) : WGM;
        u.pm = fm + ((wgid % nig) % gsz); u.pn = (wgid % nig) / gsz; return true;
    }
    __device__ __forceinline__ void a_ready(const Unit&) const {}
    __device__ __forceinline__ void done(const Unit&) const {}
};


__device__ __forceinline__ unsigned cvt_pk_bf16(float lo, float hi) { unsigned r; asm volatile("v_cvt_pk_bf16_f32 %0, %1, %2" : "=v"(r) : "v"(lo), "v"(hi)); return r; }

__device__ __forceinline__ int lane_id_here() { int l; asm volatile("v_mbcnt_lo_u32_b32 %0, -1, 0\n\tv_mbcnt_hi_u32_b32 %0, -1, %0" : "=v"(l)); return l; }
__device__ __forceinline__ float xor_shfl(float v, int mask, int lane) { return __builtin_bit_cast(float, __builtin_amdgcn_ds_bpermute((lane ^ mask) << 2, __builtin_bit_cast(int, v))); }
typedef unsigned long long ssq_t;
__device__ __forceinline__ ssq_t ssq_fix(float s) { const int hi = (int)s; const int lo = (int)((s - (float)hi) * 16777216.0f); return ((ssq_t)(unsigned)hi << 24) + (ssq_t)(unsigned)lo; }
__device__ __forceinline__ float ssq_val(ssq_t v) { return (float)(unsigned)(v >> 24) + (float)(unsigned)(v & 0xFFFFFFull) * (1.0f / 16777216.0f); }
__device__ __forceinline__ float row_rstd(const ssq_t* ssq, int row) { return 1.0f / sqrtf(ssq_val(ssq[row]) * (1.0f / 2048.0f) + 1e-6f); }
struct PreSsq { int dummy_unused; };
__device__ __forceinline__ void pre_ssq_issue(PG8_LAS unsigned char* pl, const ssq_t* ssq, int row0w  , int wave, int lane) {
    const unsigned char* src = (const unsigned char*)(ssq + row0w + (lane >> 5) * HALF) + (lane & 31) * 16;
    __builtin_amdgcn_global_load_lds((const unsigned*)src, (PG8_LAS unsigned*)(pl + wave * 1024), 16, 0, 0);
}
__device__ __forceinline__ void pre_ssq_wait() { asm volatile("s_waitcnt vmcnt(16)" ::: "memory"); }
__device__ __forceinline__ void rows_rstd(const PG8_LAS unsigned char* pl, int wave, int fr, float (&rs)[2][4]) {
#pragma unroll
    for (int ai = 0; ai < 2; ++ai)
#pragma unroll
        for (int m = 0; m < 4; ++m) rs[ai][m] = __builtin_amdgcn_rsqf(ssq_val(*(const PG8_LAS ssq_t*)(pl + wave * 1024 + ai * 512 + (m * 16 + fr) * 8)) * (1.0f / 2048.0f) + 1e-6f);
}
typedef __attribute__((address_space(1))) u32x4 gu32x4;
struct EpiBf16 {
    static constexpr bool PERM = true, AFTER_DRAIN = false, HAS_INIT = false, HAS_PRE = true;
    typedef PreSsq Pre;
    bf16_t* O; int ldc; const ssq_t* ssq; PG8_LAS unsigned char* pl;
    __device__ __forceinline__ void pre_issue(Pre& p, const Unit& u, int wr, int wc, int fr, int fq) const { pre_ssq_issue(pl, ssq, u.pm * BM + wr * 64, wr * 4 + wc, fq * 16 + fr); }
    __device__ __forceinline__ void pre_wait(Pre& p) const { pre_ssq_wait(); }
    __device__ __forceinline__ void operator()(const f32x4 (&acc)[2][2][4][2], const Unit& u, int wr, int wc, int fr, int fq, const Pre& pre) const {
        const int row0 = u.pm * BM + wr * 64 + fr; const int col0 = u.pn * BM + wc * 32 + 8 * fq;
        float rsv[2][4]; rows_rstd(pl, wr * 4 + wc, fr, rsv);
#pragma unroll
        for (int ai = 0; ai < 2; ++ai)
#pragma unroll
            for (int m = 0; m < 4; ++m) { const int row = row0 + ai * HALF + m * 16; const float rs = rsv[ai][m]; bf16_t* rowp = O + (size_t)row * ldc + col0;
#pragma unroll
                for (int bj = 0; bj < 2; ++bj) { const f32x4 v0 = acc[ai][bj][m][0] * rs, v1 = acc[ai][bj][m][1] * rs;
                    u32x4 w; w.x = cvt_pk_bf16(v0[0], v0[1]); w.y = cvt_pk_bf16(v0[2], v0[3]); w.z = cvt_pk_bf16(v1[0], v1[1]); w.w = cvt_pk_bf16(v1[2], v1[3]);
                    *(gu32x4*)(rowp + bj * HALF) = w; } }
    }
};
struct EpiSwiglu {
    static constexpr bool PERM = true, AFTER_DRAIN = false, HAS_INIT = false, HAS_PRE = true;
    typedef PreSsq Pre;
    bf16_t* O; int ldc; const ssq_t* ssq; PG8_LAS unsigned char* pl;
    __device__ __forceinline__ void pre_issue(Pre& p, const Unit& u, int wr, int wc, int fr, int fq) const { pre_ssq_issue(pl, ssq, u.pm * BM + wr * 64, wr * 4 + wc, fq * 16 + fr); }
    __device__ __forceinline__ void pre_wait(Pre& p) const { pre_ssq_wait(); }
    __device__ __forceinline__ void operator()(const f32x4 (&acc)[2][2][4][2], const Unit& u, int wr, int wc, int fr, int fq, const Pre& pre) const {
        const int row0 = u.pm * BM + wr * 64 + fr; const int col0 = u.pn * HALF + wc * 32 + 8 * fq;
        float rsv[2][4]; rows_rstd(pl, wr * 4 + wc, fr, rsv);
#pragma unroll
        for (int ai = 0; ai < 2; ++ai)
#pragma unroll
            for (int m = 0; m < 4; ++m) { const int row = row0 + ai * HALF + m * 16; const float rs = rsv[ai][m]; bf16_t* rowp = O + (size_t)row * ldc + col0;
                float r[8];
                typedef float f32x2 __attribute__((ext_vector_type(2)));
                const f32x2 rsq2 = {rs * rs, rs * rs}, nrs2 = {rs * -1.4426950408889634f, rs * -1.4426950408889634f};
#pragma unroll
                for (int n = 0; n < 2; ++n)
#pragma unroll
                    for (int jp = 0; jp < 2; ++jp) { const f32x4 vg = acc[ai][0][m][n], vu = acc[ai][1][m][n];
                        const f32x2 ag = jp ? __builtin_shufflevector(vg, vg, 2, 3) : __builtin_shufflevector(vg, vg, 0, 1), au = jp ? __builtin_shufflevector(vu, vu, 2, 3) : __builtin_shufflevector(vu, vu, 0, 1);
                        const f32x2 x = ag * nrs2;
                        f32x2 d = {__builtin_amdgcn_exp2f(x.x), __builtin_amdgcn_exp2f(x.y)}; d = d + 1.0f;
                        const f32x2 rc = {__builtin_amdgcn_rcpf(d.x), __builtin_amdgcn_rcpf(d.y)};
                        const f32x2 o = (ag * au) * (rc * rsq2);
                        r[n * 4 + 2 * jp] = o.x; r[n * 4 + 2 * jp + 1] = o.y; }
                u32x4 w; w.x = cvt_pk_bf16(r[0], r[1]); w.y = cvt_pk_bf16(r[2], r[3]); w.z = cvt_pk_bf16(r[4], r[5]); w.w = cvt_pk_bf16(r[6], r[7]);
                *(gu32x4*)rowp = w; }
    }
};
struct EpiResidH {
    static constexpr bool PERM = true, AFTER_DRAIN = false, HAS_INIT = false, HAS_PRE = true;
    struct Pre { f16x8 t[2][2]; };
    const bf16_t* xin; int ldc; float scale; bf16_t* xb; ssq_t* ssq_out;
    __device__ __forceinline__ unsigned lane_off(const Unit& u, int wr, int wc, int fr, int fq) const { return (unsigned)(((u.pm * BM + wr * 64 + fr) * ldc + u.pn * BM + wc * 32 + 8 * fq) * 2); }
    __device__ __forceinline__ void issue_batch(f16x8 (&t)[2][2], unsigned voff, int ai, int mp) const {
        const char* xr = (const char*)xin; asm volatile("" : "+s"(xr));
#pragma unroll
        for (int mm = 0; mm < 2; ++mm) { const char* sb = xr + (size_t)((ai * HALF + (2 * mp + mm) * 16) * ldc) * 2;
            asm volatile("global_load_dwordx4 %0, %1, %2" : "=v"(t[mm][0]) : "v"(voff), "s"(sb));
            asm volatile("global_load_dwordx4 %0, %1, %2 offset:256" : "=v"(t[mm][1]) : "v"(voff), "s"(sb)); }
    }
    __device__ __forceinline__ void pre_issue(Pre& p, const Unit& u, int wr, int wc, int fr, int fq) const { issue_batch(p.t, lane_off(u, wr, wc, fr, fq), 0, 0); }
    __device__ __forceinline__ void pre_wait(Pre& p) const { asm volatile("s_waitcnt vmcnt(16)" : "+v"(p.t[0][0]), "+v"(p.t[0][1]), "+v"(p.t[1][0]), "+v"(p.t[1][1]) :: "memory"); }
    __device__ __forceinline__ void batch(f32x4 (&acc)[2][2][4][2], const f16x8 (&t)[2][2], int ai, int mp, int row0, int col0, int fq, ssq_t (&olds)[8], float sc, bf16_t* xb, ssq_t* ssq_out) const {
        typedef __attribute__((address_space(1))) f16x8 gf16x8;
#pragma unroll
        for (int mm = 0; mm < 2; ++mm) { const int m = 2 * mp + mm, row = row0 + ai * HALF + m * 16; const size_t off = (size_t)row * ldc + col0; float s = 0.f;
#pragma unroll
            for (int bj = 0; bj < 2; ++bj) { const f16x8 b8 = t[mm][bj];
                const f32x4 y0 = __builtin_convertvector(__builtin_shufflevector(b8, b8, 0, 1, 2, 3), f32x4) + acc[ai][bj][m][0] * sc, y1 = __builtin_convertvector(__builtin_shufflevector(b8, b8, 4, 5, 6, 7), f32x4) + acc[ai][bj][m][1] * sc;
                const f16x4 h0 = __builtin_convertvector(y0, f16x4), h1 = __builtin_convertvector(y1, f16x4);
                *(gf16x8*)(xb + off + bj * HALF) = __builtin_shufflevector(h0, h1, 0, 1, 2, 3, 4, 5, 6, 7);
                const f32x4 z0 = __builtin_convertvector(h0, f32x4), z1 = __builtin_convertvector(h1, f32x4);
                s += ((z0[0] * z0[0] + z0[1] * z0[1]) + (z0[2] * z0[2] + z0[3] * z0[3])) + ((z1[0] * z1[0] + z1[1] * z1[1]) + (z1[2] * z1[2] + z1[3] * z1[3])); }
            { const int ln_ = lane_id_here(); s += xor_shfl(s, 16, ln_); s += xor_shfl(s, 32, ln_); }
            olds[ai * 4 + m] = 0;
            if (fq == 0) olds[ai * 4 + m] = __hip_atomic_fetch_add((__attribute__((address_space(1))) ssq_t*)(ssq_out + row), ssq_fix(s), __ATOMIC_RELAXED, __HIP_MEMORY_SCOPE_AGENT); }
    }
#define EPI_WAITB(n, t) asm volatile("s_waitcnt vmcnt(" #n ")" : "+v"(t[0][0]), "+v"(t[0][1]), "+v"(t[1][0]), "+v"(t[1][1]) :: "memory")
    __device__ __forceinline__ void operator()(f32x4 (&acc)[2][2][4][2], const Unit& u, int wr, int wc, int fr, int fq, const Pre& pre) const {
        const int row0 = u.pm * BM + wr * 64 + fr, col0 = u.pn * BM + wc * 32 + 8 * fq;
        const unsigned voff = lane_off(u, wr, wc, fr, fq);
        f16x8 t1[2][2], t2[2][2], t3[2][2];
        issue_batch(t1, voff, 0, 1); issue_batch(t2, voff, 1, 0); issue_batch(t3, voff, 1, 1);
        ssq_t olds[8];
        float sc = scale; bf16_t* xo = xb; ssq_t* so = ssq_out; asm volatile("" : "+s"(sc), "+s"(xo), "+s"(so));
        batch(acc, pre.t, 0, 0, row0, col0, fq, olds, sc, xo, so);
        EPI_WAITB(12, t1);
        batch(acc, t1, 0, 1, row0, col0, fq, olds, sc, xo, so);
        EPI_WAITB(12, t2);
        batch(acc, t2, 1, 0, row0, col0, fq, olds, sc, xo, so);
        EPI_WAITB(12, t3);
        batch(acc, t3, 1, 1, row0, col0, fq, olds, sc, xo, so);
#pragma unroll
        for (int i = 0; i < 8; ++i) asm volatile("" :: "v"(olds[i]));
    }
#undef EPI_WAITB
};

template <class Epi, class Sched, bool ALIGN_EPI = false, bool SP2 = false, int ABL = 0  , bool F16 = false  >
__device__ __forceinline__ void gemm_phase(PG8_LAS unsigned char* lds, const Gemm g, const Sched& S, const Epi& E, int tid_in) {
    int tid_ = tid_in; asm volatile("" : "+v"(tid_));
    const int tid = tid_, wid = __builtin_amdgcn_readfirstlane(tid >> 6), lane = tid & 63, wr = wid >> 2, wc = wid & 3, fr = lane & 15, fq = lane >> 4;
    const int K = g.K, nt = K / BK;
    unsigned voffA[2], voffB[2];
#pragma unroll
    for (int i = 0; i < 2; ++i) { const int R = 8 * (wid + 8 * i) + (lane >> 3), C = (((lane & 7) ^ ((R >> 1) & 7)) << 3); const int Rb = Epi::PERM ? ((R & ~31) + perm32(R & 31)) : R;
        voffA[i] = (unsigned)(R * K + C) * 2u; voffB[i] = (unsigned)(Rb * K + C) * 2u; }
    const unsigned kstep = (unsigned)(BK * 2);
    const unsigned hstep = (unsigned)HALF * (unsigned)K * 2u;
    const unsigned tstep = 2u * hstep;
    const __amdgpu_buffer_rsrc_t rA = __builtin_amdgcn_make_buffer_rsrc((void*)g.A, 0, 0x7ffffff0, 0x00020000), rB = __builtin_amdgcn_make_buffer_rsrc((void*)g.Bt, 0, 0x7ffffff0, 0x00020000);
    const unsigned ldsw = (unsigned)wid * 1024u;
    const int arow = wr * 64 + fr, brow = wc * 32 + fr;
    const int aoff0 = arow * 128 + ((fq ^ ((arow >> 1) & 7)) << 4), aoff1 = aoff0 ^ 64, boff0 = brow * 128 + ((fq ^ ((brow >> 1) & 7)) << 4), boff1 = boff0 ^ 64;
#define PG8_SA(b, h) (((b) * 2 + (h)) * HTB)
#define PG8_SB(b, h) ((4 + (b) * 2 + (h)) * HTB)
#define PG8_STAGE(bufoff, rsrc, goff, voff) do { if (ABL != 2) _Pragma("unroll") for (int _i = 0; _i < 2; ++_i) \
        __builtin_amdgcn_raw_ptr_buffer_load_lds(rsrc, (PG8_LAS void*)(lds + (bufoff) + ldsw + _i * 8192), 16, (voff)[_i], (int)(goff), 0, 0); } while (0)
#define PG8_LDA(dst, b, h) do { if (ABL != 3) _Pragma("unroll") for (int m = 0; m < 4; ++m) { dst[m][0] = *(const PG8_LAS bf16x8*)(lds + PG8_SA(b, h) + aoff0 + m * 2048); dst[m][1] = *(const PG8_LAS bf16x8*)(lds + PG8_SA(b, h) + aoff1 + m * 2048); } } while (0)
#define PG8_LDB(dst, b, h) do { if (ABL != 3) _Pragma("unroll") for (int n = 0; n < 2; ++n) { dst[n][0] = *(const PG8_LAS bf16x8*)(lds + PG8_SB(b, h) + boff0 + n * 2048); dst[n][1] = *(const PG8_LAS bf16x8*)(lds + PG8_SB(b, h) + boff1 + n * 2048); } } while (0)
#define PG8_MMA(ai, bj, At, Bt) do { __builtin_amdgcn_s_setprio(1); _Pragma("unroll") for (int m = 0; m < 4; ++m) _Pragma("unroll") for (int n = 0; n < 2; ++n) _Pragma("unroll") for (int k = 0; k < 2; ++k) { \
        if (ABL == 5) { if (((m & 1) == 0)) acc32[((ai) * 2 + (bj)) * 2 + (m >> 1)] = __builtin_amdgcn_mfma_f32_32x32x16_bf16(Bt[n][k], At[m][k], acc32[((ai) * 2 + (bj)) * 2 + (m >> 1)], 0, 0, 0); else asm volatile("" :: "v"(Bt[n][k]), "v"(At[m][k])); } \
        else if (ABL != 1) { if (F16) acc[ai][bj][m][n] = __builtin_amdgcn_mfma_f32_16x16x32_f16(__builtin_bit_cast(f16x8, Bt[n][k]), __builtin_bit_cast(f16x8, At[m][k]), acc[ai][bj][m][n], 0, 0, 0); \
            else acc[ai][bj][m][n] = __builtin_amdgcn_mfma_f32_16x16x32_bf16(Bt[n][k], At[m][k], acc[ai][bj][m][n], 0, 0, 0); } else asm volatile("" :: "v"(Bt[n][k]), "v"(At[m][k])); } __builtin_amdgcn_s_setprio(0); } while (0)
#define PG8_WAIT_V(n) asm volatile("s_waitcnt vmcnt(" #n ")" ::: "memory")
#define PG8_WAIT_L(n) asm volatile("s_waitcnt lgkmcnt(" #n ")" ::: "memory")
#define PG8_BAR __builtin_amdgcn_s_barrier()
#define PG8_SCHED __builtin_amdgcn_sched_barrier(0)
    Unit cur, nxt; int ui = 0;
    if (!S.next(0, cur)) return;
    f32x4 acc[2][2][4][2];
    if constexpr (Epi::HAS_INIT) E.init(acc, cur, wr, wc, fr, fq);
    else {
    bf16x8 z8 = {0, 0, 0, 0, 0, 0, 0, 0};
#pragma unroll
    for (int a = 0; a < 2; ++a)
#pragma unroll
        for (int b = 0; b < 2; ++b)
#pragma unroll
            for (int m = 0; m < 4; ++m)
#pragma unroll
                for (int n = 0; n < 2; ++n) { asm volatile("" : "+v"(z8)); acc[a][b][m][n] = __builtin_amdgcn_mfma_f32_16x16x32_bf16(z8, z8, (f32x4){0.f, 0.f, 0.f, 0.f}, 0, 0, 0); }
    }
    bf16x8 At[4][2], B0[2][2], B1[2][2];
    typename Epi::Pre pre = {};
    typedef float f32x16_t __attribute__((ext_vector_type(16))); f32x16_t acc32[8];
    if (ABL == 5) { _Pragma("unroll") for (int i = 0; i < 8; ++i) _Pragma("unroll") for (int r = 0; r < 16; ++r) acc32[i][r] = 0.f; }
    if (ABL == 3) { _Pragma("unroll") for (int m = 0; m < 4; ++m) _Pragma("unroll") for (int k = 0; k < 2; ++k) At[m][k] = (bf16x8){1, 2, 3, 4, 5, 6, 7, 8}; _Pragma("unroll") for (int n = 0; n < 2; ++n) _Pragma("unroll") for (int k = 0; k < 2; ++k) { B0[n][k] = (bf16x8){8, 7, 6, 5, 4, 3, 2, 1}; B1[n][k] = (bf16x8){1, 1, 2, 2, 3, 3, 4, 4}; } }
    unsigned cA = (unsigned)cur.pm * tstep, cB = (unsigned)cur.pn * tstep;
    S.a_ready(cur);
    if constexpr (SP2) {
        PG8_STAGE(PG8_SB(0, 0), rB, cB, voffB); PG8_STAGE(PG8_SB(0, 1), rB, cB + hstep, voffB); PG8_STAGE(PG8_SA(0, 0), rA, cA, voffA); PG8_STAGE(PG8_SA(0, 1), rA, cA + hstep, voffA);
        if (wr == 1) PG8_BAR;
        PG8_WAIT_V(2); PG8_BAR;
        PG8_STAGE(PG8_SB(1, 0), rB, cB + kstep, voffB); PG8_STAGE(PG8_SA(1, 0), rA, cA + kstep, voffA); PG8_STAGE(PG8_SB(1, 1), rB, cB + hstep + kstep, voffB);
        PG8_WAIT_V(6); PG8_BAR;
    } else {
        PG8_STAGE(PG8_SB(0, 0), rB, cB, voffB); PG8_STAGE(PG8_SA(0, 0), rA, cA, voffA); PG8_STAGE(PG8_SB(0, 1), rB, cB + hstep, voffB); PG8_STAGE(PG8_SA(0, 1), rA, cA + hstep, voffA);
        if (wr == 1) PG8_BAR;
        PG8_WAIT_V(4); PG8_BAR;
        PG8_STAGE(PG8_SB(1, 0), rB, cB + kstep, voffB); PG8_STAGE(PG8_SA(1, 0), rA, cA + kstep, voffA); PG8_STAGE(PG8_SB(1, 1), rB, cB + hstep + kstep, voffB);
        PG8_WAIT_V(6); PG8_BAR;
    }
    for (;;) {
        const bool has_next = S.next(ui + 1, nxt);
        const unsigned nA = has_next ? (unsigned)nxt.pm * tstep : cA, nB = has_next ? (unsigned)nxt.pn * tstep : cB;
        for (int t = 0; t < nt; t += 2) {
            const bool last = (t == nt - 2);
            const unsigned a1 = cA + (unsigned)(t + 1) * kstep;
            const unsigned a2 = last ? nA : cA + (unsigned)(t + 2) * kstep, b2 = last ? nB : cB + (unsigned)(t + 2) * kstep;
            const unsigned a3 = a2 + kstep, b3 = b2 + kstep;
            if (last && has_next) S.a_ready(nxt);
            if constexpr (Epi::HAS_PRE) { if (last) E.pre_issue(pre, cur, wr, wc, fr, fq); }
            if constexpr (SP2) {
            PG8_LDB(B0, 0, 0); PG8_LDB(B1, 0, 1); PG8_SCHED; PG8_LDA(At, 0, 0); PG8_STAGE(PG8_SA(1, 1), rA, a1 + hstep, voffA);
            PG8_WAIT_V(8); PG8_WAIT_L(0); PG8_BAR; PG8_MMA(0, 0, At, B0); PG8_MMA(0, 1, At, B1); PG8_BAR; PG8_SCHED;
            PG8_LDA(At, 0, 1); PG8_STAGE(PG8_SB(0, 0), rB, b2, voffB); PG8_STAGE(PG8_SB(0, 1), rB, b2 + hstep, voffB); PG8_STAGE(PG8_SA(0, 0), rA, a2, voffA);
            PG8_WAIT_V(8); PG8_WAIT_L(0); PG8_BAR; PG8_MMA(1, 0, At, B0); PG8_MMA(1, 1, At, B1); PG8_BAR; PG8_SCHED;
            PG8_LDB(B0, 1, 0); PG8_LDB(B1, 1, 1); PG8_SCHED; PG8_LDA(At, 1, 0); PG8_STAGE(PG8_SA(0, 1), rA, a2 + hstep, voffA);
            PG8_WAIT_V(8); PG8_WAIT_L(0); PG8_BAR; PG8_MMA(0, 0, At, B0); PG8_MMA(0, 1, At, B1); PG8_BAR; PG8_SCHED;
            PG8_LDA(At, 1, 1); PG8_STAGE(PG8_SB(1, 0), rB, b3, voffB); PG8_STAGE(PG8_SB(1, 1), rB, b3 + hstep, voffB); PG8_STAGE(PG8_SA(1, 0), rA, a3, voffA);
            PG8_WAIT_V(8); PG8_WAIT_L(0); PG8_BAR; PG8_MMA(1, 0, At, B0); PG8_MMA(1, 1, At, B1); PG8_BAR; PG8_SCHED;
            } else {
            PG8_LDB(B0, 0, 0); PG8_SCHED; PG8_LDA(At, 0, 0); PG8_STAGE(PG8_SA(1, 1), rA, a1 + hstep, voffA);
            PG8_WAIT_L(8); PG8_BAR; PG8_WAIT_L(0); PG8_MMA(0, 0, At, B0); PG8_BAR; PG8_SCHED;
            PG8_LDB(B1, 0, 1); PG8_STAGE(PG8_SB(0, 0), rB, b2, voffB);
            PG8_BAR; PG8_WAIT_L(0); PG8_MMA(0, 1, At, B1); PG8_BAR;
            PG8_LDA(At, 0, 1); PG8_STAGE(PG8_SA(0, 0), rA, a2, voffA);
            PG8_BAR; PG8_WAIT_L(0); PG8_MMA(1, 0, At, B0); PG8_BAR; PG8_SCHED;
            PG8_STAGE(PG8_SB(0, 1), rB, b2 + hstep, voffB);
            PG8_WAIT_V(6); PG8_BAR; PG8_MMA(1, 1, At, B1); PG8_BAR;
            PG8_LDB(B0, 1, 0); PG8_SCHED; PG8_LDA(At, 1, 0); PG8_STAGE(PG8_SA(0, 1), rA, a2 + hstep, voffA);
            PG8_WAIT_L(8); PG8_BAR; PG8_WAIT_L(0); PG8_MMA(0, 0, At, B0); PG8_BAR; PG8_SCHED;
            PG8_LDB(B1, 1, 1); PG8_STAGE(PG8_SB(1, 0), rB, b3, voffB);
            PG8_BAR; PG8_WAIT_L(0); PG8_MMA(0, 1, At, B1); PG8_BAR;
            PG8_LDA(At, 1, 1); PG8_STAGE(PG8_SA(1, 0), rA, a3, voffA);
            PG8_BAR; PG8_WAIT_L(0); PG8_MMA(1, 0, At, B0); PG8_BAR; PG8_SCHED;
            PG8_STAGE(PG8_SB(1, 1), rB, b3 + hstep, voffB);
            PG8_WAIT_V(6); PG8_BAR; PG8_MMA(1, 1, At, B1); PG8_BAR;
            }
        }
        if constexpr (ALIGN_EPI) { if (wr == 0) PG8_BAR; }
        if constexpr (!Epi::AFTER_DRAIN) { if constexpr (Epi::HAS_PRE) { E.pre_wait(pre); E(acc, cur, wr, wc, fr, fq, pre); } else E(acc, cur, wr, wc, fr, fq); S.done(cur); }
        if (!has_next) break;
        if constexpr (Epi::HAS_INIT) E.init(acc, nxt, wr, wc, fr, fq);
        else {
        bf16x8 z8 = {0, 0, 0, 0, 0, 0, 0, 0}; asm volatile("" : "+v"(z8));
#pragma unroll
        for (int a = 0; a < 2; ++a)
#pragma unroll
            for (int b = 0; b < 2; ++b)
#pragma unroll
                for (int m = 0; m < 4; ++m)
#pragma unroll
                    for (int n = 0; n < 2; ++n) { asm volatile("" : "+v"(z8));
                        acc[a][b][m][n] = __builtin_amdgcn_mfma_f32_16x16x32_bf16(z8, z8, (f32x4){0.f, 0.f, 0.f, 0.f}, 0, 0, 0); }
        }
        cur = nxt; cA = nA; cB = nB; ++ui;
        if constexpr (ALIGN_EPI) { if (wr == 1) PG8_BAR; }
    }
    PG8_WAIT_V(0);
    if constexpr (!ALIGN_EPI) { if (wr == 0) PG8_BAR; }
    PG8_BAR;
    if constexpr (Epi::AFTER_DRAIN) { E.fused(acc, cur, wr, wc, fr, fq, lds, wid, lane); S.done(cur); }
    if (ABL == 5) { _Pragma("unroll") for (int i = 0; i < 8; ++i) asm volatile("" :: "v"(acc32[i])); }
#undef PG8_SA
#undef PG8_SB
#undef PG8_STAGE
#undef PG8_LDA
#undef PG8_LDB
#undef PG8_MMA
#undef PG8_WAIT_V
#undef PG8_WAIT_L
#undef PG8_BAR
#undef PG8_SCHED
}
}

constexpr int NWAVES = 8;
constexpr int D = 2048, BATCH = 4, SEQ = 2048, DEPTH = 4, HD = 128, FF = 5632;
constexpr int M = BATCH * SEQ;
constexpr int AB_IN = 4608, C_IN = 6144;
constexpr float RMS_EPS = 1e-6f;
constexpr float QK_SCALE = 0.08838834764831845f;

constexpr size_t MiB = 1u << 20;
constexpr size_t WS_CTL = 0, CTL_ZERO_BYTES = 1 * MiB;
constexpr size_t SZ_WGU = (size_t)2 * FF * D * 2, SZ_WD = (size_t)D * FF * 2, SZ_WABIN = (size_t)AB_IN * D * 2, SZ_WOUT = (size_t)D * D * 2, SZ_WCIN = (size_t)C_IN * D * 2;
constexpr size_t WS_WGU = 2 * MiB;
constexpr size_t WS_WD = WS_WGU + 8 * SZ_WGU;
constexpr size_t WS_WABIN = WS_WD + 8 * SZ_WD;
constexpr size_t WS_WABOUT = WS_WABIN + 2 * SZ_WABIN;
constexpr size_t WS_WCIN = WS_WABOUT + 2 * SZ_WOUT;
constexpr size_t WS_WCOUT = WS_WCIN + 2 * SZ_WCIN;
constexpr size_t WS_H = WS_WCOUT + 2 * SZ_WOUT;
constexpr size_t WS_U = WS_H + (size_t)M * D * 2;
constexpr size_t WS_QKV = WS_U + (size_t)M * FF * 2;
constexpr size_t WS_O = WS_QKV + (size_t)M * C_IN * 2;
constexpr size_t WS_PART = WS_O + (size_t)M * D * 2;
constexpr size_t WS_LSE = WS_PART + (size_t)3 * M * 1024 * 4;
constexpr size_t WS_END = WS_LSE + (size_t)3 * M * 8 * 4;
constexpr int CW_BAR = 4096;
constexpr size_t WS_SSQ = 65536;
constexpr size_t WS_SB = 917504;
static_assert(WS_SB >= WS_SSQ + (size_t)13 * 8192 * 8 && WS_SB + 128 * 17 * 32 <= CTL_ZERO_BYTES, "token-barrier counters inside the memset region");
#ifndef NSTREAMS
#define NSTREAMS 2
#endif
constexpr int NSTREAM = NSTREAMS, MH = M / NSTREAM;
static_assert(WS_SSQ + (size_t)13 * 8192 * 8 <= CTL_ZERO_BYTES, "ssq slots inside the memset region");

constexpr int RING_OFF = 0, RING_BYTES = 131072;
constexpr int LDSCTL_OFF = RING_BYTES, MISC_OFF = LDSCTL_OFF + 320;
constexpr int LDS_BYTES = 147456;
static_assert(MISC_OFF + 128 <= LDS_BYTES, "LDS map");

#define GAS __attribute__((address_space(1)))
#define LAS __attribute__((address_space(3)))
typedef unsigned short bf16;
typedef unsigned v4u __attribute__((ext_vector_type(4)));
typedef unsigned v2u __attribute__((ext_vector_type(2)));
typedef float f32x4 __attribute__((ext_vector_type(4)));
typedef GAS unsigned gu32;
#define RLX_AGENT __ATOMIC_RELAXED, __HIP_MEMORY_SCOPE_AGENT
#define LDS_WAIT() asm volatile("s_waitcnt lgkmcnt(0)" ::: "memory")
#define VM_WAIT() asm volatile("s_waitcnt vmcnt(0)" ::: "memory")
__device__ __forceinline__ unsigned f2bf(float f) { unsigned u = __builtin_bit_cast(unsigned, f); return (u + 0x7fffu + ((u >> 16) & 1u)) >> 16; }
__device__ __forceinline__ unsigned pk2(float lo, float hi) { return f2bf(lo) | (f2bf(hi) << 16); }
typedef _Float16 h2_t __attribute__((ext_vector_type(2))); typedef float f2_t __attribute__((ext_vector_type(2))); typedef _Float16 h4_t __attribute__((ext_vector_type(4)));
__device__ __forceinline__ unsigned pkh2(float lo, float hi) { const f2_t v = {lo, hi}; return __builtin_bit_cast(unsigned, __builtin_convertvector(v, h2_t)); }
__device__ __forceinline__ float bflo(unsigned w) { return __builtin_bit_cast(float, w << 16); }
__device__ __forceinline__ float bfhi(unsigned w) { return __builtin_bit_cast(float, w & 0xffff0000u); }

#define XB_TMO      128
#define XB_XCNT(j)  (256  + 64 * (j))
#define XB_XSUB(j)  (1280 + 64 * (j))
#define XB_XGEN(j)  (2304 + 64 * (j))
#define XB_TOP      3328
#define XB_TOPGEN   3392
#define XCD_BAR_WORDS 3456
#define XB_SPIN_CAP (1u << 18)

__device__ __forceinline__ unsigned xb_ld(unsigned* p)              { return __hip_atomic_load(p, __ATOMIC_RELAXED, __HIP_MEMORY_SCOPE_AGENT); }
__device__ __forceinline__ unsigned xb_add(unsigned* p, unsigned v) { return __hip_atomic_fetch_add(p, v, __ATOMIC_RELAXED, __HIP_MEMORY_SCOPE_AGENT); }
__device__ __forceinline__ unsigned xb_xcc_id() { return (unsigned)__builtin_amdgcn_s_getreg((3 << 11) | 20) & 0xFu; }
#define XB_SPIN(cond, bar) do { unsigned _sp = 0; while (cond) { __builtin_amdgcn_s_sleep(1); \
    if ((++_sp & 255u) == 0u) { if (xb_ld(&(bar)[XB_TMO])) break; if (_sp > XB_SPIN_CAP) { atomicAdd(&(bar)[XB_TMO], 1u); break; } } } } while (0)

struct XcdBarrier {
    int wv;
    unsigned* bar; unsigned x;
    volatile LAS unsigned* st;
};

__device__ __forceinline__ int xb_lane() { int l; asm volatile("v_mbcnt_lo_u32_b32 %0, -1, 0\n\tv_mbcnt_hi_u32_b32 %0, -1, %0" : "=v"(l)); return l; }
__device__ __forceinline__ XcdBarrier xcd_barrier_post(unsigned* bar, volatile LAS unsigned* st, int wv) {
    XcdBarrier b; b.wv = wv; b.bar = bar; b.x = xb_xcc_id(); b.st = st;
    if (wv == 0 && xb_lane() == 0) (void)xb_add(&bar[XB_XCNT(b.x)], 1u);
    return b;
}
__device__ __forceinline__ void xcd_barrier_complete(unsigned* bar, unsigned x, unsigned& nloc, unsigned& nx) {
    const unsigned G = gridDim.x * gridDim.y * gridDim.z;
    unsigned sum, cnt, mine, sp = 0u;
    for (;;) {
        sum = 0u; cnt = 0u; mine = 0u;
#pragma unroll
        for (unsigned j = 0; j < 16; ++j) { const unsigned c = xb_ld(&bar[XB_XCNT(j)]); sum += c; cnt += (c > 0u) ? 1u : 0u; mine = (j == x) ? c : mine; }
        if (sum == G) break;
        __builtin_amdgcn_s_sleep(1);
        if ((++sp & 255u) == 0u) { if (xb_ld(&bar[XB_TMO])) break; if (sp > XB_SPIN_CAP) { atomicAdd(&bar[XB_TMO], 1u); break; } }
    }
    nloc = mine > 0u ? mine : 1u; nx = cnt > 0u ? cnt : 1u;
}

__device__ __forceinline__ void xcd_barrier(const XcdBarrier& b) {
    asm volatile("s_waitcnt vmcnt(0)" ::: "memory");
    __syncthreads();
    if (b.wv == 0 && xb_lane() == 0) {
        unsigned* bar = b.bar; unsigned bx = b.x; asm volatile("" : "+s"(bar), "+s"(bx));
        __builtin_amdgcn_s_waitcnt(0);
        unsigned nloc = b.st[0], nx = b.st[1];
        if (nloc == 0u) { xcd_barrier_complete(bar, bx, nloc, nx); b.st[0] = nloc; b.st[1] = nx; }
        const unsigned old = xb_add(&bar[XB_XSUB(bx)], 1u);
        const unsigned gen = old / nloc;
        if (old + 1u == (gen + 1u) * nloc) {
            __builtin_amdgcn_fence(__ATOMIC_RELEASE, "agent");
            asm volatile("s_waitcnt vmcnt(0)" ::: "memory");
            const unsigned og = xb_add(&bar[XB_TOP], 1u);
            const unsigned tg = og / nx;
            if (og + 1u == (tg + 1u) * nx) xb_add(&bar[XB_TOPGEN], 1u);
            else XB_SPIN(xb_ld(&bar[XB_TOPGEN]) == tg, bar);
            __builtin_amdgcn_fence(__ATOMIC_ACQUIRE, "agent");
            xb_add(&bar[XB_XGEN(bx)], 1u);
            asm volatile("s_waitcnt vmcnt(0)" ::: "memory");
        } else {
            XB_SPIN(xb_ld(&bar[XB_XGEN(bx)]) == gen, bar);
            __builtin_amdgcn_fence(__ATOMIC_ACQUIRE, "agent");
            asm volatile("s_waitcnt vmcnt(0)" ::: "memory");
        }
    }
    __syncthreads();
}

#define SB_TOKEN_WORDS (17 * 8)
__device__ __forceinline__ void sb_arrive(const XcdBarrier& b, unsigned* sb, int T) {
    asm volatile("s_waitcnt vmcnt(0)" ::: "memory");
    __syncthreads();
    if (b.wv == 0 && xb_lane() == 0) {
        unsigned* base = sb + (size_t)T * SB_TOKEN_WORDS; unsigned bx = b.x; asm volatile("" : "+s"(base), "+s"(bx));
        __builtin_amdgcn_s_waitcnt(0);
        const unsigned nloc = b.st[0];
        const unsigned old = xb_add(&base[8 * bx], 1u);
        if (old + 1u == nloc) {
            __builtin_amdgcn_fence(__ATOMIC_RELEASE, "agent");
            asm volatile("s_waitcnt vmcnt(0)" ::: "memory");
            xb_add(&base[8 * 16], 1u);
        }
    }
}
__device__ __forceinline__ void sb_wait(const XcdBarrier& b, unsigned* sb, int T) {
    if (b.wv == 0 && xb_lane() == 0) {
        unsigned* base = sb + (size_t)T * SB_TOKEN_WORDS; asm volatile("" : "+s"(base));
        const unsigned nx = b.st[1];
        XB_SPIN(xb_ld(&base[8 * 16]) < nx, b.bar);
        __builtin_amdgcn_fence(__ATOMIC_ACQUIRE, "agent");
        asm volatile("s_waitcnt vmcnt(0)" ::: "memory");
    }
    __syncthreads();
}

struct Frame {
    LAS unsigned char* lds;
    int tid, lane, wave;
    int G, bid;
};
__device__ __forceinline__ float wave_sum(float v) {
    const int ln_ = pg8::lane_id_here();
#pragma unroll
    for (int o = 1; o < 64; o <<= 1) v += pg8::xor_shfl(v, o, ln_);
    return v;
}
__device__ __forceinline__ float wave_max(float v) {
    const int ln_ = pg8::lane_id_here();
#pragma unroll
    for (int o = 1; o < 64; o <<= 1) v = fmaxf(v, pg8::xor_shfl(v, o, ln_));
    return v;
}
template <bool GAIN>
__device__ __forceinline__ void p0_transpose_item(const float* W, int K, int N, bf16* WT, int k0, int n0, int drow0, LAS float* scr, int lane, const float* gain) {
    const int c = lane & 7;
    f32x4 ga = {1.f, 1.f, 1.f, 1.f}, gb = {1.f, 1.f, 1.f, 1.f};
    if (GAIN) { ga = *(const GAS f32x4*)(gain + k0 + 8 * c); gb = *(const GAS f32x4*)(gain + k0 + 8 * c + 4); }
#pragma unroll 8
    for (int i = 0; i < 32; ++i) { const int kk = 2 * i + (lane >> 5); scr[kk * 33 + (lane & 31)] = __builtin_nontemporal_load(W + (size_t)(k0 + kk) * N + n0 + (lane & 31)); }
    LDS_WAIT(); asm volatile("" ::: "memory");
#pragma unroll
    for (int j = 0; j < 4; ++j) { const int n = (lane >> 3) + 8 * j; const LAS float* s = scr + (8 * c) * 33 + n;
        v4u o;
        if (GAIN && RESID_F16) { o.x = pkh2(s[0 * 33] * ga.x, s[1 * 33] * ga.y); o.y = pkh2(s[2 * 33] * ga.z, s[3 * 33] * ga.w); o.z = pkh2(s[4 * 33] * gb.x, s[5 * 33] * gb.y); o.w = pkh2(s[6 * 33] * gb.z, s[7 * 33] * gb.w); }
        else { o.x = pk2(s[0 * 33] * ga.x, s[1 * 33] * ga.y); o.y = pk2(s[2 * 33] * ga.z, s[3 * 33] * ga.w); o.z = pk2(s[4 * 33] * gb.x, s[5 * 33] * gb.y); o.w = pk2(s[6 * 33] * gb.z, s[7 * 33] * gb.w); }
        __builtin_nontemporal_store(o, (GAS v4u*)(WT + (size_t)(drow0 + n) * K + k0 + 8 * c)); }
    LDS_WAIT(); asm volatile("" ::: "memory");
}
struct Args {
    const float* x; const float* ffn_norm; const float* wg; const float* wu; const float* wd; const float* mix_norm;
    const float* ab_in; const float* ab_out; const float* ab_sink; const float* c_in; const float* c_out; const float* c_rpb; const float* final_norm;
    float* out; unsigned char* ws; int ph_lo, ph_hi;
};
static_assert(sizeof(Args) == 15 * 8 + 8, "Args has no padding");

constexpr int CV_NSLOT = 11, CV_MAXR = 1;
__device__ const int CV_TAB[CV_NSLOT][CV_MAXR][2] = {
    {{0, 164864}},
    {{0, 0}},
    {{0, 0}},
    {{0, 0}},
    {{0, 0}},
    {{0, 0}},
    {{0, 0}},
    {{0, 0}},
    {{0, 0}},
    {{0, 0}},
    {{0, 0}},
};

constexpr int CV_I_GU = (D / 64) * (FF / 32), CV_I_D = (FF / 64) * (D / 32), CV_I_ABIN = (D / 64) * (AB_IN / 32), CV_I_OUT = (D / 64) * (D / 32), CV_I_CIN = (D / 64) * (C_IN / 32);
constexpr int CV_EVEN = 2 * CV_I_GU + CV_I_D + CV_I_ABIN + CV_I_OUT + 2 * CV_I_GU + CV_I_D, CV_ODD = CV_EVEN - CV_I_ABIN + CV_I_CIN;
static_assert(2 * (CV_EVEN + CV_ODD) == 164864, "item count");
__device__ __forceinline__ void cv_item(const Args& a, unsigned char* ws, int it, LAS float* scr, int lane) {
    const int pr = it / (CV_EVEN + CV_ODD); int r = it - pr * (CV_EVEN + CV_ODD); int layer = 2 * pr; if (r >= CV_EVEN) { r -= CV_EVEN; ++layer; }
    const int li = layer >> 1; const bool odd = layer & 1; const int nin = odd ? CV_I_CIN : CV_I_ABIN;
    int f = 0, kind;
    if (r < 2 * CV_I_GU) kind = 0; else { r -= 2 * CV_I_GU; if (r < CV_I_D) kind = 1; else { r -= CV_I_D; if (r < nin) kind = 2; else { r -= nin; if (r < CV_I_OUT) kind = 3; else { r -= CV_I_OUT; f = 1;
        if (r < 2 * CV_I_GU) kind = 0; else { r -= 2 * CV_I_GU; kind = 1; } } } } }
    const int lf = layer * 2 + f;
    if (kind == 0) { const int up = r >= CV_I_GU; if (up) r -= CV_I_GU; const int nblk = FF / 32, kb = r / nblk, nb = r % nblk, n0 = 32 * nb;
        p0_transpose_item<true>((up ? a.wu : a.wg) + (size_t)lf * D * FF, D, FF, (bf16*)(ws + WS_WGU + (size_t)lf * SZ_WGU), 64 * kb, n0, (n0 >> 7) * 256 + (n0 & 127) + up * 128, scr, lane, a.ffn_norm + (size_t)lf * D); }
    else if (kind == 1) { const int nblk = D / 32, kb = r / nblk, nb = r % nblk, n0 = 32 * nb;
        p0_transpose_item<false>(a.wd + (size_t)lf * FF * D, FF, D, (bf16*)(ws + WS_WD + (size_t)lf * SZ_WD), 64 * kb, n0, n0, scr, lane, nullptr); }
    else if (kind == 2) {
        if (!odd) { const int nblk = AB_IN / 32, kb = r / nblk, nb = r % nblk, n0 = 32 * nb;
            p0_transpose_item<true>(a.ab_in + (size_t)li * D * AB_IN, D, AB_IN, (bf16*)(ws + WS_WABIN + (size_t)li * SZ_WABIN), 64 * kb, n0, n0, scr, lane, a.mix_norm + (size_t)layer * D); }
        else { const int nblk = C_IN / 32, kb = r / nblk, nb = r % nblk, n0 = 32 * nb;
            p0_transpose_item<true>(a.c_in + (size_t)li * D * C_IN, D, C_IN, (bf16*)(ws + WS_WCIN + (size_t)li * SZ_WCIN), 64 * kb, n0, n0, scr, lane, a.mix_norm + (size_t)layer * D); } }
    else { const int nblk = D / 32, kb = r / nblk, nb = r % nblk, n0 = 32 * nb;
        p0_transpose_item<false>((odd ? a.c_out : a.ab_out) + (size_t)li * D * D, D, D, (bf16*)(ws + (odd ? WS_WCOUT : WS_WABOUT) + (size_t)li * SZ_WOUT), 64 * kb, n0, n0, scr, lane, nullptr); }
}
__device__ __forceinline__ void cv_run(const Frame& F, const Args& a, unsigned char* ws, int slot, int j, int n) {
    LAS float* scr = (LAS float*)(F.lds + RING_OFF + F.wave * 16384);
    int lane = F.lane; asm volatile("" : "+v"(lane));
    int total = 0;
#pragma unroll
    for (int r = 0; r < CV_MAXR; ++r) total += CV_TAB[slot][r][1] - CV_TAB[slot][r][0];
    for (int idx = j * NWAVES + F.wave; idx < total; idx += n * NWAVES) {
        int rem = idx, it = 0;
#pragma unroll
        for (int r = 0; r < CV_MAXR; ++r) { const int b = CV_TAB[slot][r][0], len = CV_TAB[slot][r][1] - b; if (rem >= 0 && rem < len) it = b + rem; rem -= len; }
        cv_item(a, ws, it, scr, lane);
    }
}
__device__ __forceinline__ void p0_prologue(const Frame& F, const Args& a) {
    const int gw = F.bid * NWAVES + F.wave, NGW = F.G * NWAVES;
    int lane = F.lane; asm volatile("" : "+v"(lane));
    cv_run(F, a, a.ws, 0, F.bid, F.G);
    bf16* const XB = (bf16*)(a.ws + WS_H); pg8::ssq_t* const ssq0 = (pg8::ssq_t*)(a.ws + WS_SSQ);
    for (int m = gw; m < M; m += NGW) {
        const GAS f32x4* xr = (const GAS f32x4*)(a.x + (size_t)m * D) + lane;
        f32x4 v[8]; float s = 0.f;
#pragma unroll
        for (int j = 0; j < 8; ++j) { v[j] = xr[64 * j]; s += (v[j].x * v[j].x + v[j].y * v[j].y) + (v[j].z * v[j].z + v[j].w * v[j].w); }
        s = wave_sum(s);
        s = 0.f;
#pragma unroll
        for (int j = 0; j < 8; ++j) { const h4_t hq = __builtin_convertvector(v[j], h4_t); ((GAS h4_t*)(XB + (size_t)m * D) + lane)[64 * j] = hq; const f32x4 y = __builtin_convertvector(hq, f32x4); s += (y.x * y.x + y.y * y.y) + (y.z * y.z + y.w * y.w); }
        s = wave_sum(s);
        if (lane == 0) ssq0[m] = pg8::ssq_fix(s);
    }
}
__device__ __forceinline__ void final_norm_h_phase(const Frame& F, const bf16* xb, float* out, const float* g, const pg8::ssq_t* ssq, const int stream) {
    const int gw = F.bid * NWAVES + F.wave, NGW = F.G * NWAVES;
    int lane = F.lane; asm volatile("" : "+v"(lane));
    for (int m = stream * MH + gw; m < (stream + 1) * MH; m += NGW) {
        const GAS h4_t* xr = (const GAS h4_t*)(xb + (size_t)m * D) + lane; GAS f32x4* orow = (GAS f32x4*)(out + (size_t)m * D) + lane; const GAS f32x4* gr = (const GAS f32x4*)g + lane;
        const float rstd = 1.0f / sqrtf(pg8::ssq_val(((const GAS pg8::ssq_t*)ssq)[m + (lane & 0)]) * (1.f / D) + RMS_EPS);
        h4_t xv[8]; f32x4 gv[8];
#pragma unroll
        for (int j = 0; j < 8; ++j) { xv[j] = xr[64 * j]; gv[j] = gr[64 * j]; }
#pragma unroll
        for (int j = 0; j < 8; ++j) orow[64 * j] = __builtin_convertvector(xv[j], f32x4) * rstd * gv[j];
    }
}
namespace att {
using bf16x8 = __attribute__((ext_vector_type(8))) short;
using s16x4  = __attribute__((ext_vector_type(4))) short;
using f32x16 = __attribute__((ext_vector_type(16))) float;
using u32x4  = __attribute__((ext_vector_type(4))) unsigned;
constexpr float LOG2E = 1.4426950408889634f;
constexpr float CSC = 0.08838834764831845f * LOG2E;
constexpr float THR_L2 = 4.0f * LOG2E;
#define ATT_KSWZ(row, colB) ((row) * 256 + ((colB) ^ (((row) & 7) << 4)))
__device__ __forceinline__ constexpr int crowc(int r) { return (r & 3) + 8 * (r >> 2); }
__device__ __forceinline__ unsigned cvtpk(float lo, float hi) { unsigned r; asm volatile("v_cvt_pk_bf16_f32 %0, %1, %2" : "=v"(r) : "v"(lo), "v"(hi)); return r; }
__device__ __forceinline__ int swap23(int k) { return (k & ~0xC) | ((k & 4) << 1) | ((k & 8) >> 1); }
__device__ __forceinline__ int v_rd_base(int lane) { return ((lane & 3) << 3) | (((lane >> 2) & 3) << 6) | (((lane >> 4) & 1) << 5) | (((lane >> 5) & 1) << 8); }
constexpr int v_rd_off(int d0, int ks, int half) { return d0 * 512 + ks * 4096 + half * 2048; }
template <int OFF> __device__ __forceinline__ s16x4 tr_read(int vb) { s16x4 r; asm volatile("ds_read_b64_tr_b16 %0, %1 offset:%2" : "=&v"(r) : "v"(vb), "i"(OFF) : "memory"); return r; }
template <int D0> __device__ __forceinline__ void pv_one(f32x16& od, int vb, bf16x8 pa0, bf16x8 pa1) {
    const s16x4 l0 = tr_read<v_rd_off(D0, 0, 0)>(vb), h0 = tr_read<v_rd_off(D0, 0, 1)>(vb), l1 = tr_read<v_rd_off(D0, 1, 0)>(vb), h1 = tr_read<v_rd_off(D0, 1, 1)>(vb);
    asm volatile("s_waitcnt lgkmcnt(0)" ::: "memory"); __builtin_amdgcn_sched_barrier(0);
#define ATT_PK(L, H) (bf16x8){L[0], L[1], L[2], L[3], H[0], H[1], H[2], H[3]}
    od = __builtin_amdgcn_mfma_f32_32x32x16_bf16(pa0, ATT_PK(l0, h0), od, 0, 0, 0);
    od = __builtin_amdgcn_mfma_f32_32x32x16_bf16(pa1, ATT_PK(l1, h1), od, 0, 0, 0);
#undef ATT_PK
}
constexpr int ATT_SCR_OFF = 132096;
constexpr int ATT_RPB_OFF = 136192;
constexpr int RPB_PAD = 8, RPB_FLOATS = 640;
static_assert(ATT_RPB_OFF + 4 * RPB_FLOATS * 4 <= LDS_BYTES && ATT_SCR_OFF >= MISC_OFF + 128, "attention LDS map");

template <int MODE>
__device__ __forceinline__ void attn_mfma(const Frame& F, const bf16* QKV, const int ld, bf16* O, float* part, float* lsebuf, const float* extra, const int stream, const int vc) {
    int lane = F.lane; asm volatile("" : "+v"(lane));
    const int wid = F.wave, pair = wid >> 1, w2 = wid & 1, r32 = lane & 31, hi = lane >> 5;
    LAS unsigned char* const pbase = F.lds + RING_OFF + ((MODE == 1) ? 0 : pair * 32768);
    LAS float* const scr = (LAS float*)(F.lds + ATT_SCR_OFF + wid * 512);
    LAS float* const rpbt = (LAS float*)(F.lds + ATT_RPB_OFF + pair * (RPB_FLOATS * 4));
    constexpr int NT = (MODE == 0) ? 6 : (MODE == 1) ? 10 : 11;
    constexpr int NUNITS = ((MODE == 0) ? 3072 : (MODE == 1) ? 1024 : 2048) / NSTREAM;
    constexpr int HW = (MODE == 0) ? 64 : 128;
    const int vb0 = (int)(uintptr_t)(pbase + 8192) + v_rd_base(lane);
    for (int g = vc; g < NUNITS / 4; g += F.G) {
        const int u = g * 4 + pair;
        int b, h, qcol, kcol, vcol, shift = 0, jres = 0, l0 = 0, L = SEQ, pat = 0, rbase = 0, c0 = 0, qr0 = 0, qc0 = 0;
        if (MODE == 0) { const int blk = u & 31, rest = u >> 5; pat = rest % 3; const int bh = rest / 3; h = bh & 7; b = (BATCH / NSTREAM) * stream + (bh >> 3); shift = 2 * pat; L = SEQ >> shift;
            const int nbs = 5 - shift; jres = blk >> nbs; l0 = 64 * (blk & ((1 << nbs) - 1)); qcol = h * HD; kcol = 1024 + h * HD; vcol = 2048 + h * HD; }
        else if (MODE == 1) { const int blk = g & 31, bk = g >> 5; h = 4 * (bk & 1) + pair; b = (BATCH / NSTREAM) * stream + (bk >> 1); l0 = 64 * blk; qcol = 3072 + h * HD; kcol = 4096 + (h >> 2) * HD; vcol = 4352 + (h >> 2) * HD; }
        else { const int cc = u & 3, ii = (u >> 2) & 7, bh = u >> 5; h = bh & 15; b = (BATCH / NSTREAM) * stream + (bh >> 4); qr0 = 4 * ii; qc0 = 16 * cc; rbase = qr0 - 4; rbase = rbase < 0 ? 0 : (rbase > 21 ? 21 : rbase);
            c0 = (cc == 0) ? 0 : (cc == 1) ? 8 : (cc == 2) ? 24 : 32; qcol = h * HD; kcol = 2048 + h * HD; vcol = 4096 + h * HD; }
        const bf16* const Qb = QKV + (size_t)b * SEQ * ld;
        int lq = 0, qrow = 0, qcl = 0, sq;
        if (MODE == 2) { qrow = qr0 + 2 * w2 + (r32 >> 4); qcl = qc0 + (r32 & 15); sq = qrow * 64 + qcl; }
        else { lq = l0 + 32 * w2 + r32; sq = (lq << shift) + jres; }
        bf16x8 qr[8];
        { const bf16* qp = Qb + (size_t)sq * ld + qcol + hi * 8;
#pragma unroll
          for (int d0 = 0; d0 < 8; ++d0) qr[d0] = *(const bf16x8*)(qp + d0 * 16); }
        float slopeL2 = 0.f; int rs = 0, cs = 0;
        __builtin_amdgcn_s_barrier();
        if (MODE != 2) slopeL2 = exp2f(-(float)(h + 1)) * (float)(1 << shift) * LOG2E;
        else { rs = qrow - 4; rs = rs < 0 ? 0 : (rs > 24 ? 24 : rs); cs = qcl - 8; cs = cs < 0 ? 0 : (cs > 48 ? 48 : cs);
            float rv[4];
#pragma unroll
            for (int k = 0; k < 4; ++k) { int i = lane + 64 * w2 + 128 * k; i = i < 15 * 31 ? i : 15 * 31 - 1; rv[k] = ((const GAS float*)extra)[h * 15 * 31 + i]; }
#pragma unroll
            for (int k = 0; k < 4; ++k) { const int i = lane + 64 * w2 + 128 * k; if (i < 15 * 31) rpbt[RPB_PAD + i] = rv[k] * LOG2E; } }
        const int krow = 16 * w2 + (lane >> 4);
        const int kch = lane & 15;
        const int vst = 8 * w2 + (lane >> 5), vq = lane & 31;
#define ATT_KEYTOK(jj, t) ((MODE == 2) ? ((rbase + (t)) * 64 + c0 + (jj)) : ({ int lk_ = l0 - HW + 32 * (t) + (jj); lk_ = lk_ < 0 ? 0 : (lk_ > L - 1 ? L - 1 : lk_); (lk_ << shift) + jres; }))
#define ATT_STAGE(t) do { LAS unsigned char* const bb_ = pbase + ((t) & 1) * 16384; \
        if (MODE == 1) { const int row_ = 4 * wid + (lane >> 4); const int tok_ = ATT_KEYTOK(row_, t);                                 \
            __builtin_amdgcn_global_load_lds((const unsigned*)(Qb + (size_t)tok_ * ld + kcol + ((kch ^ (row_ & 7)) << 3)), (LAS unsigned*)(bb_ + wid * 1024), 16, 0, 0); \
            const int st_ = 2 * wid + (lane >> 5); const int kk_ = (st_ >> 2) * 8 + (vq >> 2); const int tokv_ = ATT_KEYTOK(swap23(kk_), t); \
            __builtin_amdgcn_global_load_lds((const unsigned*)(Qb + (size_t)tokv_ * ld + vcol + (st_ & 3) * 32 + (vq & 3) * 8), (LAS unsigned*)(bb_ + 8192 + wid * 1024), 16, 0, 0); } \
        else { \
        _Pragma("unroll") for (int i_ = 0; i_ < 4; ++i_) { const int row_ = krow + 4 * i_; const int tok_ = ATT_KEYTOK(row_, t); \
            __builtin_amdgcn_global_load_lds((const unsigned*)(Qb + (size_t)tok_ * ld + kcol + ((kch ^ (row_ & 7)) << 3)), (LAS unsigned*)(bb_ + (w2 * 4 + i_) * 1024), 16, 0, 0); } \
        _Pragma("unroll") for (int i_ = 0; i_ < 4; ++i_) { const int st_ = vst + 2 * i_; const int kk_ = (st_ >> 2) * 8 + (vq >> 2); const int tok_ = ATT_KEYTOK(swap23(kk_), t); \
            __builtin_amdgcn_global_load_lds((const unsigned*)(Qb + (size_t)tok_ * ld + vcol + (st_ & 3) * 32 + (vq & 3) * 8), (LAS unsigned*)(bb_ + 8192 + (w2 * 4 + i_) * 1024), 16, 0, 0); } } } while (0)
        float m_reg = -1e30f, l_reg = 0.f;
        f32x16 o[4];
#pragma unroll
        for (int d = 0; d < 4; ++d)
#pragma unroll
            for (int r = 0; r < 16; ++r) o[d][r] = 0.f;
        asm volatile("s_waitcnt lgkmcnt(0)" ::: "memory"); __builtin_amdgcn_s_barrier();
        ATT_STAGE(0);
        for (int t = 0; t < NT; ++t) {
            asm volatile("s_waitcnt vmcnt(0)" ::: "memory"); __builtin_amdgcn_s_barrier(); asm volatile("" ::: "memory");
            if (t + 1 < NT) ATT_STAGE(t + 1);
            bool need = true;
            if (MODE == 0) need = (w2 == 0) ? (t < 5) : (t > 0);
            else if (MODE == 1) need = (w2 == 0) ? (t < 9) : (t > 0);
            else { const int kr = rbase + t, ra = qr0 + 2 * w2; int rsA = ra - 4; rsA = rsA < 0 ? 0 : (rsA > 24 ? 24 : rsA); int rsB = ra - 3; rsB = rsB < 0 ? 0 : (rsB > 24 ? 24 : rsB); need = (kr >= rsA) && (kr < rsB + 8); }
            if (!need) continue;
            LAS unsigned char* const Kb = pbase + (t & 1) * 16384;
            f32x16 p0;
#pragma unroll
            for (int r = 0; r < 16; ++r) p0[r] = 0.f;
#pragma unroll
            for (int d0 = 0; d0 < 8; ++d0) { const int cb = (d0 * 16 + hi * 8) * 2;
                const bf16x8 kf = *(const LAS bf16x8*)(Kb + ATT_KSWZ(r32, cb));
                p0 = __builtin_amdgcn_mfma_f32_32x32x16_bf16(kf, qr[d0], p0, 0, 0, 0); }
            if (MODE != 2) {
                const int kb_i = l0 - HW + 32 * t + 4 * hi;
                const float fb = (float)(kb_i - lq);
#pragma unroll
                for (int r = 0; r < 16; ++r) { const float fd = fb + (float)crowc(r); const bool ok = (fabsf(fd) <= (float)HW) && ((unsigned)(kb_i + crowc(r)) < (unsigned)L);
                    p0[r] = ok ? fmaf(p0[r], CSC, -slopeL2 * fabsf(fd)) : -INFINITY; }
            } else {
                int rs_ = qrow - 4; rs_ = rs_ < 0 ? 0 : (rs_ > 24 ? 24 : rs_); int cs_ = qcl - 8; cs_ = cs_ < 0 ? 0 : (cs_ > 48 ? 48 : cs_);
                const int kr = rbase + t; const bool inr = (unsigned)(kr - rs_) < 8u;
                const int kcb = c0 + 4 * hi;
                const LAS float* bp = rpbt + RPB_PAD + (kr - qrow + 7) * 31 + (kcb - qcl + 15);
                float bv[16];
#pragma unroll
                for (int r = 0; r < 16; ++r) bv[r] = bp[crowc(r)];
#pragma unroll
                for (int r = 0; r < 16; ++r) { const bool ok = inr && ((unsigned)(kcb + crowc(r) - cs_) < 16u);
                    p0[r] = ok ? fmaf(p0[r], CSC, bv[r]) : -INFINITY; }
            }
            float pmax = p0[0];
#pragma unroll
            for (int r = 1; r < 16; ++r) pmax = fmaxf(pmax, p0[r]);
            { auto rr = __builtin_amdgcn_permlane32_swap(__float_as_uint(pmax), __float_as_uint(pmax), false, false); pmax = fmaxf(__uint_as_float(rr[0]), __uint_as_float(rr[1])); }
            float alpha = 1.f;
            if (!__all(pmax - m_reg <= THR_L2)) { const float mn = fmaxf(m_reg, pmax); alpha = __builtin_amdgcn_exp2f(m_reg - mn); m_reg = mn; }
            float ps = 0.f;
#pragma unroll
            for (int r = 0; r < 16; ++r) { p0[r] = __builtin_amdgcn_exp2f(p0[r] - m_reg); ps += p0[r]; }
            { auto rr = __builtin_amdgcn_permlane32_swap(__float_as_uint(ps), __float_as_uint(ps), false, false); ps = __uint_as_float(rr[0]) + __uint_as_float(rr[1]); }
            l_reg = l_reg * alpha + ps;
            bf16x8 pa0, pa1;
#define ATT_PK4(P, BASE, OUT) do { unsigned a0 = cvtpk(P[BASE + 0], P[BASE + 1]), a1 = cvtpk(P[BASE + 2], P[BASE + 3]); \
        unsigned b0 = cvtpk(P[BASE + 4], P[BASE + 5]), b1 = cvtpk(P[BASE + 6], P[BASE + 7]); \
        auto r0 = __builtin_amdgcn_permlane32_swap(a0, b0, false, false); auto r1 = __builtin_amdgcn_permlane32_swap(a1, b1, false, false); \
        u32x4 w = {r0[0], r1[0], r0[1], r1[1]}; OUT = *reinterpret_cast<bf16x8*>(&w); } while (0)
            ATT_PK4(p0, 0, pa0); ATT_PK4(p0, 8, pa1);
#undef ATT_PK4
            if (__any(alpha < 1.f)) { if (hi == 0) scr[r32] = alpha; asm volatile("s_waitcnt lgkmcnt(0)" ::: "memory");
#pragma unroll
                for (int r = 0; r < 16; ++r) { const float a = scr[crowc(r) + 4 * hi];
#pragma unroll
                    for (int d = 0; d < 4; ++d) o[d][r] *= a; } }
            const int vb = vb0 + (t & 1) * 16384;
            pv_one<0>(o[0], vb, pa0, pa1); pv_one<1>(o[1], vb, pa0, pa1); pv_one<2>(o[2], vb, pa0, pa1); pv_one<3>(o[3], vb, pa0, pa1);
        }
        float fin;
        if (MODE == 1) { const float sk = extra[h] * LOG2E; const float mf = fmaxf(m_reg, sk); const float a = __builtin_amdgcn_exp2f(m_reg - mf); const float lf = l_reg * a + __builtin_amdgcn_exp2f(sk - mf); fin = a / lf; }
        else fin = 1.0f / l_reg;
        asm volatile("s_waitcnt lgkmcnt(0)" ::: "memory");
        if (hi == 0) scr[r32] = fin;
        asm volatile("s_waitcnt lgkmcnt(0)" ::: "memory");
        if (MODE == 0 && hi == 0) lsebuf[((size_t)pat * M + (size_t)b * SEQ + sq) * 8 + h] = m_reg + __log2f(l_reg);
#pragma unroll
        for (int r = 0; r < 16; ++r) { const int qi = crowc(r) + 4 * hi; const float f = scr[qi];
            int sqi; if (MODE == 2) sqi = (qr0 + 2 * w2 + (qi >> 4)) * 64 + qc0 + (qi & 15); else sqi = ((l0 + 32 * w2 + qi) << shift) + jres;
            const size_t tokq = (size_t)b * SEQ + sqi;
            if (MODE == 0) { _Float16* op = (_Float16*)part + ((size_t)pat * M + tokq) * 1024 + h * HD + r32;
#pragma unroll
                for (int d = 0; d < 4; ++d) op[32 * d] = (_Float16)(o[d][r] * f); }
            else { bf16* op = O + tokq * D + ((MODE == 1) ? 1024 : 0) + h * HD + r32;
#pragma unroll
                for (int d = 0; d < 4; ++d) op[32 * d] = (bf16)f2bf(o[d][r] * f); } }
#undef ATT_STAGE
#undef ATT_KEYTOK
    }
    asm volatile("s_waitcnt vmcnt(0) lgkmcnt(0)" ::: "memory"); __builtin_amdgcn_s_barrier();
}
__device__ __forceinline__ void attn_combine(const Frame& F, const float* part, const float* lsebuf, bf16* O, const int stream) {
    int lane = F.lane; asm volatile("" : "+v"(lane));
    const int gw = F.bid * NWAVES + F.wave, NGW = F.G * NWAVES;
    for (int it = gw; it < MH * 8; it += NGW) {
        const int tok = stream * MH + (it >> 3), h = it & 7;
        const float e0 = lsebuf[((size_t)0 * M + tok) * 8 + h], e1 = lsebuf[((size_t)1 * M + tok) * 8 + h], e2 = lsebuf[((size_t)2 * M + tok) * 8 + h];
        const float mx = fmaxf(e0, fmaxf(e1, e2)); float w0 = __builtin_amdgcn_exp2f(e0 - mx), w1 = __builtin_amdgcn_exp2f(e1 - mx), w2 = __builtin_amdgcn_exp2f(e2 - mx);
        const float inv = 1.0f / (w0 + w1 + w2); w0 *= inv; w1 *= inv; w2 *= inv;
        typedef _Float16 f16x2 __attribute__((ext_vector_type(2)));
        const _Float16* ph = (const _Float16*)part; const size_t off = (size_t)tok * 1024 + h * HD + 2 * lane;
        const f16x2 a = *(const f16x2*)(ph + off), bq = *(const f16x2*)(ph + (size_t)M * 1024 + off), c = *(const f16x2*)(ph + (size_t)2 * M * 1024 + off);
        ((unsigned*)(O + (size_t)tok * D + h * HD))[lane] = pk2(w0 * (float)a.x + w1 * (float)bq.x + w2 * (float)c.x, w0 * (float)a.y + w1 * (float)bq.y + w2 * (float)c.y);
    }
}
}

__global__ void __launch_bounds__(NWAVES * 64, 2) fwd(Args a) {
    extern __shared__ __attribute__((aligned(16))) unsigned char lds[];
    Frame F;
    F.lds = (LAS unsigned char*)lds;
    F.wave = __builtin_amdgcn_readfirstlane((int)threadIdx.x >> 6); F.lane = 0; F.tid = 0;
    F.G = gridDim.x; F.bid = blockIdx.x;
    for (int u = (int)threadIdx.x; u < (LDS_BYTES - LDSCTL_OFF) / 4; u += NWAVES * 64) ((LAS unsigned*)(F.lds + LDSCTL_OFF))[u] = 0u;
    __syncthreads();
    XcdBarrier bar = xcd_barrier_post((unsigned*)(a.ws + WS_CTL) + CW_BAR, (volatile LAS unsigned*)(F.lds + MISC_OFF) + 8, F.wave);
#define PH_ENTER() Frame Fp = F; unsigned char* ws = a.ws; float* xo = a.out; asm volatile("" : "+s"(Fp.bid), "+s"(Fp.wave), "+s"(Fp.G), "+s"(ws), "+s"(xo)); \
    asm volatile("v_mbcnt_lo_u32_b32 %0, -1, 0\n\tv_mbcnt_hi_u32_b32 %0, -1, %0" : "=v"(Fp.lane)); Fp.tid = Fp.wave * 64 + Fp.lane;     \
    bf16* const Hb = (bf16*)(ws + WS_H); bf16* const Ub = (bf16*)(ws + WS_U); bf16* const QKVb = (bf16*)(ws + WS_QKV); bf16* const Ob = (bf16*)(ws + WS_O); float* const Pb = (float*)(ws + WS_PART); float* const Lb = (float*)(ws + WS_LSE); \
    int vc = Fp.bid - off; if (vc < 0) vc += Fp.G; const size_t rowoff = (size_t)s * MH; \
    (void)Hb; (void)Ub; (void)QKVb; (void)Ob; (void)Pb; (void)Lb; (void)xo; (void)vc; (void)rowoff
#define ITEM_BEGIN() for (int s = 0; s < NSTREAM; ++s) { if (T >= NSTREAM) sb_wait(bar, (unsigned*)(a.ws + WS_SB), T - NSTREAM);
#define ITEM_END(nunits) sb_arrive(bar, (unsigned*)(a.ws + WS_SB), T); ++T; off = (off + (nunits)) % F.G; }
    int T = 0, off = 0;
    { const int s = 0; PH_ENTER(); p0_prologue(Fp, a); }
    xcd_barrier(bar);
    for (int layer = 0; layer < DEPTH; ++layer) {
        const bool even = (layer & 1) == 0; const int li = layer >> 1;
        for (int sub = 0; sub < 3; ++sub) {
            const int lf = layer * 2 + (sub == 2 ? 1 : 0);
            const int sb = layer * 3 + sub;
            const int N1 = (sub == 1) ? (even ? AB_IN : C_IN) : 2 * FF;
            ITEM_BEGIN() { PH_ENTER();
                if (sub == 1) {
                    const bf16* W = even ? (const bf16*)(ws + WS_WABIN + (size_t)li * SZ_WABIN) : (const bf16*)(ws + WS_WCIN + (size_t)li * SZ_WCIN);
                    pg8::Gemm g{Hb + rowoff * D, W, MH, N1, D}; pg8::StaticOrder S; S.init(MH, N1, Fp.G, vc);
                    pg8::EpiBf16 E{QKVb + rowoff * N1, N1, (const pg8::ssq_t*)(ws + WS_SSQ) + (size_t)sb * M + rowoff, Fp.lds + att::ATT_SCR_OFF};
                    pg8::gemm_phase<pg8::EpiBf16, pg8::StaticOrder, true, true, 0, RESID_F16 != 0>(Fp.lds + RING_OFF, g, S, E, Fp.tid);
                } else {
                    pg8::Gemm g{Hb + rowoff * D, (const bf16*)(ws + WS_WGU + (size_t)lf * SZ_WGU), MH, 2 * FF, D}; pg8::StaticOrder S; S.init(MH, 2 * FF, Fp.G, vc);
                    pg8::EpiSwiglu E{Ub + rowoff * FF, FF, (const pg8::ssq_t*)(ws + WS_SSQ) + (size_t)sb * M + rowoff, Fp.lds + att::ATT_SCR_OFF};
                    pg8::gemm_phase<pg8::EpiSwiglu, pg8::StaticOrder, true, true, 0, RESID_F16 != 0>(Fp.lds + RING_OFF, g, S, E, Fp.tid);
                }
            } ITEM_END((MH / 256) * (N1 / 256))
            if (sub == 1) {
                if (even) {
                    ITEM_BEGIN() { PH_ENTER(); att::attn_mfma<0>(Fp, QKVb, AB_IN, Ob, Pb, Lb, nullptr, s, vc); } ITEM_END(3072 / NSTREAM / 4)
                    ITEM_BEGIN() { PH_ENTER(); att::attn_mfma<1>(Fp, QKVb, AB_IN, Ob, Pb, Lb, a.ab_sink + li * 8, s, vc); att::attn_combine(Fp, Pb, Lb, Ob, s); } ITEM_END(1024 / NSTREAM / 4)
                } else {
                    ITEM_BEGIN() { PH_ENTER(); att::attn_mfma<2>(Fp, QKVb, C_IN, Ob, Pb, Lb, a.c_rpb + (size_t)li * 16 * 15 * 31, s, vc); } ITEM_END(2048 / NSTREAM / 4)
                }
            }
            ITEM_BEGIN() { PH_ENTER();
                const bf16* A2 = (sub == 1) ? (const bf16*)(Ob + rowoff * D) : (const bf16*)(Ub + rowoff * FF); const int K2 = (sub == 1) ? D : FF;
                const bf16* W2 = (sub == 1) ? (even ? (const bf16*)(ws + WS_WABOUT + (size_t)li * SZ_WOUT) : (const bf16*)(ws + WS_WCOUT + (size_t)li * SZ_WOUT))
                                            : (const bf16*)(ws + WS_WD + (size_t)lf * SZ_WD);
                pg8::Gemm g{A2, W2, MH, D, K2}; pg8::StaticOrder S; S.init(MH, D, Fp.G, vc);
                pg8::EpiResidH E{Hb + rowoff * D, D, (sub == 1) ? 1.0f : 0.5f, Hb + rowoff * D, (pg8::ssq_t*)(ws + WS_SSQ) + (size_t)(sb + 1) * M + rowoff};
                pg8::gemm_phase<pg8::EpiResidH, pg8::StaticOrder, true, true>(Fp.lds + RING_OFF, g, S, E, Fp.tid);
            } ITEM_END((MH / 256) * (D / 256))
        }
    }
    ITEM_BEGIN() { PH_ENTER(); final_norm_h_phase(Fp, Hb, xo, a.final_norm, (const pg8::ssq_t*)(ws + WS_SSQ) + (size_t)12 * M, s); } ITEM_END(0)
#undef PH_ENTER
#undef ITEM_BEGIN
#undef ITEM_END
}

extern "C" void kernel_launch(void* const* d_in, const int* in_sizes, int n_in, void* d_out, int out_size, void* d_ws, size_t ws_size, hipStream_t stream) {
    static int grid = 0;
    if (grid == 0) {
        if (n_in != 13 || in_sizes[0] != M * D || out_size != M * D || ws_size < WS_END) { fprintf(stderr, "kernel_launch: unexpected shapes (n_in %d, in0 %d, out %d, ws %zu, need %zu); nothing launched\n", n_in, n_in > 0 ? in_sizes[0] : -1, out_size, ws_size, (size_t)WS_END); grid = -1; return; }
        int dev = 0, cus = 0, per_cu = 0;
        if (hipGetDevice(&dev) != hipSuccess || hipDeviceGetAttribute(&cus, hipDeviceAttributeMultiprocessorCount, dev) != hipSuccess) { fprintf(stderr, "kernel_launch: device query failed\n"); grid = -1; return; }
        if (hipFuncSetAttribute((const void*)fwd, hipFuncAttributeMaxDynamicSharedMemorySize, LDS_BYTES) != hipSuccess) { fprintf(stderr, "kernel_launch: hipFuncSetAttribute failed\n"); grid = -1; return; }
        if (hipOccupancyMaxActiveBlocksPerMultiprocessor(&per_cu, (const void*)fwd, NWAVES * 64, LDS_BYTES) != hipSuccess || per_cu < 1)
            fprintf(stderr, "kernel_launch: note: occupancy query reports %d workgroups per CU\n", per_cu);
        (void)hipGetLastError();
        grid = cus;
    }
    if (grid < 0) return;
    if (hipMemsetAsync((char*)d_ws + WS_CTL, 0, CTL_ZERO_BYTES, stream) != hipSuccess) { fprintf(stderr, "kernel_launch: memset failed\n"); return; }
    Args a{};
    a.x = (const float*)d_in[0]; a.ffn_norm = (const float*)d_in[1]; a.wg = (const float*)d_in[2]; a.wu = (const float*)d_in[3]; a.wd = (const float*)d_in[4]; a.mix_norm = (const float*)d_in[5];
    a.ab_in = (const float*)d_in[6]; a.ab_out = (const float*)d_in[7]; a.ab_sink = (const float*)d_in[8]; a.c_in = (const float*)d_in[9]; a.c_out = (const float*)d_in[10]; a.c_rpb = (const float*)d_in[11];
    a.final_norm = (const float*)d_in[12]; a.out = (float*)d_out; a.ws = (unsigned char*)d_ws;
    a.ph_lo = 0; a.ph_hi = 0; hipLaunchKernelGGL(fwd, dim3(grid), dim3(NWAVES * 64), LDS_BYTES, stream, a);
    const hipError_t le = hipPeekAtLastError();
    if (le != hipSuccess) fprintf(stderr, "kernel_launch: launch failed: %s\n", hipGetErrorName(le));
}
```
